# Optimizing an MI355X kernel written in HIP

```python
import jax
import jax.numpy as jnp
from jax import lax
import numpy as np

D_MODEL = 1024
BATCH = 8
SEQ = 2048
DEPTH = 2

BRANCH_W = D_MODEL // 2
N_BRANCH = 3
SB_HDIM = 64
SB_HEADS = BRANCH_W // SB_HDIM
SB_QBLOCK = 128
MB_HDIM = 64
MB_HEADS = BRANCH_W // MB_HDIM
MB_BLOCK = 256
MB_TOPK = 3
MB_QCHUNK = 16
ROPE_THETA = 500000.0
ROPE_DIM = MB_HDIM // 4
ML_HEADS = 4
ML_HDIM = BRANCH_W // ML_HEADS
ML_CHUNK = 64
CONV_W = 4
N_GROUPS = 4
EXPERTS_PER_GROUP = 8
N_EXPERTS = N_GROUPS * EXPERTS_PER_GROUP
EXPERT_TOPK = 2
D_EXPERT = D_MODEL // 4
RMS_EPS = 1e-6
P_IN = 10 * BRANCH_W + 2 * ML_HEADS + N_BRANCH * D_MODEL

kernel_name = "hybrid_sb_moba_mlstm_hmoe"


def rms_norm(x, g):
    xf = x.astype(jnp.float32)
    y = xf * lax.rsqrt(jnp.mean(xf * xf, axis=-1, keepdims=True) + RMS_EPS)
    return (y * g.astype(jnp.float32)).astype(x.dtype)


def split_heads(t, n_heads):
    b, s, _ = t.shape
    return t.reshape(b, s, n_heads, -1).transpose(0, 2, 1, 3)


def merge_heads(t):
    b, h, s, d = t.shape
    return t.transpose(0, 2, 1, 3).reshape(b, s, h * d)


def rotary_partial(x, positions):
    half = ROPE_DIM // 2
    inv_freq = jnp.power(jnp.float32(ROPE_THETA), -jnp.arange(half, dtype=jnp.float32) / half)
    ang = positions.astype(jnp.float32)[:, None, :, None] * inv_freq
    cos, sin = jnp.cos(ang), jnp.sin(ang)
    xr = x[..., :ROPE_DIM].astype(jnp.float32)
    x1, x2 = xr[..., :half], xr[..., half:]
    rot = jnp.concatenate([x1 * cos - x2 * sin, x1 * sin + x2 * cos], axis=-1).astype(x.dtype)
    return jnp.concatenate([rot, x[..., ROPE_DIM:]], axis=-1)


def causal_depthwise_conv(u, w):
    c = u.shape[-1]
    return lax.conv_general_dilated(
        u, w[:, None, :].astype(u.dtype), window_strides=(1,),
        padding=[(CONV_W - 1, 0)], dimension_numbers=("NWC", "WIO", "NWC"),
        feature_group_count=c)


def stick_breaking_attention(q, k, v):
    b, h, s, d = q.shape
    nq = s // SB_QBLOCK
    scale = d ** -0.5
    kpos = jnp.arange(s)
    qb = q.reshape(b, h, nq, SB_QBLOCK, d).transpose(2, 0, 1, 3, 4)

    def block(args):
        qi, iblk = args
        qpos = iblk * SB_QBLOCK + jnp.arange(SB_QBLOCK)
        z = jnp.einsum("bhqd,bhkd->bhqk", qi, k).astype(jnp.float32) * scale
        past = kpos[None, :] < qpos[:, None]
        log_rem = jnp.where(past, jax.nn.log_sigmoid(-z), 0.0)
        after = lax.cumsum(log_rem, axis=3, reverse=True) - log_rem
        w = jnp.where(past, jnp.exp(jax.nn.log_sigmoid(z) + after), 0.0)
        return jnp.einsum("bhqk,bhkd->bhqd", w.astype(v.dtype), v)

    out = lax.map(block, (qb, jnp.arange(nq)))
    return out.transpose(1, 2, 0, 3, 4).reshape(b, h, s, d)


def moba_attention(q, k, v):
    b, h, s, d = q.shape
    nb = -(-s // MB_BLOCK)
    sp = nb * MB_BLOCK
    pad = ((0, 0), (0, 0), (0, sp - s), (0, 0))
    kb = jnp.pad(k, pad).reshape(b, h, nb, MB_BLOCK, d)
    vb = jnp.pad(v, pad).reshape(b, h, nb, MB_BLOCK, d)
    kmean = jnp.mean(kb.astype(jnp.float32), axis=3)
    topk = min(MB_TOPK, nb - 1)
    scale = d ** -0.5
    nc = s // MB_QCHUNK
    qc = q.reshape(b, h, nc, MB_QCHUNK, d).transpose(2, 0, 1, 3, 4)
    bi = jnp.arange(b)[:, None, None, None]
    hi = jnp.arange(h)[None, :, None, None]
    blk_ids = jnp.arange(nb)

    def chunk(args):
        qi, ci = args
        qpos = ci * MB_QCHUNK + jnp.arange(MB_QCHUNK)
        own = (ci * MB_QCHUNK) // MB_BLOCK
        k_own = lax.dynamic_index_in_dim(kb, own, axis=2, keepdims=False)
        v_own = lax.dynamic_index_in_dim(vb, own, axis=2, keepdims=False)
        kpos_own = own * MB_BLOCK + jnp.arange(MB_BLOCK)
        s_own = jnp.einsum("bhqd,bhkd->bhqk", qi, k_own).astype(jnp.float32) * scale
        s_own = jnp.where(kpos_own[None, :] <= qpos[:, None], s_own, -jnp.inf)
        if topk == 0:
            p = jax.nn.softmax(s_own, axis=-1).astype(v.dtype)
            return jnp.einsum("bhqk,bhkd->bhqd", p, v_own)
        gate = jnp.einsum("bhqd,bhnd->bhqn", qi.astype(jnp.float32), kmean)
        gate = jnp.where(blk_ids < own, gate, -jnp.inf)
        _, idx = lax.top_k(gate, topk)
        valid = idx < own
        k_sel = kb[bi, hi, idx]
        v_sel = vb[bi, hi, idx]
        s_sel = jnp.einsum("bhqd,bhqnkd->bhqnk", qi, k_sel).astype(jnp.float32) * scale
        s_sel = jnp.where(valid[..., None], s_sel, -jnp.inf)
        s_all = jnp.concatenate([s_own, s_sel.reshape(b, h, MB_QCHUNK, topk * MB_BLOCK)], axis=-1)
        p = jax.nn.softmax(s_all, axis=-1).astype(v.dtype)
        p_own = p[..., :MB_BLOCK]
        p_sel = p[..., MB_BLOCK:].reshape(b, h, MB_QCHUNK, topk, MB_BLOCK)
        return (jnp.einsum("bhqk,bhkd->bhqd", p_own, v_own)
                + jnp.einsum("bhqnk,bhqnkd->bhqd", p_sel, v_sel))

    out = lax.map(chunk, (qc, jnp.arange(nc)))
    return out.transpose(1, 2, 0, 3, 4).reshape(b, h, s, d)


def mlstm_chunkwise(q, k, v, log_i, log_f):
    b, h, s, d = q.shape
    L = ML_CHUNK
    nc = s // L
    k = k * d ** -0.5

    def to_chunks(a):
        return jnp.moveaxis(a.reshape(b, h, nc, L, *a.shape[3:]), 2, 0)

    causal = jnp.tril(jnp.ones((L, L), dtype=bool))

    def step(carry, inp):
        C, n, m = carry
        qc, kc, vc, li, lf = inp
        qf, kf, vf = qc.astype(jnp.float32), kc.astype(jnp.float32), vc.astype(jnp.float32)
        bcum = jnp.cumsum(lf, axis=-1)
        dmat = bcum[..., :, None] - bcum[..., None, :] + li[..., None, :]
        dmat = jnp.where(causal, dmat, -jnp.inf)
        inter = bcum + m[..., None]
        m_t = jnp.maximum(inter, jnp.max(dmat, axis=-1))
        w_intra = jnp.exp(dmat - m_t[..., None])
        w_inter = jnp.exp(inter - m_t)
        sc = jnp.einsum("bhtd,bhsd->bhts", qf, kf) * w_intra
        num = (jnp.einsum("bhts,bhse->bhte", sc, vf)
               + w_inter[..., None] * jnp.einsum("bhed,bhtd->bhte", C, qf))
        den = jnp.sum(sc, axis=-1) + w_inter * jnp.einsum("bhd,bhtd->bht", n, qf)
        out = num / jnp.maximum(jnp.abs(den), jnp.exp(-m_t))[..., None]
        m_new = m_t[..., -1]
        decay = jnp.exp(bcum[..., -1] + m - m_new)
        w_k = jnp.exp(bcum[..., -1:] - bcum + li - m_new[..., None])
        C_new = decay[..., None, None] * C + jnp.einsum("bhs,bhse,bhsd->bhed", w_k, vf, kf)
        n_new = decay[..., None] * n + jnp.einsum("bhs,bhsd->bhd", w_k, kf)
        return (C_new, n_new, m_new), out

    init = (jnp.zeros((b, h, d, d), jnp.float32), jnp.zeros((b, h, d), jnp.float32),
            jnp.zeros((b, h), jnp.float32))
    _, hs = lax.scan(step, init, (to_chunks(q), to_chunks(k), to_chunks(v),
                                  to_chunks(log_i), to_chunks(log_f)))
    return jnp.moveaxis(hs, 0, 2).reshape(b, h, s, d).astype(v.dtype)


def mixer_block(x, positions, norm_g, w_in, qn_g, kn_g, conv_w, ml_gate_b, w_branch, w_out):
    W = BRANCH_W
    bsz, s, _ = x.shape
    xn = rms_norm(x, norm_g)
    proj = xn @ w_in
    sb = proj[..., 0:3 * W]
    mb = proj[..., 3 * W:6 * W]
    ml_qk = proj[..., 6 * W:8 * W]
    ml_v = proj[..., 8 * W:9 * W]
    ml_o = proj[..., 9 * W:10 * W]
    ml_if = proj[..., 10 * W:10 * W + 2 * ML_HEADS]
    gate_logits = proj[..., 10 * W + 2 * ML_HEADS:]

    q, k, v = (split_heads(t, SB_HEADS) for t in jnp.split(sb, 3, axis=-1))
    y_sb = merge_heads(stick_breaking_attention(q, k, v))

    q, k, v = (split_heads(t, MB_HEADS) for t in jnp.split(mb, 3, axis=-1))
    q = rotary_partial(rms_norm(q, qn_g), positions)
    k = rotary_partial(rms_norm(k, kn_g), positions)
    y_mb = merge_heads(moba_attention(q, k, v))

    qk = jax.nn.silu(causal_depthwise_conv(ml_qk, conv_w))
    q = split_heads(qk[..., :W], ML_HEADS)
    k = split_heads(qk[..., W:], ML_HEADS)
    v = split_heads(ml_v, ML_HEADS)
    if_pre = ml_if.astype(jnp.float32) + ml_gate_b.astype(jnp.float32)
    log_i = if_pre[..., :ML_HEADS].transpose(0, 2, 1)
    log_f = jax.nn.log_sigmoid(if_pre[..., ML_HEADS:]).transpose(0, 2, 1)
    y_ml = merge_heads(mlstm_chunkwise(q, k, v, log_i, log_f)) * jax.nn.sigmoid(ml_o)

    branches = jnp.stack([y_sb, y_mb, y_ml], axis=0)
    y = jnp.einsum("nbsw,nwd->nbsd", branches, w_branch)
    gates = jax.nn.sigmoid(gate_logits.reshape(bsz, s, N_BRANCH, D_MODEL))
    merged = jnp.einsum("bsnd,nbsd->bsd", gates, y)
    return x + merged @ w_out


def hier_moe_block(x, norm_g, w_rg, b_rg, w_re, b_re, w1, w3, w2):
    bsz, s, d = x.shape
    n_tok = bsz * s
    xn = rms_norm(x, norm_g).reshape(n_tok, d)
    g_prob = jax.nn.softmax((xn @ w_rg).astype(jnp.float32) + b_rg, axis=-1)
    g_w, g_idx = lax.top_k(g_prob, 1)
    e_logits = ((xn @ w_re).astype(jnp.float32) + b_re).reshape(n_tok, N_GROUPS, EXPERTS_PER_GROUP)
    e_in = jnp.take_along_axis(e_logits, g_idx[:, :, None], axis=1)[:, 0]
    e_w, e_idx = lax.top_k(jax.nn.softmax(e_in, axis=-1), EXPERT_TOPK)
    e_w = e_w / jnp.sum(e_w, axis=-1, keepdims=True) * g_w
    flat_idx = g_idx * EXPERTS_PER_GROUP + e_idx
    combine = jnp.zeros((n_tok, N_EXPERTS), jnp.float32).at[
        jnp.arange(n_tok)[:, None], flat_idx].add(e_w)
    hid = jax.nn.silu(jnp.einsum("nd,edf->nef", xn, w1)) * jnp.einsum("nd,edf->nef", xn, w3)
    hid = hid * combine.astype(hid.dtype)[:, :, None]
    y = jnp.einsum("nef,efd->nd", hid, w2)
    return x + y.reshape(bsz, s, d)


def setup_inputs(seed: int = 0) -> dict:
    key = jax.random.key(seed)
    ks = jax.random.split(key, 20)

    def nrm(k, shape, scale):
        return jax.random.normal(k, shape, jnp.float32) * scale

    x = nrm(ks[0], (BATCH, SEQ, D_MODEL), 1.0)
    start = jax.random.randint(ks[1], (BATCH,), 0, 4096, dtype=jnp.int32)
    positions = (start[:, None] + jnp.arange(SEQ, dtype=jnp.int32)[None, :]).astype(jnp.int32)
    norm1_g = 1.0 + nrm(ks[2], (DEPTH, D_MODEL), 0.02)
    w_in = nrm(ks[3], (DEPTH, D_MODEL, P_IN), D_MODEL ** -0.5)
    qn_g = 1.0 + nrm(ks[4], (DEPTH, MB_HDIM), 0.02)
    kn_g = 1.0 + nrm(ks[5], (DEPTH, MB_HDIM), 0.02)
    conv_w = nrm(ks[6], (DEPTH, CONV_W, 2 * BRANCH_W), CONV_W ** -0.5)
    i_bias = nrm(ks[7], (DEPTH, ML_HEADS), 0.1)
    f_bias = jnp.linspace(3.0, 6.0, ML_HEADS, dtype=jnp.float32)[None, :] + nrm(ks[8], (DEPTH, ML_HEADS), 0.1)
    ml_gate_b = jnp.concatenate([i_bias, f_bias], axis=-1)
    w_branch = nrm(ks[9], (DEPTH, N_BRANCH, BRANCH_W, D_MODEL), BRANCH_W ** -0.5)
    w_out = nrm(ks[10], (DEPTH, D_MODEL, D_MODEL), D_MODEL ** -0.5)
    norm2_g = 1.0 + nrm(ks[11], (DEPTH, D_MODEL), 0.02)
    w_rg = nrm(ks[12], (DEPTH, D_MODEL, N_GROUPS), D_MODEL ** -0.5)
    b_rg = nrm(ks[13], (DEPTH, N_GROUPS), 0.01)
    w_re = nrm(ks[14], (DEPTH, D_MODEL, N_EXPERTS), D_MODEL ** -0.5)
    b_re = nrm(ks[15], (DEPTH, N_EXPERTS), 0.01)
    w1 = nrm(ks[16], (DEPTH, N_EXPERTS, D_MODEL, D_EXPERT), D_MODEL ** -0.5)
    w3 = nrm(ks[17], (DEPTH, N_EXPERTS, D_MODEL, D_EXPERT), D_MODEL ** -0.5)
    w2 = nrm(ks[18], (DEPTH, N_EXPERTS, D_EXPERT, D_MODEL), D_EXPERT ** -0.5)
    return {"x": x, "positions": positions, "norm1_g": norm1_g, "w_in": w_in,
            "qn_g": qn_g, "kn_g": kn_g, "conv_w": conv_w, "ml_gate_b": ml_gate_b,
            "w_branch": w_branch, "w_out": w_out, "norm2_g": norm2_g,
            "w_rg": w_rg, "b_rg": b_rg, "w_re": w_re, "b_re": b_re,
            "w1": w1, "w3": w3, "w2": w2}


def reference(x, positions, norm1_g, w_in, qn_g, kn_g, conv_w, ml_gate_b, w_branch, w_out,
              norm2_g, w_rg, b_rg, w_re, b_re, w1, w3, w2):
    for l in range(DEPTH):
        x = mixer_block(x, positions, norm1_g[l], w_in[l], qn_g[l], kn_g[l], conv_w[l],
                        ml_gate_b[l], w_branch[l], w_out[l])
        x = hier_moe_block(x, norm2_g[l], w_rg[l], b_rg[l], w_re[l], b_re[l],
                           w1[l], w3[l], w2[l])
    return x
```

```cpp
#include <hip/hip_runtime.h>
#include <stdint.h>
#include <cstdio>

typedef unsigned short bf16;
constexpr int BATCH = 8, SEQ = 2048, DM = 1024, M = BATCH * SEQ, W = 512, PIN = 8200, DEPTH = 2;
constexpr float RMS_EPS = 1e-6f;
constexpr float C2 = 0.18033688011112042f;
constexpr float LOG2E = 1.4426950408889634f;
constexpr size_t MiB = 1u << 20;
constexpr size_t WS_IFPRE = 1 * MiB, WS_KMEAN = WS_IFPRE + 512 * 1024, WS_RE = WS_KMEAN + 128 * 1024, WS_RW = WS_RE + 128 * 1024;
constexpr size_t WS_XN = 4 * MiB, WS_SBQ = 52 * MiB, WS_SBK = 68 * MiB, WS_SBV = 84 * MiB, WS_MBQ = 100 * MiB, WS_MBK = 116 * MiB, WS_MBV = 132 * MiB;
constexpr size_t WS_MLQK = 148 * MiB, WS_MLV = 180 * MiB, WS_MLO = 196 * MiB, WS_GATES = 212 * MiB, WS_END = 308 * MiB;
constexpr size_t WS_MLQ2 = WS_XN, WS_MLK2 = WS_XN + 16 * MiB, WS_MERGED = WS_MLQK, WS_XN2 = WS_XN;

__device__ __forceinline__ float bf2f(bf16 v) { return __uint_as_float((unsigned)v << 16); }
__device__ __forceinline__ bf16 f2bf(float f) { unsigned u = __float_as_uint(f); return (bf16)((u + 0x7fffu + ((u >> 16) & 1u)) >> 16); }
__device__ __forceinline__ float sigmoidf_(float x) { return 1.0f / (1.0f + __expf(-x)); }
__device__ __forceinline__ float wave_sum(float v) {
#pragma unroll
    for (int o = 1; o < 64; o <<= 1) v += __shfl_xor(v, o);
    return v;
}

__global__ __launch_bounds__(512) void k_rmsnorm(const float* __restrict__ x, const float* __restrict__ g, bf16* __restrict__ out) {
    const int lane = threadIdx.x & 63, row = blockIdx.x * 8 + (threadIdx.x >> 6);
    const float4* xr = (const float4*)(x + (size_t)row * DM) + lane;
    float4 v[4]; float s = 0.f;
#pragma unroll
    for (int j = 0; j < 4; ++j) { v[j] = xr[64 * j]; s += v[j].x * v[j].x + v[j].y * v[j].y + v[j].z * v[j].z + v[j].w * v[j].w; }
    const float r = rsqrtf(wave_sum(s) * (1.f / DM) + RMS_EPS);
#pragma unroll
    for (int j = 0; j < 4; ++j) {
        const float4 gg = ((const float4*)g)[lane + 64 * j];
        ushort4 o; o.x = f2bf(v[j].x * r * gg.x); o.y = f2bf(v[j].y * r * gg.y); o.z = f2bf(v[j].z * r * gg.z); o.w = f2bf(v[j].w * r * gg.w);
        ((ushort4*)(out + (size_t)row * DM))[lane + 64 * j] = o;
    }
}

struct EpiInProj {
    bf16 *sbq, *sbk, *sbv, *mbq, *mbk, *mbv, *mlqk, *mlv, *mlo, *gates; float* ifpre; const float* gate_b;
    __device__ __forceinline__ void operator()(int r, int c, float v) const {
        if (c < 512) sbq[(size_t)r * 512 + c] = f2bf(v * C2);
        else if (c < 1024) sbk[(size_t)r * 512 + c - 512] = f2bf(v);
        else if (c < 1536) sbv[(size_t)r * 512 + c - 1024] = f2bf(v);
        else if (c < 2048) mbq[(size_t)r * 512 + c - 1536] = f2bf(v);
        else if (c < 2560) mbk[(size_t)r * 512 + c - 2048] = f2bf(v);
        else if (c < 3072) mbv[(size_t)r * 512 + c - 2560] = f2bf(v);
        else if (c < 4096) mlqk[(size_t)r * 1024 + c - 3072] = f2bf(v);
        else if (c < 4608) mlv[(size_t)r * 512 + c - 4096] = f2bf(v);
        else if (c < 5120) mlo[(size_t)r * 512 + c - 4608] = f2bf(v);
        else if (c < 5128) ifpre[(size_t)r * 8 + c - 5120] = v + gate_b[c - 5120];
        else gates[(size_t)r * 3072 + c - 5128] = f2bf(sigmoidf_(v));
    }
};
struct EpiResid {
    const float* xin; float* out;
    __device__ __forceinline__ void operator()(int r, int c, float v) const { out[(size_t)r * DM + c] = xin[(size_t)r * DM + c] + v; }
};

template <class Epi>
__global__ __launch_bounds__(512) void k_gemm_naive(const bf16* __restrict__ A, int lda, const float* __restrict__ B, int ldb, int N, int K, Epi epi) {
    __shared__ float As[16][132]; __shared__ float Bs[16][132];
    const int tid = threadIdx.x, tx = tid & 15, ty = tid >> 4;
    const int m0 = blockIdx.y * 128, n0 = blockIdx.x * 128;
    float acc[4][8];
#pragma unroll
    for (int i = 0; i < 4; ++i)
#pragma unroll
        for (int j = 0; j < 8; ++j) acc[i][j] = 0.f;
    for (int k0 = 0; k0 < K; k0 += 16) {
        { const int row = tid >> 2, kk = (tid & 3) * 4; const ushort4 v = *(const ushort4*)(A + (size_t)(m0 + row) * lda + k0 + kk);
          As[kk][row] = bf2f(v.x); As[kk + 1][row] = bf2f(v.y); As[kk + 2][row] = bf2f(v.z); As[kk + 3][row] = bf2f(v.w); }
        { const int kk = tid >> 5, n = (tid & 31) * 4;
#pragma unroll
          for (int j = 0; j < 4; ++j) { const int c = n0 + n + j; Bs[kk][n + j] = c < N ? B[(size_t)(k0 + kk) * ldb + c] : 0.f; } }
        __syncthreads();
#pragma unroll
        for (int kk = 0; kk < 16; ++kk) {
            float a[4], b[8];
#pragma unroll
            for (int i = 0; i < 4; ++i) a[i] = As[kk][ty * 4 + i];
#pragma unroll
            for (int j = 0; j < 8; ++j) b[j] = Bs[kk][tx * 8 + j];
#pragma unroll
            for (int i = 0; i < 4; ++i)
#pragma unroll
                for (int j = 0; j < 8; ++j) acc[i][j] += a[i] * b[j];
        }
        __syncthreads();
    }
#pragma unroll
    for (int i = 0; i < 4; ++i)
#pragma unroll
        for (int j = 0; j < 8; ++j) { const int r = m0 + ty * 4 + i, c = n0 + tx * 8 + j; if (c < N) epi(r, c, acc[i][j]); }
}

__global__ __launch_bounds__(512) void k_ymerge_naive(const bf16* __restrict__ A0, const bf16* __restrict__ A1, const bf16* __restrict__ A2, const float* __restrict__ wb,
                                                       const bf16* __restrict__ gates, bf16* __restrict__ merged) {
    __shared__ float As[16][132]; __shared__ float Bs[16][132];
    const int tid = threadIdx.x, tx = tid & 15, ty = tid >> 4;
    const int m0 = blockIdx.y * 128, n0 = blockIdx.x * 128;
    float macc[4][8];
#pragma unroll
    for (int i = 0; i < 4; ++i)
#pragma unroll
        for (int j = 0; j < 8; ++j) macc[i][j] = 0.f;
    for (int n = 0; n < 3; ++n) {
        const bf16* A = n == 0 ? A0 : (n == 1 ? A1 : A2); const float* B = wb + (size_t)n * 512 * 1024;
        float acc[4][8];
#pragma unroll
        for (int i = 0; i < 4; ++i)
#pragma unroll
            for (int j = 0; j < 8; ++j) acc[i][j] = 0.f;
        for (int k0 = 0; k0 < 512; k0 += 16) {
            { const int row = tid >> 2, kk = (tid & 3) * 4; const ushort4 v = *(const ushort4*)(A + (size_t)(m0 + row) * 512 + k0 + kk);
              As[kk][row] = bf2f(v.x); As[kk + 1][row] = bf2f(v.y); As[kk + 2][row] = bf2f(v.z); As[kk + 3][row] = bf2f(v.w); }
            { const int kk = tid >> 5, nn = (tid & 31) * 4;
#pragma unroll
              for (int j = 0; j < 4; ++j) Bs[kk][nn + j] = B[(size_t)(k0 + kk) * 1024 + n0 + nn + j]; }
            __syncthreads();
#pragma unroll
            for (int kk = 0; kk < 16; ++kk) {
                float a[4], b[8];
#pragma unroll
                for (int i = 0; i < 4; ++i) a[i] = As[kk][ty * 4 + i];
#pragma unroll
                for (int j = 0; j < 8; ++j) b[j] = Bs[kk][tx * 8 + j];
#pragma unroll
                for (int i = 0; i < 4; ++i)
#pragma unroll
                    for (int j = 0; j < 8; ++j) acc[i][j] += a[i] * b[j];
            }
            __syncthreads();
        }
#pragma unroll
        for (int i = 0; i < 4; ++i)
#pragma unroll
            for (int j = 0; j < 8; ++j) { const int r = m0 + ty * 4 + i, c = n0 + tx * 8 + j; macc[i][j] += bf2f(gates[(size_t)r * 3072 + n * 1024 + c]) * acc[i][j]; }
    }
#pragma unroll
    for (int i = 0; i < 4; ++i)
#pragma unroll
        for (int j = 0; j < 8; ++j) { const int r = m0 + ty * 4 + i, c = n0 + tx * 8 + j; merged[(size_t)r * DM + c] = f2bf(macc[i][j]); }
}

__device__ __forceinline__ void load64(const bf16* p, float (&x)[64]) {
#pragma unroll
    for (int i = 0; i < 8; ++i) { const uint4 v = ((const uint4*)p)[i];
        x[8 * i + 0] = __uint_as_float(v.x << 16); x[8 * i + 1] = __uint_as_float(v.x & 0xffff0000u);
        x[8 * i + 2] = __uint_as_float(v.y << 16); x[8 * i + 3] = __uint_as_float(v.y & 0xffff0000u);
        x[8 * i + 4] = __uint_as_float(v.z << 16); x[8 * i + 5] = __uint_as_float(v.z & 0xffff0000u);
        x[8 * i + 6] = __uint_as_float(v.w << 16); x[8 * i + 7] = __uint_as_float(v.w & 0xffff0000u); }
}
__device__ __forceinline__ void store64(bf16* p, const float (&x)[64]) {
#pragma unroll
    for (int i = 0; i < 8; ++i) { uint4 v;
        v.x = (unsigned)f2bf(x[8 * i + 0]) | ((unsigned)f2bf(x[8 * i + 1]) << 16); v.y = (unsigned)f2bf(x[8 * i + 2]) | ((unsigned)f2bf(x[8 * i + 3]) << 16);
        v.z = (unsigned)f2bf(x[8 * i + 4]) | ((unsigned)f2bf(x[8 * i + 5]) << 16); v.w = (unsigned)f2bf(x[8 * i + 6]) | ((unsigned)f2bf(x[8 * i + 7]) << 16);
        ((uint4*)p)[i] = v; }
}
__global__ __launch_bounds__(256) void k_prep_qk(bf16* mbq, bf16* mbk, const float* __restrict__ qn_g, const float* __restrict__ kn_g, const int* __restrict__ positions) {
    const int idx = blockIdx.x * 256 + threadIdx.x; const int row = idx >> 4, hh = idx & 15, which = hh >> 3, h = hh & 7;
    bf16* p = (which ? mbk : mbq) + (size_t)row * 512 + h * 64; const float* g = which ? kn_g : qn_g;
    float x[64]; load64(p, x);
    float ss = 0.f;
#pragma unroll
    for (int i = 0; i < 64; ++i) ss += x[i] * x[i];
    const float r = rsqrtf(ss * (1.f / 64.f) + RMS_EPS);
#pragma unroll
    for (int i = 0; i < 64; ++i) x[i] = x[i] * r * g[i];
    const double pos = (double)positions[row];
    const double invf[8] = {1.0, 0.19392274474868576, 0.03760603093086393, 0.007292664737217109, 0.001414213562373095, 0.0002742481756762073, 5.318295896944988e-05, 1.031338537721246e-05};
#pragma unroll
    for (int i = 0; i < 8; ++i) {
        double rev = pos * invf[i] * 0.15915494309189535; rev -= floor(rev);
        const float fr = (float)rev; const float sn = __builtin_amdgcn_sinf(fr), cs = __builtin_amdgcn_cosf(fr);
        const float x1 = x[i], x2 = x[i + 8]; x[i] = x1 * cs - x2 * sn; x[i + 8] = x1 * sn + x2 * cs;
    }
    if (!which) {
#pragma unroll
        for (int i = 0; i < 64; ++i) x[i] *= C2;
    }
    store64(p, x);
}
__global__ __launch_bounds__(256) void k_kmean(const bf16* __restrict__ mbk, float* __restrict__ kmean) {
    const int idx = blockIdx.x * 256 + threadIdx.x; const int d = idx & 63, blk = (idx >> 6) & 7, h = (idx >> 9) & 7, b = idx >> 12;
    float s = 0.f;
    for (int i = 0; i < 256; ++i) s += bf2f(mbk[(size_t)(b * SEQ + blk * 256 + i) * 512 + h * 64 + d]);
    kmean[idx] = s * (1.f / 256.f);
}
__global__ __launch_bounds__(256) void k_conv(const bf16* __restrict__ mlqk, const float* __restrict__ cw, bf16* __restrict__ q2, bf16* __restrict__ k2) {
    const size_t idx = (size_t)blockIdx.x * 256 + threadIdx.x; const int c = (int)(idx & 1023), row = (int)(idx >> 10), t = row & (SEQ - 1);
    float y = 0.f;
#pragma unroll
    for (int j = 0; j < 4; ++j) { const int tt = t - 3 + j; if (tt >= 0) y += cw[j * 1024 + c] * bf2f(mlqk[(size_t)(row - 3 + j) * 1024 + c]); }
    y = y * sigmoidf_(y);
    if (c < 512) q2[(size_t)row * 512 + c] = f2bf(y); else k2[(size_t)row * 512 + c - 512] = f2bf(y * 0.08838834764831845f);
}

__global__ __launch_bounds__(256) void k_sb_naive(bf16* sbq, const bf16* __restrict__ sbk, const bf16* __restrict__ sbv) {
    const int idx = blockIdx.x * 256 + threadIdx.x; const int row = idx >> 3, h = idx & 7, t = row & (SEQ - 1), base = row - t;
    float q[64], acc[64]; load64(sbq + (size_t)row * 512 + h * 64, q);
#pragma unroll
    for (int i = 0; i < 64; ++i) acc[i] = 0.f;
    float C = 0.f;
    for (int s = t - 1; s >= 0; --s) {
        float k[64]; load64(sbk + (size_t)(base + s) * 512 + h * 64, k);
        float z = 0.f;
#pragma unroll
        for (int i = 0; i < 64; ++i) z += q[i] * k[i];
        const float sp = z > 0.f ? z + __log2f(1.f + exp2f(-z)) : __log2f(1.f + exp2f(z));
        C += sp; const float w = exp2f(z - C);
        float v[64]; load64(sbv + (size_t)(base + s) * 512 + h * 64, v);
#pragma unroll
        for (int i = 0; i < 64; ++i) acc[i] += w * v[i];
        if (C > 150.f) break;
    }
    store64(sbq + (size_t)row * 512 + h * 64, acc);
}

__global__ __launch_bounds__(256) void k_moba_naive(bf16* mbq, const bf16* __restrict__ mbk, const bf16* __restrict__ mbv, const float* __restrict__ kmean) {
    const int idx = blockIdx.x * 256 + threadIdx.x; const int row = idx >> 3, h = idx & 7, t = row & (SEQ - 1), base = row - t, b = row >> 11, own = t >> 8;
    float q[64], acc[64]; load64(mbq + (size_t)row * 512 + h * 64, q);
#pragma unroll
    for (int i = 0; i < 64; ++i) acc[i] = 0.f;
    unsigned sel = 0u;
    {
        float g[8];
#pragma unroll
        for (int blk = 0; blk < 8; ++blk) { float s = 0.f; const float* km = kmean + ((size_t)(b * 8 + h) * 8 + blk) * 64;
#pragma unroll
            for (int i = 0; i < 64; ++i) s += q[i] * km[i];
            g[blk] = blk < own ? s : -INFINITY; }
#pragma unroll
        for (int r = 0; r < 3; ++r) { float best = -INFINITY; int bi = -1;
#pragma unroll
            for (int blk = 0; blk < 8; ++blk) { const bool ok = !((sel >> blk) & 1u) && g[blk] > best; if (ok) { best = g[blk]; bi = blk; } }
            if (bi >= 0) sel |= 1u << bi; }
    }
    sel |= 1u << own;
    float m = -INFINITY, l = 0.f;
    for (int blk = 0; blk <= own; ++blk) {
        if (!((sel >> blk) & 1u)) continue;
        const int s1 = blk == own ? t : blk * 256 + 255;
        for (int s = blk * 256; s <= s1; ++s) {
            float k[64]; load64(mbk + (size_t)(base + s) * 512 + h * 64, k);
            float z = 0.f;
#pragma unroll
            for (int i = 0; i < 64; ++i) z += q[i] * k[i];
            const float mn = fmaxf(m, z), sc = exp2f(m - mn), p = exp2f(z - mn);
            float v[64]; load64(mbv + (size_t)(base + s) * 512 + h * 64, v);
            l = l * sc + p;
#pragma unroll
            for (int i = 0; i < 64; ++i) acc[i] = acc[i] * sc + p * v[i];
            m = mn;
        }
    }
    const float il = 1.f / l;
#pragma unroll
    for (int i = 0; i < 64; ++i) acc[i] *= il;
    store64(mbq + (size_t)row * 512 + h * 64, acc);
}

__global__ __launch_bounds__(512) void k_mlstm_naive(const bf16* __restrict__ q2, const bf16* __restrict__ k2, const bf16* __restrict__ mlv, bf16* mlo, const float* __restrict__ ifpre) {
    const int b = blockIdx.x >> 2, h = blockIdx.x & 3, tid = threadIdx.x, e = tid >> 2, dq = tid & 3;
    float Cst[32], nst[32];
#pragma unroll
    for (int j = 0; j < 32; ++j) { Cst[j] = 0.f; nst[j] = 0.f; }
    float m = 0.f;
    for (int t = 0; t < SEQ; ++t) {
        const size_t row = (size_t)b * SEQ + t;
        const float li = ifpre[row * 8 + h], fp = ifpre[row * 8 + 4 + h];
        const float lf = fp >= 0.f ? -log1pf(__expf(-fp)) : fp - log1pf(__expf(fp));
        const float mn = fmaxf(lf + m, li), fd = __expf(lf + m - mn), ii = __expf(li - mn); m = mn;
        const bf16* kp = k2 + row * 512 + h * 128 + dq * 32; const bf16* qp = q2 + row * 512 + h * 128 + dq * 32;
        const float ve = bf2f(mlv[row * 512 + h * 128 + e]) * ii;
        float num = 0.f, den = 0.f;
#pragma unroll
        for (int c4 = 0; c4 < 4; ++c4) {
            const uint4 kv = ((const uint4*)kp)[c4], qv = ((const uint4*)qp)[c4];
            const unsigned ku[4] = {kv.x, kv.y, kv.z, kv.w}, qu[4] = {qv.x, qv.y, qv.z, qv.w};
#pragma unroll
            for (int u = 0; u < 4; ++u) {
                const float k0 = __uint_as_float(ku[u] << 16), k1 = __uint_as_float(ku[u] & 0xffff0000u), q0 = __uint_as_float(qu[u] << 16), q1 = __uint_as_float(qu[u] & 0xffff0000u);
                const int j = c4 * 8 + u * 2;
                Cst[j] = fd * Cst[j] + ve * k0; Cst[j + 1] = fd * Cst[j + 1] + ve * k1;
                nst[j] = fd * nst[j] + ii * k0; nst[j + 1] = fd * nst[j + 1] + ii * k1;
                num += Cst[j] * q0 + Cst[j + 1] * q1; den += nst[j] * q0 + nst[j + 1] * q1;
            }
        }
        num += __shfl_xor(num, 1); num += __shfl_xor(num, 2); den += __shfl_xor(den, 1); den += __shfl_xor(den, 2);
        const float o = num / fmaxf(fabsf(den), __expf(-m));
        if (dq == 0) { bf16* op = mlo + row * 512 + h * 128 + e; *op = f2bf(o * sigmoidf_(bf2f(*op))); }
    }
}

__global__ __launch_bounds__(512) void k_router(const float* __restrict__ hin, const float* __restrict__ g2, const float* __restrict__ w_rg, const float* __restrict__ b_rg,
                                                const float* __restrict__ w_re, const float* __restrict__ b_re, bf16* __restrict__ xn2, int* __restrict__ re, float* __restrict__ rw) {
    const int lane = threadIdx.x & 63, row = blockIdx.x * 8 + (threadIdx.x >> 6);
    const float4* xr = (const float4*)(hin + (size_t)row * DM) + lane;
    float x[16]; float s = 0.f;
#pragma unroll
    for (int j = 0; j < 4; ++j) { const float4 v = xr[64 * j]; x[4 * j] = v.x; x[4 * j + 1] = v.y; x[4 * j + 2] = v.z; x[4 * j + 3] = v.w; s += v.x * v.x + v.y * v.y + v.z * v.z + v.w * v.w; }
    const float r = rsqrtf(wave_sum(s) * (1.f / DM) + RMS_EPS);
#pragma unroll
    for (int j = 0; j < 4; ++j) { const float4 gg = ((const float4*)g2)[lane + 64 * j]; x[4 * j] *= r * gg.x; x[4 * j + 1] *= r * gg.y; x[4 * j + 2] *= r * gg.z; x[4 * j + 3] *= r * gg.w;
        ushort4 o; o.x = f2bf(x[4 * j]); o.y = f2bf(x[4 * j + 1]); o.z = f2bf(x[4 * j + 2]); o.w = f2bf(x[4 * j + 3]);
        ((ushort4*)(xn2 + (size_t)row * DM))[lane + 64 * j] = o; }
    float lg[36];
#pragma unroll
    for (int o = 0; o < 36; ++o) lg[o] = 0.f;
#pragma unroll
    for (int j = 0; j < 4; ++j)
#pragma unroll
        for (int u = 0; u < 4; ++u) { const int d = (lane + 64 * j) * 4 + u; const float xv = x[4 * j + u];
            const float4 wg = *(const float4*)(w_rg + (size_t)d * 4); lg[0] += xv * wg.x; lg[1] += xv * wg.y; lg[2] += xv * wg.z; lg[3] += xv * wg.w;
#pragma unroll
            for (int o4 = 0; o4 < 8; ++o4) { const float4 we = *(const float4*)(w_re + (size_t)d * 32 + o4 * 4);
                lg[4 + o4 * 4] += xv * we.x; lg[5 + o4 * 4] += xv * we.y; lg[6 + o4 * 4] += xv * we.z; lg[7 + o4 * 4] += xv * we.w; } }
#pragma unroll
    for (int o = 0; o < 36; ++o) lg[o] = wave_sum(lg[o]);
    float gl[4]; float gm = -INFINITY; int gi = 0;
#pragma unroll
    for (int i = 0; i < 4; ++i) { gl[i] = lg[i] + b_rg[i]; if (gl[i] > gm) { gm = gl[i]; gi = i; } }
    float gs = 0.f;
#pragma unroll
    for (int i = 0; i < 4; ++i) gs += __expf(gl[i] - gm);
    const float gw = 1.f / gs;
    float el[8];
#pragma unroll
    for (int j = 0; j < 8; ++j) { const float a0 = lg[4 + j] + b_re[j], a1 = lg[12 + j] + b_re[8 + j], a2 = lg[20 + j] + b_re[16 + j], a3 = lg[28 + j] + b_re[24 + j];
        el[j] = gi == 0 ? a0 : (gi == 1 ? a1 : (gi == 2 ? a2 : a3)); }
    float m1 = -INFINITY; int i1 = 0;
#pragma unroll
    for (int j = 0; j < 8; ++j) if (el[j] > m1) { m1 = el[j]; i1 = j; }
    float m2 = -INFINITY; int i2 = 0;
#pragma unroll
    for (int j = 0; j < 8; ++j) if (j != i1 && el[j] > m2) { m2 = el[j]; i2 = j; }
    const float p2 = __expf(m2 - m1);
    const float w1 = gw / (1.f + p2), w2 = gw * p2 / (1.f + p2);
    if (lane == 0) { re[row * 2] = gi * 8 + i1; re[row * 2 + 1] = gi * 8 + i2; rw[row * 2] = w1; rw[row * 2 + 1] = w2; }
}

__global__ __launch_bounds__(512) void k_moe_naive(const bf16* __restrict__ xn2, const int* __restrict__ re, const float* __restrict__ rw, const float* __restrict__ w1, const float* __restrict__ w3,
                                                   const float* __restrict__ w2, float* out) {
    __shared__ float xs[1024]; __shared__ float tmp[2][256]; __shared__ float hid[2][256];
    const int row = blockIdx.x, tid = threadIdx.x;
    xs[tid] = bf2f(xn2[(size_t)row * DM + tid]); xs[tid + 512] = bf2f(xn2[(size_t)row * DM + tid + 512]);
    __syncthreads();
    const int f = tid & 255, which = tid >> 8;
    for (int k = 0; k < 2; ++k) {
        const int e = re[row * 2 + k]; const float wgt = rw[row * 2 + k];
        const float* wp = (which ? w3 : w1) + (size_t)e * 1024 * 256 + f;
        float s = 0.f;
        for (int d = 0; d < 1024; ++d) s += xs[d] * wp[(size_t)d * 256];
        tmp[which][f] = s;
        __syncthreads();
        if (which == 0) { const float a = tmp[0][f]; hid[k][f] = a * sigmoidf_(a) * tmp[1][f] * wgt; }
        __syncthreads();
    }
    const int e0 = re[row * 2], e1 = re[row * 2 + 1];
    for (int c = tid; c < 1024; c += 512) {
        float y = 0.f;
        const float* p0 = w2 + (size_t)e0 * 256 * 1024 + c; const float* p1 = w2 + (size_t)e1 * 256 * 1024 + c;
        for (int ff = 0; ff < 256; ++ff) y += hid[0][ff] * p0[(size_t)ff * 1024] + hid[1][ff] * p1[(size_t)ff * 1024];
        out[(size_t)row * DM + c] += y;
    }
}

extern "C" void kernel_launch(void* const* d_in, const int* in_sizes, int n_in, void* d_out, int out_size, void* d_ws, size_t ws_size, hipStream_t stream) {
    if (n_in != 18 || out_size != M * DM || ws_size < WS_END) { fprintf(stderr, "kernel_launch: unexpected shapes (n_in %d out %d ws %zu)\n", n_in, out_size, ws_size); return; }
    const float* x = (const float*)d_in[0]; const int* positions = (const int*)d_in[1];
    const float *norm1_g = (const float*)d_in[2], *w_in = (const float*)d_in[3], *qn_g = (const float*)d_in[4], *kn_g = (const float*)d_in[5], *conv_w = (const float*)d_in[6],
                *ml_gate_b = (const float*)d_in[7], *w_branch = (const float*)d_in[8], *w_out = (const float*)d_in[9], *norm2_g = (const float*)d_in[10], *w_rg = (const float*)d_in[11],
                *b_rg = (const float*)d_in[12], *w_re = (const float*)d_in[13], *b_re = (const float*)d_in[14], *w1 = (const float*)d_in[15], *w3 = (const float*)d_in[16], *w2 = (const float*)d_in[17];
    unsigned char* ws = (unsigned char*)d_ws; float* out = (float*)d_out;
    bf16 *XN = (bf16*)(ws + WS_XN), *SBQ = (bf16*)(ws + WS_SBQ), *SBK = (bf16*)(ws + WS_SBK), *SBV = (bf16*)(ws + WS_SBV), *MBQ = (bf16*)(ws + WS_MBQ), *MBK = (bf16*)(ws + WS_MBK),
         *MBV = (bf16*)(ws + WS_MBV), *MLQK = (bf16*)(ws + WS_MLQK), *MLV = (bf16*)(ws + WS_MLV), *MLO = (bf16*)(ws + WS_MLO), *GATES = (bf16*)(ws + WS_GATES), *MLQ2 = (bf16*)(ws + WS_MLQ2),
         *MLK2 = (bf16*)(ws + WS_MLK2), *MERGED = (bf16*)(ws + WS_MERGED), *XN2 = (bf16*)(ws + WS_XN2);
    float *IFPRE = (float*)(ws + WS_IFPRE), *KMEAN = (float*)(ws + WS_KMEAN), *RW = (float*)(ws + WS_RW); int* RE = (int*)(ws + WS_RE);
    for (int l = 0; l < DEPTH; ++l) {
        const float* xin = l == 0 ? x : out;
        k_rmsnorm<<<M / 8, 512, 0, stream>>>(xin, norm1_g + l * DM, XN);
        EpiInProj e1{SBQ, SBK, SBV, MBQ, MBK, MBV, MLQK, MLV, MLO, GATES, IFPRE, ml_gate_b + l * 8};
        k_gemm_naive<EpiInProj><<<dim3((PIN + 127) / 128, M / 128), 512, 0, stream>>>(XN, DM, w_in + (size_t)l * DM * PIN, PIN, PIN, DM, e1);
        k_prep_qk<<<M * 16 / 256, 256, 0, stream>>>(MBQ, MBK, qn_g + l * 64, kn_g + l * 64, positions);
        k_kmean<<<8 * 8 * 8 * 64 / 256, 256, 0, stream>>>(MBK, KMEAN);
        k_conv<<<M * 1024 / 256, 256, 0, stream>>>(MLQK, conv_w + l * 4 * 1024, MLQ2, MLK2);
        k_sb_naive<<<M * 8 / 256, 256, 0, stream>>>(SBQ, SBK, SBV);
        k_moba_naive<<<M * 8 / 256, 256, 0, stream>>>(MBQ, MBK, MBV, KMEAN);
        k_mlstm_naive<<<32, 512, 0, stream>>>(MLQ2, MLK2, MLV, MLO, IFPRE);
        k_ymerge_naive<<<dim3(DM / 128, M / 128), 512, 0, stream>>>(SBQ, MBQ, MLO, w_branch + (size_t)l * 3 * 512 * 1024, GATES, MERGED);
        EpiResid e2{xin, out};
        k_gemm_naive<EpiResid><<<dim3(DM / 128, M / 128), 512, 0, stream>>>(MERGED, DM, w_out + (size_t)l * DM * DM, DM, DM, DM, e2);
        k_router<<<M / 8, 512, 0, stream>>>(out, norm2_g + l * DM, w_rg + (size_t)l * DM * 4, b_rg + l * 4, w_re + (size_t)l * DM * 32, b_re + l * 32, XN2, RE, RW);
        k_moe_naive<<<M, 512, 0, stream>>>(XN2, RE, RW, w1 + (size_t)l * 32 * 1024 * 256, w3 + (size_t)l * 32 * 1024 * 256, w2 + (size_t)l * 32 * 256 * 1024, out);
    }
}
```

```cpp
#include <hip/hip_runtime.h>
#include <stdint.h>
#include <cstdio>
#include <cmath>

constexpr int BATCH = 8, SEQ = 2048, DM = 1024, M = BATCH * SEQ, W = 512, PIN = 8200, DEPTH = 2;
constexpr float RMS_EPS = 1e-6f;
constexpr float C2 = 0.18033688011112042f;
constexpr size_t MiB = 1u << 20;
constexpr size_t WS_CTL = 0, CTL_ZERO_BYTES = 1 * MiB;
constexpr size_t WS_IFPRE = 1 * MiB, WS_KMEAN = WS_IFPRE + 512 * 1024, WS_RE = WS_KMEAN + 128 * 1024, WS_RW = WS_RE + 128 * 1024;
constexpr size_t WS_XN = 4 * MiB, WS_WTIN = 36 * MiB;
constexpr size_t WS_SBQ = 52 * MiB, WS_SBK = 68 * MiB, WS_SBV = 84 * MiB, WS_MBQ = 100 * MiB, WS_MBK = 116 * MiB, WS_MBV = 132 * MiB;
constexpr size_t WS_MLO = 148 * MiB, WS_MLV = 164 * MiB, WS_MLQK = 180 * MiB, WS_GATES = 212 * MiB;
constexpr size_t WS_WTBR = 308 * MiB, WS_WTOUT = 311 * MiB, WS_END = 313 * MiB;
constexpr size_t WS_MLQ2 = WS_XN, WS_MLK2 = WS_XN + 16 * MiB, WS_MERGED = WS_MLQK, WS_XN2 = WS_XN;
constexpr size_t WS_WT13 = 52 * MiB, WS_WT2 = 84 * MiB;
namespace pg8 {
#define PG8_LAS __attribute__((address_space(3)))
typedef unsigned short bf16_t;
typedef short bf16x8 __attribute__((ext_vector_type(8)));
typedef float f32x4 __attribute__((ext_vector_type(4)));
typedef unsigned u32x4 __attribute__((ext_vector_type(4)));
constexpr int BM = 256, BK = 64, HALF = 128, HTB = HALF * BK * 2  , STAGE_BYTES = 8 * HTB, NXCD = 8, WGM = 8;

__host__ __device__ __forceinline__ int lds_byte(int r, int c) { const int st = (r >> 4) * 2 + (c >> 5), rr = r & 15, cc = c & 31, ob = rr * 64 + cc * 2; return st * 1024 + (ob ^ (((ob >> 9) & 1) << 5)); }
__host__ __device__ __forceinline__ void stage_rc(int b, int& R, int& C) { const int st = b / 1024, sb = b % 1024, swz = sb ^ (((sb >> 9) & 1) << 5); R = (st >> 1) * 16 + swz / 64; C = (st & 1) * 32 + (swz % 64) / 2; }
__host__ __device__ __forceinline__ int perm32(int rho) { const int n = rho >> 4, i = rho & 15; return 8 * (i >> 2) + 4 * n + (i & 3); }

struct Unit { int pm, pn; };
struct Gemm { const bf16_t* A; const bf16_t* Bt; int M, N, K; };

struct StaticOrder {
    int nM, nN, nwg, G, c;
    __host__ __device__ void init(int M, int N, int G_, int c_) { nM = M / BM; nN = N / BM; nwg = nM * nN; G = G_; c = c_; }
    __host__ __device__ bool next(int i, Unit& u) const {
        const long L = (long)i * G + c; if (L >= nwg) return false;
        int wgid = (int)L; { const int q = nwg / NXCD, r = nwg % NXCD, xcd = wgid % NXCD, off = wgid / NXCD; wgid = (xcd < r ? xcd * (q + 1) : r * (q + 1) + (xcd - r) * q) + off; }
        const int nig = WGM * nN, gid = wgid / nig, fm = gid * WGM, gsz = (nM - fm) < WGM ? (nM - fm) : WGM;
        u.pm = fm + ((wgid % nig) % gsz); u.pn = (wgid % nig) / gsz; return true;
    }
    __device__ __forceinline__ void a_ready(const Unit&) const {}
    __device__ __forceinline__ void done(const Unit&) const {}
};

__device__ __forceinline__ unsigned cvt_pk_bf16(float lo, float hi) { unsigned r; asm volatile("v_cvt_pk_bf16_f32 %0, %1, %2" : "=v"(r) : "v"(lo), "v"(hi)); return r; }
typedef float f32x2 __attribute__((ext_vector_type(2)));
__device__ __forceinline__ float fast_sigmoid(float x) { return __builtin_amdgcn_rcpf(1.0f + __expf(-x)); }
struct EpiInProj {
    static constexpr bool PERM = true, AFTER_DRAIN = false;
    unsigned char* ws;
    __device__ __forceinline__ void operator()(const f32x4 (&acc)[2][2][4][2], const Unit& u, int wr, int wc, int fr, int fq) const {
        const int pn = u.pn; bf16_t* base; int ldc, colt; float sc = 1.f; bool sig = false;
        if (pn < 12) { base = (bf16_t*)(ws + WS_SBQ) + (size_t)(pn >> 1) * (8u << 20); ldc = 512; colt = (pn & 1) * 256; if (pn < 2) sc = C2; }
        else if (pn < 14) { base = (bf16_t*)(ws + WS_MLO); ldc = 512; colt = (pn & 1) * 256; }
        else if (pn < 16) { base = (bf16_t*)(ws + WS_MLV); ldc = 512; colt = (pn & 1) * 256; }
        else if (pn < 20) { base = (bf16_t*)(ws + WS_MLQK); ldc = 1024; colt = (pn - 16) * 256; }
        else { base = (bf16_t*)(ws + WS_GATES); ldc = 3072; colt = (pn - 20) * 256; sig = true; }
        const int row0 = u.pm * BM + wr * 64 + fr, col0 = colt + wc * 32 + 8 * fq;
#pragma unroll
        for (int ai = 0; ai < 2; ++ai)
#pragma unroll
            for (int m = 0; m < 4; ++m) { bf16_t* rowp = base + (size_t)(row0 + ai * HALF + m * 16) * ldc + col0;
#pragma unroll
                for (int bj = 0; bj < 2; ++bj) { f32x4 v0 = acc[ai][bj][m][0], v1 = acc[ai][bj][m][1];
                    if (sig) { v0 = (f32x4){fast_sigmoid(v0[0]), fast_sigmoid(v0[1]), fast_sigmoid(v0[2]), fast_sigmoid(v0[3])}; v1 = (f32x4){fast_sigmoid(v1[0]), fast_sigmoid(v1[1]), fast_sigmoid(v1[2]), fast_sigmoid(v1[3])}; }
                    else { v0 = v0 * sc; v1 = v1 * sc; }
                    u32x4 w; w.x = cvt_pk_bf16(v0[0], v0[1]); w.y = cvt_pk_bf16(v0[2], v0[3]); w.z = cvt_pk_bf16(v1[0], v1[1]); w.w = cvt_pk_bf16(v1[2], v1[3]);
                    *(u32x4*)(rowp + bj * HALF) = w; } }
    }
};
template <class Epi, class Sched, bool ALIGN_EPI = false, bool SP2 = false>
__device__ __forceinline__ void gemm_phase(PG8_LAS unsigned char* lds, const Gemm g, const Sched& S, const Epi& E) {
    const int tid = threadIdx.x, wid = __builtin_amdgcn_readfirstlane(tid >> 6), lane = tid & 63, wr = wid >> 2, wc = wid & 3, fr = lane & 15, fq = lane >> 4;
    const int K = g.K, nt = K / BK;
    unsigned voffA[2], voffB[2];
#pragma unroll
    for (int i = 0; i < 2; ++i) { int R, C; stage_rc(tid * 16 + i * 8192, R, C); const int Rb = Epi::PERM ? ((R & ~31) + perm32(R & 31)) : R;
        voffA[i] = (unsigned)(R * K + C) * 2u; voffB[i] = (unsigned)(Rb * K + C) * 2u; }
    const size_t kstep = (size_t)(BK * 2);
    const size_t hstep = (size_t)HALF * K * 2;
    const size_t tstep = 2 * hstep;
    const unsigned ldsw = (unsigned)wid * 1024u;
    const int aoff = lds_byte(wr * 64 + fr, fq * 8), boff = lds_byte(wc * 32 + fr, fq * 8);
#define PG8_SA(b, h) (((b) * 2 + (h)) * HTB)
#define PG8_SB(b, h) ((4 + (b) * 2 + (h)) * HTB)
#define PG8_STAGE(bufoff, gbase, voff) do { _Pragma("unroll") for (int _i = 0; _i < 2; ++_i) \
        __builtin_amdgcn_global_load_lds((const unsigned*)((const char*)(gbase) + (voff)[_i]), (PG8_LAS unsigned*)(lds + (bufoff) + ldsw + _i * 8192), 16, 0, 0); } while (0)
#define PG8_LDA(dst, b, h) do { _Pragma("unroll") for (int m = 0; m < 4; ++m) _Pragma("unroll") for (int k = 0; k < 2; ++k) dst[m][k] = *(const PG8_LAS bf16x8*)(lds + PG8_SA(b, h) + aoff + m * 2048 + k * 1024); } while (0)
#define PG8_LDB(dst, b, h) do { _Pragma("unroll") for (int n = 0; n < 2; ++n) _Pragma("unroll") for (int k = 0; k < 2; ++k) dst[n][k] = *(const PG8_LAS bf16x8*)(lds + PG8_SB(b, h) + boff + n * 2048 + k * 1024); } while (0)
#define PG8_MMA(ai, bj, At, Bt) do { __builtin_amdgcn_s_setprio(1); _Pragma("unroll") for (int m = 0; m < 4; ++m) _Pragma("unroll") for (int n = 0; n < 2; ++n) _Pragma("unroll") for (int k = 0; k < 2; ++k) \
        acc[ai][bj][m][n] = __builtin_amdgcn_mfma_f32_16x16x32_bf16(Bt[n][k], At[m][k], acc[ai][bj][m][n], 0, 0, 0); __builtin_amdgcn_s_setprio(0); } while (0)
#define PG8_WAIT_V(n) asm volatile("s_waitcnt vmcnt(" #n ")" ::: "memory")
#define PG8_WAIT_L(n) asm volatile("s_waitcnt lgkmcnt(" #n ")" ::: "memory")
#define PG8_BAR __builtin_amdgcn_s_barrier()
#define PG8_SCHED __builtin_amdgcn_sched_barrier(0)
    Unit cur, nxt; int ui = 0;
    if (!S.next(0, cur)) return;
    f32x4 acc[2][2][4][2];
#pragma unroll
    for (int a = 0; a < 2; ++a)
#pragma unroll
        for (int b = 0; b < 2; ++b)
#pragma unroll
            for (int m = 0; m < 4; ++m)
#pragma unroll
                for (int n = 0; n < 2; ++n) acc[a][b][m][n] = (f32x4){0.f, 0.f, 0.f, 0.f};
    bf16x8 At[4][2], B0[2][2], B1[2][2];
    const char* cA = (const char*)g.A + (size_t)cur.pm * tstep; const char* cB = (const char*)g.Bt + (size_t)cur.pn * tstep;
    S.a_ready(cur);
    if constexpr (SP2) {
        PG8_STAGE(PG8_SB(0, 0), cB, voffB); PG8_STAGE(PG8_SB(0, 1), cB + hstep, voffB); PG8_STAGE(PG8_SA(0, 0), cA, voffA); PG8_STAGE(PG8_SA(0, 1), cA + hstep, voffA);
        if (wr == 1) PG8_BAR;
        PG8_WAIT_V(2); PG8_BAR;
        PG8_STAGE(PG8_SB(1, 0), cB + kstep, voffB); PG8_STAGE(PG8_SA(1, 0), cA + kstep, voffA); PG8_STAGE(PG8_SB(1, 1), cB + hstep + kstep, voffB);
        PG8_WAIT_V(6); PG8_BAR;
    } else {
        PG8_STAGE(PG8_SB(0, 0), cB, voffB); PG8_STAGE(PG8_SA(0, 0), cA, voffA); PG8_STAGE(PG8_SB(0, 1), cB + hstep, voffB); PG8_STAGE(PG8_SA(0, 1), cA + hstep, voffA);
        if (wr == 1) PG8_BAR;
        PG8_WAIT_V(4); PG8_BAR;
        PG8_STAGE(PG8_SB(1, 0), cB + kstep, voffB); PG8_STAGE(PG8_SA(1, 0), cA + kstep, voffA); PG8_STAGE(PG8_SB(1, 1), cB + hstep + kstep, voffB);
        PG8_WAIT_V(6); PG8_BAR;
    }
    for (;;) {
        const bool has_next = S.next(ui + 1, nxt);
        const char* nA = has_next ? (const char*)g.A + (size_t)nxt.pm * tstep : cA; const char* nB = has_next ? (const char*)g.Bt + (size_t)nxt.pn * tstep : cB;
        for (int t = 0; t < nt; t += 2) {
            const bool last = (t == nt - 2);
            const char* a1 = cA + (size_t)(t + 1) * kstep;
            const char* a2 = last ? nA : cA + (size_t)(t + 2) * kstep; const char* b2 = last ? nB : cB + (size_t)(t + 2) * kstep;
            const char* a3 = a2 + kstep; const char* b3 = b2 + kstep;
            if (last && has_next) S.a_ready(nxt);
            if constexpr (SP2) {
            PG8_LDB(B0, 0, 0); PG8_LDB(B1, 0, 1); PG8_SCHED; PG8_LDA(At, 0, 0); PG8_STAGE(PG8_SA(1, 1), a1 + hstep, voffA);
            PG8_WAIT_V(8); PG8_WAIT_L(0); PG8_BAR; PG8_MMA(0, 0, At, B0); PG8_MMA(0, 1, At, B1); PG8_BAR; PG8_SCHED;
            PG8_LDA(At, 0, 1); PG8_STAGE(PG8_SB(0, 0), b2, voffB); PG8_STAGE(PG8_SB(0, 1), b2 + hstep, voffB); PG8_STAGE(PG8_SA(0, 0), a2, voffA);
            PG8_WAIT_V(8); PG8_WAIT_L(0); PG8_BAR; PG8_MMA(1, 0, At, B0); PG8_MMA(1, 1, At, B1); PG8_BAR; PG8_SCHED;
            PG8_LDB(B0, 1, 0); PG8_LDB(B1, 1, 1); PG8_SCHED; PG8_LDA(At, 1, 0); PG8_STAGE(PG8_SA(0, 1), a2 + hstep, voffA);
            PG8_WAIT_V(8); PG8_WAIT_L(0); PG8_BAR; PG8_MMA(0, 0, At, B0); PG8_MMA(0, 1, At, B1); PG8_BAR; PG8_SCHED;
            PG8_LDA(At, 1, 1); PG8_STAGE(PG8_SB(1, 0), b3, voffB); PG8_STAGE(PG8_SB(1, 1), b3 + hstep, voffB); PG8_STAGE(PG8_SA(1, 0), a3, voffA);
            PG8_WAIT_V(8); PG8_WAIT_L(0); PG8_BAR; PG8_MMA(1, 0, At, B0); PG8_MMA(1, 1, At, B1); PG8_BAR; PG8_SCHED;
            } else {
            PG8_LDB(B0, 0, 0); PG8_SCHED; PG8_LDA(At, 0, 0); PG8_STAGE(PG8_SA(1, 1), a1 + hstep, voffA);
            PG8_WAIT_L(8); PG8_BAR; PG8_WAIT_L(0); PG8_MMA(0, 0, At, B0); PG8_BAR; PG8_SCHED;
            PG8_LDB(B1, 0, 1); PG8_STAGE(PG8_SB(0, 0), b2, voffB);
            PG8_BAR; PG8_WAIT_L(0); PG8_MMA(0, 1, At, B1); PG8_BAR;
            PG8_LDA(At, 0, 1); PG8_STAGE(PG8_SA(0, 0), a2, voffA);
            PG8_BAR; PG8_WAIT_L(0); PG8_MMA(1, 0, At, B0); PG8_BAR; PG8_SCHED;
            PG8_STAGE(PG8_SB(0, 1), b2 + hstep, voffB);
            PG8_WAIT_V(6); PG8_BAR; PG8_MMA(1, 1, At, B1); PG8_BAR;
            PG8_LDB(B0, 1, 0); PG8_SCHED; PG8_LDA(At, 1, 0); PG8_STAGE(PG8_SA(0, 1), a2 + hstep, voffA);
            PG8_WAIT_L(8); PG8_BAR; PG8_WAIT_L(0); PG8_MMA(0, 0, At, B0); PG8_BAR; PG8_SCHED;
            PG8_LDB(B1, 1, 1); PG8_STAGE(PG8_SB(1, 0), b3, voffB);
            PG8_BAR; PG8_WAIT_L(0); PG8_MMA(0, 1, At, B1); PG8_BAR;
            PG8_LDA(At, 1, 1); PG8_STAGE(PG8_SA(1, 0), a3, voffA);
            PG8_BAR; PG8_WAIT_L(0); PG8_MMA(1, 0, At, B0); PG8_BAR; PG8_SCHED;
            PG8_STAGE(PG8_SB(1, 1), b3 + hstep, voffB);
            PG8_WAIT_V(6); PG8_BAR; PG8_MMA(1, 1, At, B1); PG8_BAR;
            }
        }
        if constexpr (ALIGN_EPI) { if (wr == 0) PG8_BAR; }
        if constexpr (!Epi::AFTER_DRAIN) { E(acc, cur, wr, wc, fr, fq); S.done(cur); }
        if (!has_next) break;
#pragma unroll
        for (int a = 0; a < 2; ++a)
#pragma unroll
            for (int b = 0; b < 2; ++b)
#pragma unroll
                for (int m = 0; m < 4; ++m)
#pragma unroll
                    for (int n = 0; n < 2; ++n) acc[a][b][m][n] = (f32x4){0.f, 0.f, 0.f, 0.f};
        cur = nxt; cA = nA; cB = nB; ++ui;
        if constexpr (ALIGN_EPI) { if (wr == 1) PG8_BAR; }
    }
    PG8_WAIT_V(0);
    if constexpr (!ALIGN_EPI) { if (wr == 0) PG8_BAR; }
    PG8_BAR;
    if constexpr (Epi::AFTER_DRAIN) { E.fused(acc, cur, wr, wc, fr, fq, lds, wid, lane); S.done(cur); }
#undef PG8_SA
#undef PG8_SB
#undef PG8_STAGE
#undef PG8_LDA
#undef PG8_LDB
#undef PG8_MMA
#undef PG8_WAIT_V
#undef PG8_WAIT_L
#undef PG8_BAR
#undef PG8_SCHED
}
}

#ifndef PG8_SP2
#define PG8_SP2 true
#endif
#ifndef PG8_ALIGN
#define PG8_ALIGN true
#endif
#define GAS __attribute__((address_space(1)))
#define LAS __attribute__((address_space(3)))
typedef unsigned short bf16;
typedef unsigned v4u __attribute__((ext_vector_type(4)));
typedef float f32x4 __attribute__((ext_vector_type(4)));
typedef short bf16x8 __attribute__((ext_vector_type(8)));
typedef GAS unsigned gu32;
typedef GAS unsigned long long gu64;
#define RLX_AGENT __ATOMIC_RELAXED, __HIP_MEMORY_SCOPE_AGENT
#define LDS_WAIT() asm volatile("s_waitcnt lgkmcnt(0)" ::: "memory")
#define VM_WAIT() asm volatile("s_waitcnt vmcnt(0)" ::: "memory")
__device__ __forceinline__ unsigned long long rt() { return __builtin_amdgcn_s_memrealtime(); }
__device__ __forceinline__ unsigned f2bf(float f) { unsigned u = __builtin_bit_cast(unsigned, f); return (u + 0x7fffu + ((u >> 16) & 1u)) >> 16; }
__device__ __forceinline__ unsigned pk2(float lo, float hi) { return f2bf(lo) | (f2bf(hi) << 16); }

#define XB_TMO      128
#define XB_XCNT(j)  (256  + 64 * (j))
#define XB_XSUB(j)  (1280 + 64 * (j))
#define XB_XGEN(j)  (2304 + 64 * (j))
#define XB_TOP      3328
#define XB_TOPGEN   3392
#define XCD_BAR_WORDS 3456
#define XB_SPIN_CAP (1u << 18)

__device__ __forceinline__ unsigned xb_ld(unsigned* p)              { return __hip_atomic_load(p, __ATOMIC_RELAXED, __HIP_MEMORY_SCOPE_AGENT); }
__device__ __forceinline__ unsigned xb_add(unsigned* p, unsigned v) { return __hip_atomic_fetch_add(p, v, __ATOMIC_RELAXED, __HIP_MEMORY_SCOPE_AGENT); }
__device__ __forceinline__ unsigned xb_xcc_id() { return (unsigned)__builtin_amdgcn_s_getreg((3 << 11) | 20) & 0xFu; }
#define XB_SPIN(cond, bar) do { unsigned _sp = 0; while (cond) { __builtin_amdgcn_s_sleep(1); \
    if ((++_sp & 255u) == 0u) { if (xb_ld(&(bar)[XB_TMO])) break; if (_sp > XB_SPIN_CAP) { atomicAdd(&(bar)[XB_TMO], 1u); break; } } } } while (0)

struct XcdBarrier {
    unsigned* bar; unsigned x;
    volatile LAS unsigned* st;
};

__device__ __forceinline__ XcdBarrier xcd_barrier_post(unsigned* bar, volatile LAS unsigned* st) {
    XcdBarrier b; b.bar = bar; b.x = xb_xcc_id(); b.st = st;
    if (threadIdx.x == 0) (void)xb_add(&bar[XB_XCNT(b.x)], 1u);
    return b;
}
__device__ __forceinline__ void xcd_barrier_complete(unsigned* bar, unsigned x, unsigned& nloc, unsigned& nx) {
    const unsigned G = gridDim.x * gridDim.y * gridDim.z;
    unsigned sum, cnt, mine, sp = 0u;
    for (;;) {
        sum = 0u; cnt = 0u; mine = 0u;
#pragma unroll
        for (unsigned j = 0; j < 16; ++j) { const unsigned c = xb_ld(&bar[XB_XCNT(j)]); sum += c; cnt += (c > 0u) ? 1u : 0u; mine = (j == x) ? c : mine; }
        if (sum == G) break;
        __builtin_amdgcn_s_sleep(1);
        if ((++sp & 255u) == 0u) { if (xb_ld(&bar[XB_TMO])) break; if (sp > XB_SPIN_CAP) { atomicAdd(&bar[XB_TMO], 1u); break; } }
    }
    nloc = mine > 0u ? mine : 1u; nx = cnt > 0u ? cnt : 1u;
}

__device__ __forceinline__ void xcd_barrier(const XcdBarrier& b) {
    asm volatile("s_waitcnt vmcnt(0)" ::: "memory");
    __syncthreads();
    if (threadIdx.x == 0) {
        unsigned* bar = b.bar;
        __builtin_amdgcn_s_waitcnt(0);
        unsigned nloc = b.st[0], nx = b.st[1];
        if (nloc == 0u) { xcd_barrier_complete(bar, b.x, nloc, nx); b.st[0] = nloc; b.st[1] = nx; }
        const unsigned old = xb_add(&bar[XB_XSUB(b.x)], 1u);
        const unsigned gen = old / nloc;
        if (old + 1u == (gen + 1u) * nloc) {
            __builtin_amdgcn_fence(__ATOMIC_RELEASE, "agent");
            asm volatile("s_waitcnt vmcnt(0)" ::: "memory");
            const unsigned og = xb_add(&bar[XB_TOP], 1u);
            const unsigned tg = og / nx;
            if (og + 1u == (tg + 1u) * nx) xb_add(&bar[XB_TOPGEN], 1u);
            else XB_SPIN(xb_ld(&bar[XB_TOPGEN]) == tg, bar);
            __builtin_amdgcn_fence(__ATOMIC_ACQUIRE, "agent");
            xb_add(&bar[XB_XGEN(b.x)], 1u);
            asm volatile("s_waitcnt vmcnt(0)" ::: "memory");
        } else {
            XB_SPIN(xb_ld(&bar[XB_XGEN(b.x)]) == gen, bar);
            __builtin_amdgcn_fence(__ATOMIC_ACQUIRE, "agent");
            asm volatile("s_waitcnt vmcnt(0)" ::: "memory");
        }
    }
    __syncthreads();
}
__device__ __forceinline__ float bf2f(bf16 v) { return __uint_as_float((unsigned)v << 16); }
__device__ __forceinline__ float sigmoidf_(float x) { return 1.0f / (1.0f + __expf(-x)); }
__device__ __forceinline__ float wave_sum(float v) {
#pragma unroll
    for (int o = 1; o < 64; o <<= 1) v += __shfl_xor(v, o);
    return v;
}

struct EpiResid {
    const float* xin; float* out;
    __device__ __forceinline__ void operator()(int r, int c, float v) const { out[(size_t)r * DM + c] = xin[(size_t)r * DM + c] + v; }
};

template <class Epi>
__global__ __launch_bounds__(512) void k_gemm_naive(const bf16* __restrict__ A, int lda, const float* __restrict__ B, int ldb, int N, int K, Epi epi) {
    __shared__ float As[16][132]; __shared__ float Bs[16][132];
    const int tid = threadIdx.x, tx = tid & 15, ty = tid >> 4;
    const int m0 = blockIdx.y * 128, n0 = blockIdx.x * 128;
    float acc[4][8];
#pragma unroll
    for (int i = 0; i < 4; ++i)
#pragma unroll
        for (int j = 0; j < 8; ++j) acc[i][j] = 0.f;
    for (int k0 = 0; k0 < K; k0 += 16) {
        { const int row = tid >> 2, kk = (tid & 3) * 4; const ushort4 v = *(const ushort4*)(A + (size_t)(m0 + row) * lda + k0 + kk);
          As[kk][row] = bf2f(v.x); As[kk + 1][row] = bf2f(v.y); As[kk + 2][row] = bf2f(v.z); As[kk + 3][row] = bf2f(v.w); }
        { const int kk = tid >> 5, n = (tid & 31) * 4;
#pragma unroll
          for (int j = 0; j < 4; ++j) { const int c = n0 + n + j; Bs[kk][n + j] = c < N ? B[(size_t)(k0 + kk) * ldb + c] : 0.f; } }
        __syncthreads();
#pragma unroll
        for (int kk = 0; kk < 16; ++kk) {
            float a[4], b[8];
#pragma unroll
            for (int i = 0; i < 4; ++i) a[i] = As[kk][ty * 4 + i];
#pragma unroll
            for (int j = 0; j < 8; ++j) b[j] = Bs[kk][tx * 8 + j];
#pragma unroll
            for (int i = 0; i < 4; ++i)
#pragma unroll
                for (int j = 0; j < 8; ++j) acc[i][j] += a[i] * b[j];
        }
        __syncthreads();
    }
#pragma unroll
    for (int i = 0; i < 4; ++i)
#pragma unroll
        for (int j = 0; j < 8; ++j) { const int r = m0 + ty * 4 + i, c = n0 + tx * 8 + j; if (c < N) epi(r, c, acc[i][j]); }
}

__global__ __launch_bounds__(512) void k_ymerge_naive(const bf16* __restrict__ A0, const bf16* __restrict__ A1, const bf16* __restrict__ A2, const float* __restrict__ wb,
                                                       const bf16* __restrict__ gates, bf16* __restrict__ merged) {
    __shared__ float As[16][132]; __shared__ float Bs[16][132];
    const int tid = threadIdx.x, tx = tid & 15, ty = tid >> 4;
    const int m0 = blockIdx.y * 128, n0 = blockIdx.x * 128;
    float macc[4][8];
#pragma unroll
    for (int i = 0; i < 4; ++i)
#pragma unroll
        for (int j = 0; j < 8; ++j) macc[i][j] = 0.f;
    for (int n = 0; n < 3; ++n) {
        const bf16* A = n == 0 ? A0 : (n == 1 ? A1 : A2); const float* B = wb + (size_t)n * 512 * 1024;
        float acc[4][8];
#pragma unroll
        for (int i = 0; i < 4; ++i)
#pragma unroll
            for (int j = 0; j < 8; ++j) acc[i][j] = 0.f;
        for (int k0 = 0; k0 < 512; k0 += 16) {
            { const int row = tid >> 2, kk = (tid & 3) * 4; const ushort4 v = *(const ushort4*)(A + (size_t)(m0 + row) * 512 + k0 + kk);
              As[kk][row] = bf2f(v.x); As[kk + 1][row] = bf2f(v.y); As[kk + 2][row] = bf2f(v.z); As[kk + 3][row] = bf2f(v.w); }
            { const int kk = tid >> 5, nn = (tid & 31) * 4;
#pragma unroll
              for (int j = 0; j < 4; ++j) Bs[kk][nn + j] = B[(size_t)(k0 + kk) * 1024 + n0 + nn + j]; }
            __syncthreads();
#pragma unroll
            for (int kk = 0; kk < 16; ++kk) {
                float a[4], b[8];
#pragma unroll
                for (int i = 0; i < 4; ++i) a[i] = As[kk][ty * 4 + i];
#pragma unroll
                for (int j = 0; j < 8; ++j) b[j] = Bs[kk][tx * 8 + j];
#pragma unroll
                for (int i = 0; i < 4; ++i)
#pragma unroll
                    for (int j = 0; j < 8; ++j) acc[i][j] += a[i] * b[j];
            }
            __syncthreads();
        }
#pragma unroll
        for (int i = 0; i < 4; ++i)
#pragma unroll
            for (int j = 0; j < 8; ++j) { const int r = m0 + ty * 4 + i, c = n0 + tx * 8 + j; macc[i][j] += bf2f(gates[(size_t)r * 3072 + n * 1024 + c]) * acc[i][j]; }
    }
#pragma unroll
    for (int i = 0; i < 4; ++i)
#pragma unroll
        for (int j = 0; j < 8; ++j) { const int r = m0 + ty * 4 + i, c = n0 + tx * 8 + j; merged[(size_t)r * DM + c] = f2bf(macc[i][j]); }
}

__device__ __forceinline__ void load64(const bf16* p, float (&x)[64]) {
#pragma unroll
    for (int i = 0; i < 8; ++i) { const uint4 v = ((const uint4*)p)[i];
        x[8 * i + 0] = __uint_as_float(v.x << 16); x[8 * i + 1] = __uint_as_float(v.x & 0xffff0000u);
        x[8 * i + 2] = __uint_as_float(v.y << 16); x[8 * i + 3] = __uint_as_float(v.y & 0xffff0000u);
        x[8 * i + 4] = __uint_as_float(v.z << 16); x[8 * i + 5] = __uint_as_float(v.z & 0xffff0000u);
        x[8 * i + 6] = __uint_as_float(v.w << 16); x[8 * i + 7] = __uint_as_float(v.w & 0xffff0000u); }
}
__device__ __forceinline__ void store64(bf16* p, const float (&x)[64]) {
#pragma unroll
    for (int i = 0; i < 8; ++i) { uint4 v;
        v.x = (unsigned)f2bf(x[8 * i + 0]) | ((unsigned)f2bf(x[8 * i + 1]) << 16); v.y = (unsigned)f2bf(x[8 * i + 2]) | ((unsigned)f2bf(x[8 * i + 3]) << 16);
        v.z = (unsigned)f2bf(x[8 * i + 4]) | ((unsigned)f2bf(x[8 * i + 5]) << 16); v.w = (unsigned)f2bf(x[8 * i + 6]) | ((unsigned)f2bf(x[8 * i + 7]) << 16);
        ((uint4*)p)[i] = v; }
}
__global__ __launch_bounds__(256) void k_prep_qk(bf16* mbq, bf16* mbk, const float* __restrict__ qn_g, const float* __restrict__ kn_g, const int* __restrict__ positions) {
    const int idx = blockIdx.x * 256 + threadIdx.x; const int row = idx >> 4, hh = idx & 15, which = hh >> 3, h = hh & 7;
    bf16* p = (which ? mbk : mbq) + (size_t)row * 512 + h * 64; const float* g = which ? kn_g : qn_g;
    float x[64]; load64(p, x);
    float ss = 0.f;
#pragma unroll
    for (int i = 0; i < 64; ++i) ss += x[i] * x[i];
    const float r = rsqrtf(ss * (1.f / 64.f) + RMS_EPS);
#pragma unroll
    for (int i = 0; i < 64; ++i) x[i] = x[i] * r * g[i];
    const double pos = (double)positions[row];
    const double invf[8] = {1.0, 0.19392274474868576, 0.03760603093086393, 0.007292664737217109, 0.001414213562373095, 0.0002742481756762073, 5.318295896944988e-05, 1.031338537721246e-05};
#pragma unroll
    for (int i = 0; i < 8; ++i) {
        double rev = pos * invf[i] * 0.15915494309189535; rev -= floor(rev);
        const float fr = (float)rev; const float sn = __builtin_amdgcn_sinf(fr), cs = __builtin_amdgcn_cosf(fr);
        const float x1 = x[i], x2 = x[i + 8]; x[i] = x1 * cs - x2 * sn; x[i + 8] = x1 * sn + x2 * cs;
    }
    if (!which) {
#pragma unroll
        for (int i = 0; i < 64; ++i) x[i] *= C2;
    }
    store64(p, x);
}
__global__ __launch_bounds__(256) void k_kmean(const bf16* __restrict__ mbk, float* __restrict__ kmean) {
    const int idx = blockIdx.x * 256 + threadIdx.x; const int d = idx & 63, blk = (idx >> 6) & 7, h = (idx >> 9) & 7, b = idx >> 12;
    float s = 0.f;
    for (int i = 0; i < 256; ++i) s += bf2f(mbk[(size_t)(b * SEQ + blk * 256 + i) * 512 + h * 64 + d]);
    kmean[idx] = s * (1.f / 256.f);
}
__global__ __launch_bounds__(256) void k_conv(const bf16* __restrict__ mlqk, const float* __restrict__ cw, bf16* __restrict__ q2, bf16* __restrict__ k2) {
    const size_t idx = (size_t)blockIdx.x * 256 + threadIdx.x; const int c = (int)(idx & 1023), row = (int)(idx >> 10), t = row & (SEQ - 1);
    float y = 0.f;
#pragma unroll
    for (int j = 0; j < 4; ++j) { const int tt = t - 3 + j; if (tt >= 0) y += cw[j * 1024 + c] * bf2f(mlqk[(size_t)(row - 3 + j) * 1024 + c]); }
    y = y * sigmoidf_(y);
    if (c < 512) q2[(size_t)row * 512 + c] = f2bf(y); else k2[(size_t)row * 512 + c - 512] = f2bf(y * 0.08838834764831845f);
}

__global__ __launch_bounds__(256) void k_sb_naive(bf16* sbq, const bf16* __restrict__ sbk, const bf16* __restrict__ sbv) {
    const int idx = blockIdx.x * 256 + threadIdx.x; const int row = idx >> 3, h = idx & 7, t = row & (SEQ - 1), base = row - t;
    float q[64], acc[64]; load64(sbq + (size_t)row * 512 + h * 64, q);
#pragma unroll
    for (int i = 0; i < 64; ++i) acc[i] = 0.f;
    float C = 0.f;
    for (int s = t - 1; s >= 0; --s) {
        float k[64]; load64(sbk + (size_t)(base + s) * 512 + h * 64, k);
        float z = 0.f;
#pragma unroll
        for (int i = 0; i < 64; ++i) z += q[i] * k[i];
        const float sp = z > 0.f ? z + __log2f(1.f + exp2f(-z)) : __log2f(1.f + exp2f(z));
        C += sp; const float w = exp2f(z - C);
        float v[64]; load64(sbv + (size_t)(base + s) * 512 + h * 64, v);
#pragma unroll
        for (int i = 0; i < 64; ++i) acc[i] += w * v[i];
        if (C > 150.f) break;
    }
    store64(sbq + (size_t)row * 512 + h * 64, acc);
}

__global__ __launch_bounds__(256) void k_moba_naive(bf16* mbq, const bf16* __restrict__ mbk, const bf16* __restrict__ mbv, const float* __restrict__ kmean) {
    const int idx = blockIdx.x * 256 + threadIdx.x; const int row = idx >> 3, h = idx & 7, t = row & (SEQ - 1), base = row - t, b = row >> 11, own = t >> 8;
    float q[64], acc[64]; load64(mbq + (size_t)row * 512 + h * 64, q);
#pragma unroll
    for (int i = 0; i < 64; ++i) acc[i] = 0.f;
    unsigned sel = 0u;
    {
        float g[8];
#pragma unroll
        for (int blk = 0; blk < 8; ++blk) { float s = 0.f; const float* km = kmean + ((size_t)(b * 8 + h) * 8 + blk) * 64;
#pragma unroll
            for (int i = 0; i < 64; ++i) s += q[i] * km[i];
            g[blk] = blk < own ? s : -INFINITY; }
#pragma unroll
        for (int r = 0; r < 3; ++r) { float best = -INFINITY; int bi = -1;
#pragma unroll
            for (int blk = 0; blk < 8; ++blk) { const bool ok = !((sel >> blk) & 1u) && g[blk] > best; if (ok) { best = g[blk]; bi = blk; } }
            if (bi >= 0) sel |= 1u << bi; }
    }
    sel |= 1u << own;
    float m = -INFINITY, l = 0.f;
    for (int blk = 0; blk <= own; ++blk) {
        if (!((sel >> blk) & 1u)) continue;
        const int s1 = blk == own ? t : blk * 256 + 255;
        for (int s = blk * 256; s <= s1; ++s) {
            float k[64]; load64(mbk + (size_t)(base + s) * 512 + h * 64, k);
            float z = 0.f;
#pragma unroll
            for (int i = 0; i < 64; ++i) z += q[i] * k[i];
            const float mn = fmaxf(m, z), sc = exp2f(m - mn), p = exp2f(z - mn);
            float v[64]; load64(mbv + (size_t)(base + s) * 512 + h * 64, v);
            l = l * sc + p;
#pragma unroll
            for (int i = 0; i < 64; ++i) acc[i] = acc[i] * sc + p * v[i];
            m = mn;
        }
    }
    const float il = 1.f / l;
#pragma unroll
    for (int i = 0; i < 64; ++i) acc[i] *= il;
    store64(mbq + (size_t)row * 512 + h * 64, acc);
}

__global__ __launch_bounds__(512) void k_mlstm_naive(const bf16* __restrict__ q2, const bf16* __restrict__ k2, const bf16* __restrict__ mlv, bf16* mlo, const float* __restrict__ ifpre) {
    const int b = blockIdx.x >> 2, h = blockIdx.x & 3, tid = threadIdx.x, e = tid >> 2, dq = tid & 3;
    float Cst[32], nst[32];
#pragma unroll
    for (int j = 0; j < 32; ++j) { Cst[j] = 0.f; nst[j] = 0.f; }
    float m = 0.f;
    for (int t = 0; t < SEQ; ++t) {
        const size_t row = (size_t)b * SEQ + t;
        const float li = ifpre[row * 8 + h], fp = ifpre[row * 8 + 4 + h];
        const float lf = fp >= 0.f ? -log1pf(__expf(-fp)) : fp - log1pf(__expf(fp));
        const float mn = fmaxf(lf + m, li), fd = __expf(lf + m - mn), ii = __expf(li - mn); m = mn;
        const bf16* kp = k2 + row * 512 + h * 128 + dq * 32; const bf16* qp = q2 + row * 512 + h * 128 + dq * 32;
        const float ve = bf2f(mlv[row * 512 + h * 128 + e]) * ii;
        float num = 0.f, den = 0.f;
#pragma unroll
        for (int c4 = 0; c4 < 4; ++c4) {
            const uint4 kv = ((const uint4*)kp)[c4], qv = ((const uint4*)qp)[c4];
            const unsigned ku[4] = {kv.x, kv.y, kv.z, kv.w}, qu[4] = {qv.x, qv.y, qv.z, qv.w};
#pragma unroll
            for (int u = 0; u < 4; ++u) {
                const float k0 = __uint_as_float(ku[u] << 16), k1 = __uint_as_float(ku[u] & 0xffff0000u), q0 = __uint_as_float(qu[u] << 16), q1 = __uint_as_float(qu[u] & 0xffff0000u);
                const int j = c4 * 8 + u * 2;
                Cst[j] = fd * Cst[j] + ve * k0; Cst[j + 1] = fd * Cst[j + 1] + ve * k1;
                nst[j] = fd * nst[j] + ii * k0; nst[j + 1] = fd * nst[j + 1] + ii * k1;
                num += Cst[j] * q0 + Cst[j + 1] * q1; den += nst[j] * q0 + nst[j + 1] * q1;
            }
        }
        num += __shfl_xor(num, 1); num += __shfl_xor(num, 2); den += __shfl_xor(den, 1); den += __shfl_xor(den, 2);
        const float o = num / fmaxf(fabsf(den), __expf(-m));
        if (dq == 0) { bf16* op = mlo + row * 512 + h * 128 + e; *op = f2bf(o * sigmoidf_(bf2f(*op))); }
    }
}

__global__ __launch_bounds__(512) void k_router(const float* __restrict__ hin, const float* __restrict__ g2, const float* __restrict__ w_rg, const float* __restrict__ b_rg,
                                                const float* __restrict__ w_re, const float* __restrict__ b_re, bf16* __restrict__ xn2, int* __restrict__ re, float* __restrict__ rw) {
    const int lane = threadIdx.x & 63, row = blockIdx.x * 8 + (threadIdx.x >> 6);
    const float4* xr = (const float4*)(hin + (size_t)row * DM) + lane;
    float x[16]; float s = 0.f;
#pragma unroll
    for (int j = 0; j < 4; ++j) { const float4 v = xr[64 * j]; x[4 * j] = v.x; x[4 * j + 1] = v.y; x[4 * j + 2] = v.z; x[4 * j + 3] = v.w; s += v.x * v.x + v.y * v.y + v.z * v.z + v.w * v.w; }
    const float r = rsqrtf(wave_sum(s) * (1.f / DM) + RMS_EPS);
#pragma unroll
    for (int j = 0; j < 4; ++j) { const float4 gg = ((const float4*)g2)[lane + 64 * j]; x[4 * j] *= r * gg.x; x[4 * j + 1] *= r * gg.y; x[4 * j + 2] *= r * gg.z; x[4 * j + 3] *= r * gg.w;
        ushort4 o; o.x = f2bf(x[4 * j]); o.y = f2bf(x[4 * j + 1]); o.z = f2bf(x[4 * j + 2]); o.w = f2bf(x[4 * j + 3]);
        ((ushort4*)(xn2 + (size_t)row * DM))[lane + 64 * j] = o; }
    float lg[36];
#pragma unroll
    for (int o = 0; o < 36; ++o) lg[o] = 0.f;
#pragma unroll
    for (int j = 0; j < 4; ++j)
#pragma unroll
        for (int u = 0; u < 4; ++u) { const int d = (lane + 64 * j) * 4 + u; const float xv = x[4 * j + u];
            const float4 wg = *(const float4*)(w_rg + (size_t)d * 4); lg[0] += xv * wg.x; lg[1] += xv * wg.y; lg[2] += xv * wg.z; lg[3] += xv * wg.w;
#pragma unroll
            for (int o4 = 0; o4 < 8; ++o4) { const float4 we = *(const float4*)(w_re + (size_t)d * 32 + o4 * 4);
                lg[4 + o4 * 4] += xv * we.x; lg[5 + o4 * 4] += xv * we.y; lg[6 + o4 * 4] += xv * we.z; lg[7 + o4 * 4] += xv * we.w; } }
#pragma unroll
    for (int o = 0; o < 36; ++o) lg[o] = wave_sum(lg[o]);
    float gl[4]; float gm = -INFINITY; int gi = 0;
#pragma unroll
    for (int i = 0; i < 4; ++i) { gl[i] = lg[i] + b_rg[i]; if (gl[i] > gm) { gm = gl[i]; gi = i; } }
    float gs = 0.f;
#pragma unroll
    for (int i = 0; i < 4; ++i) gs += __expf(gl[i] - gm);
    const float gw = 1.f / gs;
    float el[8];
#pragma unroll
    for (int j = 0; j < 8; ++j) { const float a0 = lg[4 + j] + b_re[j], a1 = lg[12 + j] + b_re[8 + j], a2 = lg[20 + j] + b_re[16 + j], a3 = lg[28 + j] + b_re[24 + j];
        el[j] = gi == 0 ? a0 : (gi == 1 ? a1 : (gi == 2 ? a2 : a3)); }
    float m1 = -INFINITY; int i1 = 0;
#pragma unroll
    for (int j = 0; j < 8; ++j) if (el[j] > m1) { m1 = el[j]; i1 = j; }
    float m2 = -INFINITY; int i2 = 0;
#pragma unroll
    for (int j = 0; j < 8; ++j) if (j != i1 && el[j] > m2) { m2 = el[j]; i2 = j; }
    const float p2 = __expf(m2 - m1);
    const float w1 = gw / (1.f + p2), w2 = gw * p2 / (1.f + p2);
    if (lane == 0) { re[row * 2] = gi * 8 + i1; re[row * 2 + 1] = gi * 8 + i2; rw[row * 2] = w1; rw[row * 2 + 1] = w2; }
}

__global__ __launch_bounds__(512) void k_moe_naive(const bf16* __restrict__ xn2, const int* __restrict__ re, const float* __restrict__ rw, const float* __restrict__ w1, const float* __restrict__ w3,
                                                   const float* __restrict__ w2, float* out) {
    __shared__ float xs[1024]; __shared__ float tmp[2][256]; __shared__ float hid[2][256];
    const int row = blockIdx.x, tid = threadIdx.x;
    xs[tid] = bf2f(xn2[(size_t)row * DM + tid]); xs[tid + 512] = bf2f(xn2[(size_t)row * DM + tid + 512]);
    __syncthreads();
    const int f = tid & 255, which = tid >> 8;
    for (int k = 0; k < 2; ++k) {
        const int e = re[row * 2 + k]; const float wgt = rw[row * 2 + k];
        const float* wp = (which ? w3 : w1) + (size_t)e * 1024 * 256 + f;
        float s = 0.f;
        for (int d = 0; d < 1024; ++d) s += xs[d] * wp[(size_t)d * 256];
        tmp[which][f] = s;
        __syncthreads();
        if (which == 0) { const float a = tmp[0][f]; hid[k][f] = a * sigmoidf_(a) * tmp[1][f] * wgt; }
        __syncthreads();
    }
    const int e0 = re[row * 2], e1 = re[row * 2 + 1];
    for (int c = tid; c < 1024; c += 512) {
        float y = 0.f;
        const float* p0 = w2 + (size_t)e0 * 256 * 1024 + c; const float* p1 = w2 + (size_t)e1 * 256 * 1024 + c;
        for (int ff = 0; ff < 256; ++ff) y += hid[0][ff] * p0[(size_t)ff * 1024] + hid[1][ff] * p1[(size_t)ff * 1024];
        out[(size_t)row * DM + c] += y;
    }
}

constexpr int NWAVES = 8;
constexpr int RING_OFF = 0, RING_BYTES = 131072, LDSCTL_OFF = RING_BYTES, MISC_OFF = LDSCTL_OFF + 320, LDS_BYTES = 147456;
constexpr int CW_TMO = 0, CW_CODE = 1, CW_BAR = 4096;
struct Args { const void* in[18]; float* out; unsigned char* ws; int layer, ph_lo, ph_hi, pad; };
struct Frame {
    LAS unsigned char* lds; volatile LAS unsigned* MISC; gu32* ctl;
    int tid, lane, wave, vcu, G;
};
__device__ __forceinline__ void tr_item(const float* src, int ld, int k0, int nsrc0, bf16* dst, int Kdim, int ndst0, LAS float* scr, int lane) {
#pragma unroll 8
    for (int i = 0; i < 32; ++i) { const int kk = 2 * i + (lane >> 5); scr[kk * 33 + (lane & 31)] = src[(size_t)(k0 + kk) * ld + nsrc0 + (lane & 31)]; }
    LDS_WAIT(); asm volatile("" ::: "memory");
    const int c = lane & 7;
#pragma unroll
    for (int j = 0; j < 4; ++j) { const int n = (lane >> 3) + 8 * j; const LAS float* s = scr + (8 * c) * 33 + n;
        v4u o; o.x = pk2(s[0 * 33], s[1 * 33]); o.y = pk2(s[2 * 33], s[3 * 33]); o.z = pk2(s[4 * 33], s[5 * 33]); o.w = pk2(s[6 * 33], s[7 * 33]);
        *(GAS v4u*)(dst + (size_t)(ndst0 + n) * Kdim + k0 + 8 * c) = o; }
    LDS_WAIT(); asm volatile("" ::: "memory");
}
__device__ __forceinline__ int win_remap(int nd) { return nd < 3072 ? nd : (nd < 3584 ? nd + 1536 : (nd < 4096 ? nd + 512 : (nd < 5120 ? nd - 1024 : nd + 8))); }

__device__ __forceinline__ void p0_prologue(Frame& F, const Args& a, const float* xin) {
    const int l = a.layer;
    LAS float* scr = (LAS float*)(F.lds + RING_OFF + F.wave * 16384);
    const int gw = F.vcu * NWAVES + F.wave, NGW = F.G * NWAVES;
    const float* w_in = (const float*)a.in[3] + (size_t)l * DM * PIN; const float* w_br = (const float*)a.in[8] + (size_t)l * 3 * 512 * 1024; const float* w_out = (const float*)a.in[9] + (size_t)l * DM * DM;
    bf16* WT_IN = (bf16*)(a.ws + WS_WTIN); bf16* WT_BR = (bf16*)(a.ws + WS_WTBR); bf16* WT_OUT = (bf16*)(a.ws + WS_WTOUT);
    constexpr int I_IN = 16 * 256, I_BR = 3 * 256, I_OUT = 16 * 32, NITEMS = I_IN + I_BR + I_OUT;
    for (int it = gw; it < NITEMS; it += NGW) {
        int r = it;
        if (r < I_IN) { const int kb = r >> 8, nb = r & 255; tr_item(w_in, PIN, 64 * kb, win_remap(32 * nb), WT_IN, DM, 32 * nb, scr, F.lane); continue; } r -= I_IN;
        if (r < I_BR) { const int n = r >> 8, rr = r & 255, kb = rr >> 5, nb = rr & 31; tr_item(w_br + (size_t)n * 512 * 1024, 1024, 64 * kb, 32 * nb, WT_BR + (size_t)n * 1024 * 512, 512, 32 * nb, scr, F.lane); continue; } r -= I_BR;
        { const int kb = r >> 5, nb = r & 31; tr_item(w_out, 1024, 64 * kb, 32 * nb, WT_OUT, DM, 32 * nb, scr, F.lane); }
    }
    const float* g1 = (const float*)a.in[2] + l * DM; const float* gate_b = (const float*)a.in[7] + l * 8;
    bf16* XN = (bf16*)(a.ws + WS_XN); float* IFPRE = (float*)(a.ws + WS_IFPRE);
    for (int m = gw; m < M; m += NGW) {
        const GAS f32x4* xr = (const GAS f32x4*)(xin + (size_t)m * DM) + F.lane;
        f32x4 v[4]; float s = 0.f;
#pragma unroll
        for (int j = 0; j < 4; ++j) { v[j] = xr[64 * j]; s += (v[j].x * v[j].x + v[j].y * v[j].y) + (v[j].z * v[j].z + v[j].w * v[j].w); }
#pragma unroll
        for (int o = 1; o < 64; o <<= 1) s += __shfl_xor(s, o);
        const float rs = rsqrtf(s * (1.f / DM) + RMS_EPS);
        float ip[8];
#pragma unroll
        for (int o = 0; o < 8; ++o) ip[o] = 0.f;
        GAS unsigned long long* o8 = (GAS unsigned long long*)(XN + (size_t)m * DM) + F.lane;
#pragma unroll
        for (int j = 0; j < 4; ++j) { const f32x4 gg = ((const GAS f32x4*)g1)[F.lane + 64 * j]; v[j] = v[j] * rs * gg;
            o8[64 * j] = (unsigned long long)pk2(v[j].x, v[j].y) | ((unsigned long long)pk2(v[j].z, v[j].w) << 32);
#pragma unroll
            for (int u = 0; u < 4; ++u) { const int d = (F.lane + 64 * j) * 4 + u; const float xv = v[j][u];
                const f32x4 wa = *(const GAS f32x4*)(w_in + (size_t)d * PIN + 5120), wb = *(const GAS f32x4*)(w_in + (size_t)d * PIN + 5124);
                ip[0] += xv * wa.x; ip[1] += xv * wa.y; ip[2] += xv * wa.z; ip[3] += xv * wa.w; ip[4] += xv * wb.x; ip[5] += xv * wb.y; ip[6] += xv * wb.z; ip[7] += xv * wb.w; } }
#pragma unroll
        for (int o = 0; o < 8; ++o) {
#pragma unroll
            for (int sft = 1; sft < 64; sft <<= 1) ip[o] += __shfl_xor(ip[o], sft); }
        float val = ip[0];
#pragma unroll
        for (int o = 1; o < 8; ++o) val = F.lane == o ? ip[o] : val;
        if (F.lane < 8) IFPRE[(size_t)m * 8 + F.lane] = val + gate_b[F.lane];
    }
}

__global__ void __launch_bounds__(NWAVES * 64, 2) mk(Args args) {
    extern __shared__ __attribute__((aligned(16))) unsigned char lds[];
    Frame F;
    F.lds = (LAS unsigned char*)lds; F.MISC = (volatile LAS unsigned*)(F.lds + MISC_OFF);
    F.tid = threadIdx.x; F.lane = F.tid & 63; F.wave = __builtin_amdgcn_readfirstlane(F.tid >> 6);
    F.G = gridDim.x; { const int bx = blockIdx.x; F.vcu = (F.G % 8 == 0) ? (bx % 8) * (F.G / 8) + bx / 8 : bx; }
    unsigned char* ws = args.ws; F.ctl = (gu32*)(ws + WS_CTL);
    for (int u = F.tid; u < (LDS_BYTES - LDSCTL_OFF) / 4; u += NWAVES * 64) ((LAS unsigned*)(F.lds + LDSCTL_OFF))[u] = 0u;
    __syncthreads();
    const int lo = args.ph_lo, hi = args.ph_hi;
    XcdBarrier bar; bar.bar = (unsigned*)(F.ctl + CW_BAR); bar.x = 0; bar.st = nullptr;
    if (hi - lo > 1) bar = xcd_barrier_post((unsigned*)(F.ctl + CW_BAR), F.MISC + 8);
#define IN(k) (lo <= (k) && (k) < hi)
#define BOTH(k) (IN(k) && IN((k) + 1))
    const float* xin = args.layer == 0 ? (const float*)args.in[0] : (const float*)args.out;
    if (IN(0)) { p0_prologue(F, args, xin); if (BOTH(0)) xcd_barrier(bar); }
    if (IN(1)) {
        pg8::Gemm g{(const pg8::bf16_t*)(ws + WS_XN), (const pg8::bf16_t*)(ws + WS_WTIN), M, 8192, DM}; pg8::StaticOrder S; S.init(M, 8192, F.G, (int)blockIdx.x);
        pg8::EpiInProj E{ws};
        pg8::gemm_phase<pg8::EpiInProj, pg8::StaticOrder, PG8_ALIGN, PG8_SP2>(F.lds + RING_OFF, g, S, E);
        if (BOTH(1)) xcd_barrier(bar);
    }
#undef IN
#undef BOTH
}

extern "C" void kernel_launch(void* const* d_in, const int* in_sizes, int n_in, void* d_out, int out_size, void* d_ws, size_t ws_size, hipStream_t stream) {
    static int grid = 0;
    if (grid == 0) {
        if (n_in != 18 || out_size != M * DM || ws_size < WS_END) { fprintf(stderr, "kernel_launch: unexpected shapes (n_in %d out %d ws %zu)\n", n_in, out_size, ws_size); grid = -1; return; }
        int dev = 0, cus = 0;
        if (hipGetDevice(&dev) != hipSuccess || hipDeviceGetAttribute(&cus, hipDeviceAttributeMultiprocessorCount, dev) != hipSuccess) { grid = -1; return; }
        if (hipFuncSetAttribute((const void*)mk, hipFuncAttributeMaxDynamicSharedMemorySize, LDS_BYTES) != hipSuccess) { grid = -1; return; }
        (void)hipGetLastError();
        grid = cus;
    }
    if (grid < 0) return;
    hipMemsetAsync((char*)d_ws + WS_CTL, 0, CTL_ZERO_BYTES, stream);
    const float* x = (const float*)d_in[0]; const int* positions = (const int*)d_in[1];
    const float *qn_g = (const float*)d_in[4], *kn_g = (const float*)d_in[5], *conv_w = (const float*)d_in[6],
                *w_branch = (const float*)d_in[8], *w_out = (const float*)d_in[9], *norm2_g = (const float*)d_in[10], *w_rg = (const float*)d_in[11],
                *b_rg = (const float*)d_in[12], *w_re = (const float*)d_in[13], *b_re = (const float*)d_in[14], *w1 = (const float*)d_in[15], *w3 = (const float*)d_in[16], *w2 = (const float*)d_in[17];
    unsigned char* ws = (unsigned char*)d_ws; float* out = (float*)d_out;
    bf16 *SBQ = (bf16*)(ws + WS_SBQ), *SBK = (bf16*)(ws + WS_SBK), *SBV = (bf16*)(ws + WS_SBV), *MBQ = (bf16*)(ws + WS_MBQ), *MBK = (bf16*)(ws + WS_MBK),
         *MBV = (bf16*)(ws + WS_MBV), *MLQK = (bf16*)(ws + WS_MLQK), *MLV = (bf16*)(ws + WS_MLV), *MLO = (bf16*)(ws + WS_MLO), *GATES = (bf16*)(ws + WS_GATES), *MLQ2 = (bf16*)(ws + WS_MLQ2),
         *MLK2 = (bf16*)(ws + WS_MLK2), *MERGED = (bf16*)(ws + WS_MERGED), *XN2 = (bf16*)(ws + WS_XN2);
    float *IFPRE = (float*)(ws + WS_IFPRE), *KMEAN = (float*)(ws + WS_KMEAN), *RW = (float*)(ws + WS_RW); int* RE = (int*)(ws + WS_RE);
    Args a{};
    for (int i = 0; i < 18; ++i) a.in[i] = d_in[i];
    a.out = out; a.ws = ws;
    for (int l = 0; l < DEPTH; ++l) {
        const float* xin = l == 0 ? x : out;
        a.layer = l;
        a.ph_lo = 0; a.ph_hi = 1; hipLaunchKernelGGL(mk, dim3(grid), dim3(NWAVES * 64), LDS_BYTES, stream, a);
        a.ph_lo = 1; a.ph_hi = 2; hipLaunchKernelGGL(mk, dim3(grid), dim3(NWAVES * 64), LDS_BYTES, stream, a);
        k_prep_qk<<<M * 16 / 256, 256, 0, stream>>>(MBQ, MBK, qn_g + l * 64, kn_g + l * 64, positions);
        k_kmean<<<8 * 8 * 8 * 64 / 256, 256, 0, stream>>>(MBK, KMEAN);
        k_conv<<<M * 1024 / 256, 256, 0, stream>>>(MLQK, conv_w + l * 4 * 1024, MLQ2, MLK2);
        k_sb_naive<<<M * 8 / 256, 256, 0, stream>>>(SBQ, SBK, SBV);
        k_moba_naive<<<M * 8 / 256, 256, 0, stream>>>(MBQ, MBK, MBV, KMEAN);
        k_mlstm_naive<<<32, 512, 0, stream>>>(MLQ2, MLK2, MLV, MLO, IFPRE);
        k_ymerge_naive<<<dim3(DM / 128, M / 128), 512, 0, stream>>>(SBQ, MBQ, MLO, w_branch + (size_t)l * 3 * 512 * 1024, GATES, MERGED);
        EpiResid e2{xin, out};
        k_gemm_naive<EpiResid><<<dim3(DM / 128, M / 128), 512, 0, stream>>>(MERGED, DM, w_out + (size_t)l * DM * DM, DM, DM, DM, e2);
        k_router<<<M / 8, 512, 0, stream>>>(out, norm2_g + l * DM, w_rg + (size_t)l * DM * 4, b_rg + l * 4, w_re + (size_t)l * DM * 32, b_re + l * 32, XN2, RE, RW);
        k_moe_naive<<<M, 512, 0, stream>>>(XN2, RE, RW, w1 + (size_t)l * 32 * 1024 * 256, w3 + (size_t)l * 32 * 1024 * 256, w2 + (size_t)l * 32 * 256 * 1024, out);
    }
}
```

```cpp
#include <hip/hip_runtime.h>
#include <stdint.h>
#include <cstdio>
#include <cmath>

constexpr int BATCH = 8, SEQ = 2048, DM = 1024, M = BATCH * SEQ, W = 512, PIN = 8200, DEPTH = 2;
constexpr float RMS_EPS = 1e-6f;
constexpr float C2 = 0.18033688011112042f;
constexpr size_t MiB = 1u << 20;
constexpr size_t WS_CTL = 0, CTL_ZERO_BYTES = 1 * MiB;
constexpr size_t WS_IFPRE = 1 * MiB, WS_KMEAN = WS_IFPRE + 512 * 1024, WS_RE = WS_KMEAN + 128 * 1024, WS_RW = WS_RE + 128 * 1024;
constexpr size_t WS_XN = 4 * MiB, WS_WTIN = 36 * MiB;
constexpr size_t WS_SBQ = 52 * MiB, WS_SBK = 68 * MiB, WS_SBV = 84 * MiB, WS_MBQ = 100 * MiB, WS_MBK = 116 * MiB, WS_MBV = 132 * MiB;
constexpr size_t WS_MLO = 148 * MiB, WS_MLV = 164 * MiB, WS_MLQK = 180 * MiB, WS_GATES = 212 * MiB;
constexpr size_t WS_WTBR = 308 * MiB, WS_WTOUT = 311 * MiB, WS_END = 313 * MiB;
constexpr size_t WS_MLQ2 = WS_XN, WS_MLK2 = WS_XN + 16 * MiB, WS_MERGED = WS_MLQK, WS_XN2 = WS_XN;
constexpr size_t WS_WT13 = 52 * MiB, WS_WT2 = 84 * MiB;
namespace pg8 {
#define PG8_LAS __attribute__((address_space(3)))
typedef unsigned short bf16_t;
typedef short bf16x8 __attribute__((ext_vector_type(8)));
typedef float f32x4 __attribute__((ext_vector_type(4)));
typedef unsigned u32x4 __attribute__((ext_vector_type(4)));
constexpr int BM = 256, BK = 64, HALF = 128, HTB = HALF * BK * 2  , STAGE_BYTES = 8 * HTB, NXCD = 8, WGM = 8;

__host__ __device__ __forceinline__ int lds_byte(int r, int c) { const int st = (r >> 4) * 2 + (c >> 5), rr = r & 15, cc = c & 31, ob = rr * 64 + cc * 2; return st * 1024 + (ob ^ (((ob >> 9) & 1) << 5)); }
__host__ __device__ __forceinline__ void stage_rc(int b, int& R, int& C) { const int st = b / 1024, sb = b % 1024, swz = sb ^ (((sb >> 9) & 1) << 5); R = (st >> 1) * 16 + swz / 64; C = (st & 1) * 32 + (swz % 64) / 2; }
__host__ __device__ __forceinline__ int perm32(int rho) { const int n = rho >> 4, i = rho & 15; return 8 * (i >> 2) + 4 * n + (i & 3); }

struct Unit { int pm, pn; };
struct Gemm { const bf16_t* A; const bf16_t* Bt; int M, N, K; };

struct StaticOrder {
    int nM, nN, nwg, G, c;
    __host__ __device__ void init(int M, int N, int G_, int c_) { nM = M / BM; nN = N / BM; nwg = nM * nN; G = G_; c = c_; }
    __host__ __device__ bool next(int i, Unit& u) const {
        const long L = (long)i * G + c; if (L >= nwg) return false;
        int wgid = (int)L; { const int q = nwg / NXCD, r = nwg % NXCD, xcd = wgid % NXCD, off = wgid / NXCD; wgid = (xcd < r ? xcd * (q + 1) : r * (q + 1) + (xcd - r) * q) + off; }
        const int nig = WGM * nN, gid = wgid / nig, fm = gid * WGM, gsz = (nM - fm) < WGM ? (nM - fm) : WGM;
        u.pm = fm + ((wgid % nig) % gsz); u.pn = (wgid % nig) / gsz; return true;
    }
    __device__ __forceinline__ void a_ready(const Unit&) const {}
    __device__ __forceinline__ void done(const Unit&) const {}
};

__device__ __forceinline__ unsigned cvt_pk_bf16(float lo, float hi) { unsigned r; asm volatile("v_cvt_pk_bf16_f32 %0, %1, %2" : "=v"(r) : "v"(lo), "v"(hi)); return r; }
typedef float f32x2 __attribute__((ext_vector_type(2)));
__device__ __forceinline__ float fast_sigmoid(float x) { return __builtin_amdgcn_rcpf(1.0f + __expf(-x)); }
struct EpiInProj {
    static constexpr bool PERM = true, AFTER_DRAIN = false;
    unsigned char* ws;
    __device__ __forceinline__ void operator()(const f32x4 (&acc)[2][2][4][2], const Unit& u, int wr, int wc, int fr, int fq) const {
        const int pn = u.pn; bf16_t* base; int ldc, colt; float sc = 1.f; bool sig = false;
        if (pn < 12) { base = (bf16_t*)(ws + WS_SBQ) + (size_t)(pn >> 1) * (8u << 20); ldc = 512; colt = (pn & 1) * 256; if (pn < 2) sc = C2; }
        else if (pn < 14) { base = (bf16_t*)(ws + WS_MLO); ldc = 512; colt = (pn & 1) * 256; }
        else if (pn < 16) { base = (bf16_t*)(ws + WS_MLV); ldc = 512; colt = (pn & 1) * 256; }
        else if (pn < 20) { base = (bf16_t*)(ws + WS_MLQK); ldc = 1024; colt = (pn - 16) * 256; }
        else { base = (bf16_t*)(ws + WS_GATES); ldc = 3072; colt = (pn - 20) * 256; sig = true; }
        const int row0 = u.pm * BM + wr * 64 + fr, col0 = colt + wc * 32 + 8 * fq;
#pragma unroll
        for (int ai = 0; ai < 2; ++ai)
#pragma unroll
            for (int m = 0; m < 4; ++m) { bf16_t* rowp = base + (size_t)(row0 + ai * HALF + m * 16) * ldc + col0;
#pragma unroll
                for (int bj = 0; bj < 2; ++bj) { f32x4 v0 = acc[ai][bj][m][0], v1 = acc[ai][bj][m][1];
                    if (sig) { v0 = (f32x4){fast_sigmoid(v0[0]), fast_sigmoid(v0[1]), fast_sigmoid(v0[2]), fast_sigmoid(v0[3])}; v1 = (f32x4){fast_sigmoid(v1[0]), fast_sigmoid(v1[1]), fast_sigmoid(v1[2]), fast_sigmoid(v1[3])}; }
                    else { v0 = v0 * sc; v1 = v1 * sc; }
                    u32x4 w; w.x = cvt_pk_bf16(v0[0], v0[1]); w.y = cvt_pk_bf16(v0[2], v0[3]); w.z = cvt_pk_bf16(v1[0], v1[1]); w.w = cvt_pk_bf16(v1[2], v1[3]);
                    *(u32x4*)(rowp + bj * HALF) = w; } }
    }
};
struct EpiYMerge {
    static constexpr bool PERM = true, AFTER_DRAIN = false;
    const bf16_t* gates; bf16_t* merged;
    __device__ __forceinline__ void operator()(const f32x4 (&acc)[2][2][4][2], const Unit& u, int wr, int wc, int fr, int fq) const {
        const int n = u.pn >> 2, pn = u.pn & 3, pm = u.pm - 192 * n;
        const int row0 = pm * BM + wr * 64 + fr, col0 = pn * BM + wc * 32 + 8 * fq;
#pragma unroll
        for (int ai = 0; ai < 2; ++ai)
#pragma unroll
            for (int m = 0; m < 4; ++m) { const size_t r = (size_t)(row0 + ai * HALF + m * 16);
#pragma unroll
                for (int bj = 0; bj < 2; ++bj) { const int c = col0 + bj * HALF;
                    const u32x4 gv = *(const u32x4*)(gates + r * 3072 + n * 1024 + c);
                    f32x4 v0 = acc[ai][bj][m][0], v1 = acc[ai][bj][m][1];
                    v0[0] *= __uint_as_float(gv.x << 16); v0[1] *= __uint_as_float(gv.x & 0xffff0000u); v0[2] *= __uint_as_float(gv.y << 16); v0[3] *= __uint_as_float(gv.y & 0xffff0000u);
                    v1[0] *= __uint_as_float(gv.z << 16); v1[1] *= __uint_as_float(gv.z & 0xffff0000u); v1[2] *= __uint_as_float(gv.w << 16); v1[3] *= __uint_as_float(gv.w & 0xffff0000u);
                    bf16_t* mp = merged + r * 1024 + c;
                    if (n > 0) { const u32x4 pv = *(const u32x4*)mp;
                        v0[0] += __uint_as_float(pv.x << 16); v0[1] += __uint_as_float(pv.x & 0xffff0000u); v0[2] += __uint_as_float(pv.y << 16); v0[3] += __uint_as_float(pv.y & 0xffff0000u);
                        v1[0] += __uint_as_float(pv.z << 16); v1[1] += __uint_as_float(pv.z & 0xffff0000u); v1[2] += __uint_as_float(pv.w << 16); v1[3] += __uint_as_float(pv.w & 0xffff0000u); }
                    u32x4 w; w.x = cvt_pk_bf16(v0[0], v0[1]); w.y = cvt_pk_bf16(v0[2], v0[3]); w.z = cvt_pk_bf16(v1[0], v1[1]); w.w = cvt_pk_bf16(v1[2], v1[3]);
                    *(u32x4*)mp = w; } }
    }
};
struct YOrder {
    int vcu, G;
    __device__ __forceinline__ bool next(int i, Unit& u) const { const int j = i / 3, n = i - 3 * j, tile = vcu + G * j; if (tile >= 256) return false; u.pm = (tile >> 2) + 192 * n; u.pn = (tile & 3) + 4 * n; return true; }
    __device__ __forceinline__ void a_ready(const Unit&) const {}
    __device__ __forceinline__ void done(const Unit&) const {}
};
struct EpiResid32 {
    static constexpr bool PERM = false, AFTER_DRAIN = false;
    const float* xin; float* out;
    __device__ __forceinline__ void operator()(const f32x4 (&acc)[2][2][4][2], const Unit& u, int wr, int wc, int fr, int fq) const {
        const int row0 = u.pm * BM + wr * 64 + fr, col0 = u.pn * BM + wc * 32 + 4 * fq;
#pragma unroll
        for (int ai = 0; ai < 2; ++ai)
#pragma unroll
            for (int m = 0; m < 4; ++m) { const size_t off = (size_t)(row0 + ai * HALF + m * 16) * 1024 + col0;
#pragma unroll
                for (int bj = 0; bj < 2; ++bj)
#pragma unroll
                    for (int n = 0; n < 2; ++n) { const f32x4 xv = *(const f32x4*)(xin + off + bj * HALF + n * 16); *(f32x4*)(out + off + bj * HALF + n * 16) = xv + acc[ai][bj][m][n]; } }
    }
};
template <class Epi, class Sched, bool ALIGN_EPI = false, bool SP2 = false>
__device__ __forceinline__ void gemm_phase(PG8_LAS unsigned char* lds, const Gemm g, const Sched& S, const Epi& E) {
    const int tid = threadIdx.x, wid = __builtin_amdgcn_readfirstlane(tid >> 6), lane = tid & 63, wr = wid >> 2, wc = wid & 3, fr = lane & 15, fq = lane >> 4;
    const int K = g.K, nt = K / BK;
    unsigned voffA[2], voffB[2];
#pragma unroll
    for (int i = 0; i < 2; ++i) { int R, C; stage_rc(tid * 16 + i * 8192, R, C); const int Rb = Epi::PERM ? ((R & ~31) + perm32(R & 31)) : R;
        voffA[i] = (unsigned)(R * K + C) * 2u; voffB[i] = (unsigned)(Rb * K + C) * 2u; }
    const size_t kstep = (size_t)(BK * 2);
    const size_t hstep = (size_t)HALF * K * 2;
    const size_t tstep = 2 * hstep;
    const unsigned ldsw = (unsigned)wid * 1024u;
    const int aoff = lds_byte(wr * 64 + fr, fq * 8), boff = lds_byte(wc * 32 + fr, fq * 8);
#define PG8_SA(b, h) (((b) * 2 + (h)) * HTB)
#define PG8_SB(b, h) ((4 + (b) * 2 + (h)) * HTB)
#define PG8_STAGE(bufoff, gbase, voff) do { _Pragma("unroll") for (int _i = 0; _i < 2; ++_i) \
        __builtin_amdgcn_global_load_lds((const unsigned*)((const char*)(gbase) + (voff)[_i]), (PG8_LAS unsigned*)(lds + (bufoff) + ldsw + _i * 8192), 16, 0, 0); } while (0)
#define PG8_LDA(dst, b, h) do { _Pragma("unroll") for (int m = 0; m < 4; ++m) _Pragma("unroll") for (int k = 0; k < 2; ++k) dst[m][k] = *(const PG8_LAS bf16x8*)(lds + PG8_SA(b, h) + aoff + m * 2048 + k * 1024); } while (0)
#define PG8_LDB(dst, b, h) do { _Pragma("unroll") for (int n = 0; n < 2; ++n) _Pragma("unroll") for (int k = 0; k < 2; ++k) dst[n][k] = *(const PG8_LAS bf16x8*)(lds + PG8_SB(b, h) + boff + n * 2048 + k * 1024); } while (0)
#define PG8_MMA(ai, bj, At, Bt) do { __builtin_amdgcn_s_setprio(1); _Pragma("unroll") for (int m = 0; m < 4; ++m) _Pragma("unroll") for (int n = 0; n < 2; ++n) _Pragma("unroll") for (int k = 0; k < 2; ++k) \
        acc[ai][bj][m][n] = __builtin_amdgcn_mfma_f32_16x16x32_bf16(Bt[n][k], At[m][k], acc[ai][bj][m][n], 0, 0, 0); __builtin_amdgcn_s_setprio(0); } while (0)
#define PG8_WAIT_V(n) asm volatile("s_waitcnt vmcnt(" #n ")" ::: "memory")
#define PG8_WAIT_L(n) asm volatile("s_waitcnt lgkmcnt(" #n ")" ::: "memory")
#define PG8_BAR __builtin_amdgcn_s_barrier()
#define PG8_SCHED __builtin_amdgcn_sched_barrier(0)
    Unit cur, nxt; int ui = 0;
    if (!S.next(0, cur)) return;
    f32x4 acc[2][2][4][2];
#pragma unroll
    for (int a = 0; a < 2; ++a)
#pragma unroll
        for (int b = 0; b < 2; ++b)
#pragma unroll
            for (int m = 0; m < 4; ++m)
#pragma unroll
                for (int n = 0; n < 2; ++n) acc[a][b][m][n] = (f32x4){0.f, 0.f, 0.f, 0.f};
    bf16x8 At[4][2], B0[2][2], B1[2][2];
    const char* cA = (const char*)g.A + (size_t)cur.pm * tstep; const char* cB = (const char*)g.Bt + (size_t)cur.pn * tstep;
    S.a_ready(cur);
    if constexpr (SP2) {
        PG8_STAGE(PG8_SB(0, 0), cB, voffB); PG8_STAGE(PG8_SB(0, 1), cB + hstep, voffB); PG8_STAGE(PG8_SA(0, 0), cA, voffA); PG8_STAGE(PG8_SA(0, 1), cA + hstep, voffA);
        if (wr == 1) PG8_BAR;
        PG8_WAIT_V(2); PG8_BAR;
        PG8_STAGE(PG8_SB(1, 0), cB + kstep, voffB); PG8_STAGE(PG8_SA(1, 0), cA + kstep, voffA); PG8_STAGE(PG8_SB(1, 1), cB + hstep + kstep, voffB);
        PG8_WAIT_V(6); PG8_BAR;
    } else {
        PG8_STAGE(PG8_SB(0, 0), cB, voffB); PG8_STAGE(PG8_SA(0, 0), cA, voffA); PG8_STAGE(PG8_SB(0, 1), cB + hstep, voffB); PG8_STAGE(PG8_SA(0, 1), cA + hstep, voffA);
        if (wr == 1) PG8_BAR;
        PG8_WAIT_V(4); PG8_BAR;
        PG8_STAGE(PG8_SB(1, 0), cB + kstep, voffB); PG8_STAGE(PG8_SA(1, 0), cA + kstep, voffA); PG8_STAGE(PG8_SB(1, 1), cB + hstep + kstep, voffB);
        PG8_WAIT_V(6); PG8_BAR;
    }
    for (;;) {
        const bool has_next = S.next(ui + 1, nxt);
        const char* nA = has_next ? (const char*)g.A + (size_t)nxt.pm * tstep : cA; const char* nB = has_next ? (const char*)g.Bt + (size_t)nxt.pn * tstep : cB;
        for (int t = 0; t < nt; t += 2) {
            const bool last = (t == nt - 2);
            const char* a1 = cA + (size_t)(t + 1) * kstep;
            const char* a2 = last ? nA : cA + (size_t)(t + 2) * kstep; const char* b2 = last ? nB : cB + (size_t)(t + 2) * kstep;
            const char* a3 = a2 + kstep; const char* b3 = b2 + kstep;
            if (last && has_next) S.a_ready(nxt);
            if constexpr (SP2) {
            PG8_LDB(B0, 0, 0); PG8_LDB(B1, 0, 1); PG8_SCHED; PG8_LDA(At, 0, 0); PG8_STAGE(PG8_SA(1, 1), a1 + hstep, voffA);
            PG8_WAIT_V(8); PG8_WAIT_L(0); PG8_BAR; PG8_MMA(0, 0, At, B0); PG8_MMA(0, 1, At, B1); PG8_BAR; PG8_SCHED;
            PG8_LDA(At, 0, 1); PG8_STAGE(PG8_SB(0, 0), b2, voffB); PG8_STAGE(PG8_SB(0, 1), b2 + hstep, voffB); PG8_STAGE(PG8_SA(0, 0), a2, voffA);
            PG8_WAIT_V(8); PG8_WAIT_L(0); PG8_BAR; PG8_MMA(1, 0, At, B0); PG8_MMA(1, 1, At, B1); PG8_BAR; PG8_SCHED;
            PG8_LDB(B0, 1, 0); PG8_LDB(B1, 1, 1); PG8_SCHED; PG8_LDA(At, 1, 0); PG8_STAGE(PG8_SA(0, 1), a2 + hstep, voffA);
            PG8_WAIT_V(8); PG8_WAIT_L(0); PG8_BAR; PG8_MMA(0, 0, At, B0); PG8_MMA(0, 1, At, B1); PG8_BAR; PG8_SCHED;
            PG8_LDA(At, 1, 1); PG8_STAGE(PG8_SB(1, 0), b3, voffB); PG8_STAGE(PG8_SB(1, 1), b3 + hstep, voffB); PG8_STAGE(PG8_SA(1, 0), a3, voffA);
            PG8_WAIT_V(8); PG8_WAIT_L(0); PG8_BAR; PG8_MMA(1, 0, At, B0); PG8_MMA(1, 1, At, B1); PG8_BAR; PG8_SCHED;
            } else {
            PG8_LDB(B0, 0, 0); PG8_SCHED; PG8_LDA(At, 0, 0); PG8_STAGE(PG8_SA(1, 1), a1 + hstep, voffA);
            PG8_WAIT_L(8); PG8_BAR; PG8_WAIT_L(0); PG8_MMA(0, 0, At, B0); PG8_BAR; PG8_SCHED;
            PG8_LDB(B1, 0, 1); PG8_STAGE(PG8_SB(0, 0), b2, voffB);
            PG8_BAR; PG8_WAIT_L(0); PG8_MMA(0, 1, At, B1); PG8_BAR;
            PG8_LDA(At, 0, 1); PG8_STAGE(PG8_SA(0, 0), a2, voffA);
            PG8_BAR; PG8_WAIT_L(0); PG8_MMA(1, 0, At, B0); PG8_BAR; PG8_SCHED;
            PG8_STAGE(PG8_SB(0, 1), b2 + hstep, voffB);
            PG8_WAIT_V(6); PG8_BAR; PG8_MMA(1, 1, At, B1); PG8_BAR;
            PG8_LDB(B0, 1, 0); PG8_SCHED; PG8_LDA(At, 1, 0); PG8_STAGE(PG8_SA(0, 1), a2 + hstep, voffA);
            PG8_WAIT_L(8); PG8_BAR; PG8_WAIT_L(0); PG8_MMA(0, 0, At, B0); PG8_BAR; PG8_SCHED;
            PG8_LDB(B1, 1, 1); PG8_STAGE(PG8_SB(1, 0), b3, voffB);
            PG8_BAR; PG8_WAIT_L(0); PG8_MMA(0, 1, At, B1); PG8_BAR;
            PG8_LDA(At, 1, 1); PG8_STAGE(PG8_SA(1, 0), a3, voffA);
            PG8_BAR; PG8_WAIT_L(0); PG8_MMA(1, 0, At, B0); PG8_BAR; PG8_SCHED;
            PG8_STAGE(PG8_SB(1, 1), b3 + hstep, voffB);
            PG8_WAIT_V(6); PG8_BAR; PG8_MMA(1, 1, At, B1); PG8_BAR;
            }
        }
        if constexpr (ALIGN_EPI) { if (wr == 0) PG8_BAR; }
        if constexpr (!Epi::AFTER_DRAIN) { E(acc, cur, wr, wc, fr, fq); S.done(cur); }
        if (!has_next) break;
#pragma unroll
        for (int a = 0; a < 2; ++a)
#pragma unroll
            for (int b = 0; b < 2; ++b)
#pragma unroll
                for (int m = 0; m < 4; ++m)
#pragma unroll
                    for (int n = 0; n < 2; ++n) acc[a][b][m][n] = (f32x4){0.f, 0.f, 0.f, 0.f};
        cur = nxt; cA = nA; cB = nB; ++ui;
        if constexpr (ALIGN_EPI) { if (wr == 1) PG8_BAR; }
    }
    PG8_WAIT_V(0);
    if constexpr (!ALIGN_EPI) { if (wr == 0) PG8_BAR; }
    PG8_BAR;
    if constexpr (Epi::AFTER_DRAIN) { E.fused(acc, cur, wr, wc, fr, fq, lds, wid, lane); S.done(cur); }
#undef PG8_SA
#undef PG8_SB
#undef PG8_STAGE
#undef PG8_LDA
#undef PG8_LDB
#undef PG8_MMA
#undef PG8_WAIT_V
#undef PG8_WAIT_L
#undef PG8_BAR
#undef PG8_SCHED
}
}

#ifndef PG8_SP2
#define PG8_SP2 true
#endif
#ifndef PG8_ALIGN
#define PG8_ALIGN true
#endif
#define GAS __attribute__((address_space(1)))
#define LAS __attribute__((address_space(3)))
typedef unsigned short bf16;
typedef unsigned v4u __attribute__((ext_vector_type(4)));
typedef float f32x4 __attribute__((ext_vector_type(4)));
typedef short bf16x8 __attribute__((ext_vector_type(8)));
typedef GAS unsigned gu32;
typedef GAS unsigned long long gu64;
#define RLX_AGENT __ATOMIC_RELAXED, __HIP_MEMORY_SCOPE_AGENT
#define LDS_WAIT() asm volatile("s_waitcnt lgkmcnt(0)" ::: "memory")
#define VM_WAIT() asm volatile("s_waitcnt vmcnt(0)" ::: "memory")
__device__ __forceinline__ unsigned long long rt() { return __builtin_amdgcn_s_memrealtime(); }
__device__ __forceinline__ unsigned f2bf(float f) { unsigned u = __builtin_bit_cast(unsigned, f); return (u + 0x7fffu + ((u >> 16) & 1u)) >> 16; }
__device__ __forceinline__ unsigned pk2(float lo, float hi) { return f2bf(lo) | (f2bf(hi) << 16); }

#define XB_TMO      128
#define XB_XCNT(j)  (256  + 64 * (j))
#define XB_XSUB(j)  (1280 + 64 * (j))
#define XB_XGEN(j)  (2304 + 64 * (j))
#define XB_TOP      3328
#define XB_TOPGEN   3392
#define XCD_BAR_WORDS 3456
#define XB_SPIN_CAP (1u << 18)

__device__ __forceinline__ unsigned xb_ld(unsigned* p)              { return __hip_atomic_load(p, __ATOMIC_RELAXED, __HIP_MEMORY_SCOPE_AGENT); }
__device__ __forceinline__ unsigned xb_add(unsigned* p, unsigned v) { return __hip_atomic_fetch_add(p, v, __ATOMIC_RELAXED, __HIP_MEMORY_SCOPE_AGENT); }
__device__ __forceinline__ unsigned xb_xcc_id() { return (unsigned)__builtin_amdgcn_s_getreg((3 << 11) | 20) & 0xFu; }
#define XB_SPIN(cond, bar) do { unsigned _sp = 0; while (cond) { __builtin_amdgcn_s_sleep(1); \
    if ((++_sp & 255u) == 0u) { if (xb_ld(&(bar)[XB_TMO])) break; if (_sp > XB_SPIN_CAP) { atomicAdd(&(bar)[XB_TMO], 1u); break; } } } } while (0)

struct XcdBarrier {
    unsigned* bar; unsigned x;
    volatile LAS unsigned* st;
};

__device__ __forceinline__ XcdBarrier xcd_barrier_post(unsigned* bar, volatile LAS unsigned* st) {
    XcdBarrier b; b.bar = bar; b.x = xb_xcc_id(); b.st = st;
    if (threadIdx.x == 0) (void)xb_add(&bar[XB_XCNT(b.x)], 1u);
    return b;
}
__device__ __forceinline__ void xcd_barrier_complete(unsigned* bar, unsigned x, unsigned& nloc, unsigned& nx) {
    const unsigned G = gridDim.x * gridDim.y * gridDim.z;
    unsigned sum, cnt, mine, sp = 0u;
    for (;;) {
        sum = 0u; cnt = 0u; mine = 0u;
#pragma unroll
        for (unsigned j = 0; j < 16; ++j) { const unsigned c = xb_ld(&bar[XB_XCNT(j)]); sum += c; cnt += (c > 0u) ? 1u : 0u; mine = (j == x) ? c : mine; }
        if (sum == G) break;
        __builtin_amdgcn_s_sleep(1);
        if ((++sp & 255u) == 0u) { if (xb_ld(&bar[XB_TMO])) break; if (sp > XB_SPIN_CAP) { atomicAdd(&bar[XB_TMO], 1u); break; } }
    }
    nloc = mine > 0u ? mine : 1u; nx = cnt > 0u ? cnt : 1u;
}

__device__ __forceinline__ void xcd_barrier(const XcdBarrier& b) {
    asm volatile("s_waitcnt vmcnt(0)" ::: "memory");
    __syncthreads();
    if (threadIdx.x == 0) {
        unsigned* bar = b.bar;
        __builtin_amdgcn_s_waitcnt(0);
        unsigned nloc = b.st[0], nx = b.st[1];
        if (nloc == 0u) { xcd_barrier_complete(bar, b.x, nloc, nx); b.st[0] = nloc; b.st[1] = nx; }
        const unsigned old = xb_add(&bar[XB_XSUB(b.x)], 1u);
        const unsigned gen = old / nloc;
        if (old + 1u == (gen + 1u) * nloc) {
            __builtin_amdgcn_fence(__ATOMIC_RELEASE, "agent");
            asm volatile("s_waitcnt vmcnt(0)" ::: "memory");
            const unsigned og = xb_add(&bar[XB_TOP], 1u);
            const unsigned tg = og / nx;
            if (og + 1u == (tg + 1u) * nx) xb_add(&bar[XB_TOPGEN], 1u);
            else XB_SPIN(xb_ld(&bar[XB_TOPGEN]) == tg, bar);
            __builtin_amdgcn_fence(__ATOMIC_ACQUIRE, "agent");
            xb_add(&bar[XB_XGEN(b.x)], 1u);
            asm volatile("s_waitcnt vmcnt(0)" ::: "memory");
        } else {
            XB_SPIN(xb_ld(&bar[XB_XGEN(b.x)]) == gen, bar);
            __builtin_amdgcn_fence(__ATOMIC_ACQUIRE, "agent");
            asm volatile("s_waitcnt vmcnt(0)" ::: "memory");
        }
    }
    __syncthreads();
}
__device__ __forceinline__ float bf2f(bf16 v) { return __uint_as_float((unsigned)v << 16); }
__device__ __forceinline__ float sigmoidf_(float x) { return 1.0f / (1.0f + __expf(-x)); }
__device__ __forceinline__ float wave_sum(float v) {
#pragma unroll
    for (int o = 1; o < 64; o <<= 1) v += __shfl_xor(v, o);
    return v;
}
__device__ __forceinline__ void load64(const bf16* p, float (&x)[64]) {
#pragma unroll
    for (int i = 0; i < 8; ++i) { const uint4 v = ((const uint4*)p)[i];
        x[8 * i + 0] = __uint_as_float(v.x << 16); x[8 * i + 1] = __uint_as_float(v.x & 0xffff0000u);
        x[8 * i + 2] = __uint_as_float(v.y << 16); x[8 * i + 3] = __uint_as_float(v.y & 0xffff0000u);
        x[8 * i + 4] = __uint_as_float(v.z << 16); x[8 * i + 5] = __uint_as_float(v.z & 0xffff0000u);
        x[8 * i + 6] = __uint_as_float(v.w << 16); x[8 * i + 7] = __uint_as_float(v.w & 0xffff0000u); }
}
__device__ __forceinline__ void store64(bf16* p, const float (&x)[64]) {
#pragma unroll
    for (int i = 0; i < 8; ++i) { uint4 v;
        v.x = pk2(x[8 * i + 0], x[8 * i + 1]); v.y = pk2(x[8 * i + 2], x[8 * i + 3]); v.z = pk2(x[8 * i + 4], x[8 * i + 5]); v.w = pk2(x[8 * i + 6], x[8 * i + 7]);
        ((uint4*)p)[i] = v; }
}
constexpr int NWAVES = 8;
constexpr int RING_OFF = 0, RING_BYTES = 131072, LDSCTL_OFF = RING_BYTES, MISC_OFF = LDSCTL_OFF + 320, LDS_BYTES = 147456;
constexpr int CW_TMO = 0, CW_CODE = 1, CW_BAR = 4096;
struct Args { const void* in[18]; float* out; unsigned char* ws; int layer, ph_lo, ph_hi, pad; };
struct Frame {
    LAS unsigned char* lds; volatile LAS unsigned* MISC; gu32* ctl;
    int tid, lane, wave, vcu, G;
};
__device__ __forceinline__ void tr_item(const float* src, int ld, int k0, int nsrc0, bf16* dst, int Kdim, int ndst0, LAS float* scr, int lane) {
#pragma unroll 8
    for (int i = 0; i < 32; ++i) { const int kk = 2 * i + (lane >> 5); scr[kk * 33 + (lane & 31)] = src[(size_t)(k0 + kk) * ld + nsrc0 + (lane & 31)]; }
    LDS_WAIT(); asm volatile("" ::: "memory");
    const int c = lane & 7;
#pragma unroll
    for (int j = 0; j < 4; ++j) { const int n = (lane >> 3) + 8 * j; const LAS float* s = scr + (8 * c) * 33 + n;
        v4u o; o.x = pk2(s[0 * 33], s[1 * 33]); o.y = pk2(s[2 * 33], s[3 * 33]); o.z = pk2(s[4 * 33], s[5 * 33]); o.w = pk2(s[6 * 33], s[7 * 33]);
        *(GAS v4u*)(dst + (size_t)(ndst0 + n) * Kdim + k0 + 8 * c) = o; }
    LDS_WAIT(); asm volatile("" ::: "memory");
}
__device__ __forceinline__ int win_remap(int nd) { return nd < 3072 ? nd : (nd < 3584 ? nd + 1536 : (nd < 4096 ? nd + 512 : (nd < 5120 ? nd - 1024 : nd + 8))); }

__device__ __forceinline__ void p0_prologue(Frame& F, const Args& a, const int l, const float* xin) {
    LAS float* scr = (LAS float*)(F.lds + RING_OFF + F.wave * 16384);
    const int gw = F.vcu * NWAVES + F.wave, NGW = F.G * NWAVES;
    const float* w_in = (const float*)a.in[3] + (size_t)l * DM * PIN; const float* w_br = (const float*)a.in[8] + (size_t)l * 3 * 512 * 1024; const float* w_out = (const float*)a.in[9] + (size_t)l * DM * DM;
    bf16* WT_IN = (bf16*)(a.ws + WS_WTIN); bf16* WT_BR = (bf16*)(a.ws + WS_WTBR); bf16* WT_OUT = (bf16*)(a.ws + WS_WTOUT);
    constexpr int I_IN = 16 * 256, I_BR = 3 * 256, I_OUT = 16 * 32, NITEMS = I_IN + I_BR + I_OUT;
    for (int it = gw; it < NITEMS; it += NGW) {
        int r = it;
        if (r < I_IN) { const int kb = r >> 8, nb = r & 255; tr_item(w_in, PIN, 64 * kb, win_remap(32 * nb), WT_IN, DM, 32 * nb, scr, F.lane); continue; } r -= I_IN;
        if (r < I_BR) { const int n = r >> 8, rr = r & 255, kb = rr >> 5, nb = rr & 31; tr_item(w_br + (size_t)n * 512 * 1024, 1024, 64 * kb, 32 * nb, WT_BR + (size_t)n * 1024 * 512, 512, 32 * nb, scr, F.lane); continue; } r -= I_BR;
        { const int kb = r >> 5, nb = r & 31; tr_item(w_out, 1024, 64 * kb, 32 * nb, WT_OUT, DM, 32 * nb, scr, F.lane); }
    }
    const float* g1 = (const float*)a.in[2] + l * DM; const float* gate_b = (const float*)a.in[7] + l * 8;
    bf16* XN = (bf16*)(a.ws + WS_XN); float* IFPRE = (float*)(a.ws + WS_IFPRE);
    for (int m = gw; m < M; m += NGW) {
        const GAS f32x4* xr = (const GAS f32x4*)(xin + (size_t)m * DM) + F.lane;
        f32x4 v[4]; float s = 0.f;
#pragma unroll
        for (int j = 0; j < 4; ++j) { v[j] = xr[64 * j]; s += (v[j].x * v[j].x + v[j].y * v[j].y) + (v[j].z * v[j].z + v[j].w * v[j].w); }
#pragma unroll
        for (int o = 1; o < 64; o <<= 1) s += __shfl_xor(s, o);
        const float rs = rsqrtf(s * (1.f / DM) + RMS_EPS);
        float ip[8];
#pragma unroll
        for (int o = 0; o < 8; ++o) ip[o] = 0.f;
        GAS unsigned long long* o8 = (GAS unsigned long long*)(XN + (size_t)m * DM) + F.lane;
#pragma unroll
        for (int j = 0; j < 4; ++j) { const f32x4 gg = ((const GAS f32x4*)g1)[F.lane + 64 * j]; v[j] = v[j] * rs * gg;
            o8[64 * j] = (unsigned long long)pk2(v[j].x, v[j].y) | ((unsigned long long)pk2(v[j].z, v[j].w) << 32);
#pragma unroll
            for (int u = 0; u < 4; ++u) { const int d = (F.lane + 64 * j) * 4 + u; const float xv = v[j][u];
                const f32x4 wa = *(const GAS f32x4*)(w_in + (size_t)d * PIN + 5120), wb = *(const GAS f32x4*)(w_in + (size_t)d * PIN + 5124);
                ip[0] += xv * wa.x; ip[1] += xv * wa.y; ip[2] += xv * wa.z; ip[3] += xv * wa.w; ip[4] += xv * wb.x; ip[5] += xv * wb.y; ip[6] += xv * wb.z; ip[7] += xv * wb.w; } }
#pragma unroll
        for (int o = 0; o < 8; ++o) {
#pragma unroll
            for (int sft = 1; sft < 64; sft <<= 1) ip[o] += __shfl_xor(ip[o], sft); }
        float val = ip[0];
#pragma unroll
        for (int o = 1; o < 8; ++o) val = F.lane == o ? ip[o] : val;
        if (F.lane < 8) IFPRE[(size_t)m * 8 + F.lane] = val + gate_b[F.lane];
    }
}


__device__ __forceinline__ float dot64(const float (&q)[64], const bf16* p) {
    float z = 0.f;
#pragma unroll
    for (int i = 0; i < 8; ++i) { const uint4 v = ((const uint4*)p)[i];
        z += q[8 * i + 0] * __uint_as_float(v.x << 16) + q[8 * i + 1] * __uint_as_float(v.x & 0xffff0000u) + q[8 * i + 2] * __uint_as_float(v.y << 16) + q[8 * i + 3] * __uint_as_float(v.y & 0xffff0000u)
           + q[8 * i + 4] * __uint_as_float(v.z << 16) + q[8 * i + 5] * __uint_as_float(v.z & 0xffff0000u) + q[8 * i + 6] * __uint_as_float(v.w << 16) + q[8 * i + 7] * __uint_as_float(v.w & 0xffff0000u);
        asm volatile("" ::: "memory"); }
    return z;
}
__device__ __forceinline__ void axpy64(float (&acc)[64], float sc, float p, const bf16* vp) {
#pragma unroll
    for (int i = 0; i < 8; ++i) { const uint4 v = ((const uint4*)vp)[i];
        acc[8 * i + 0] = acc[8 * i + 0] * sc + p * __uint_as_float(v.x << 16); acc[8 * i + 1] = acc[8 * i + 1] * sc + p * __uint_as_float(v.x & 0xffff0000u);
        acc[8 * i + 2] = acc[8 * i + 2] * sc + p * __uint_as_float(v.y << 16); acc[8 * i + 3] = acc[8 * i + 3] * sc + p * __uint_as_float(v.y & 0xffff0000u);
        acc[8 * i + 4] = acc[8 * i + 4] * sc + p * __uint_as_float(v.z << 16); acc[8 * i + 5] = acc[8 * i + 5] * sc + p * __uint_as_float(v.z & 0xffff0000u);
        acc[8 * i + 6] = acc[8 * i + 6] * sc + p * __uint_as_float(v.w << 16); acc[8 * i + 7] = acc[8 * i + 7] * sc + p * __uint_as_float(v.w & 0xffff0000u);
        asm volatile("" ::: "memory"); }
}

__device__ __forceinline__ void ph_prep_qk(Frame& F, const Args& a, const int l) {
    bf16* mbq = (bf16*)(a.ws + WS_MBQ); bf16* mbk = (bf16*)(a.ws + WS_MBK);
    const float* qn_g = (const float*)a.in[4] + l * 64; const float* kn_g = (const float*)a.in[5] + l * 64; const int* positions = (const int*)a.in[1];
    for (int idx = blockIdx.x * 512 + F.tid; idx < M * 16; idx += F.G * 512) {
        const int row = idx >> 4, hh = idx & 15, which = hh >> 3, h = hh & 7;
        bf16* p = (which ? mbk : mbq) + (size_t)row * 512 + h * 64; const float* g = which ? kn_g : qn_g;
        float x[64]; load64(p, x);
        float ss = 0.f;
#pragma unroll
        for (int i = 0; i < 64; ++i) ss += x[i] * x[i];
        const float r = rsqrtf(ss * (1.f / 64.f) + RMS_EPS);
#pragma unroll
        for (int i = 0; i < 64; ++i) x[i] = x[i] * r * g[i];
        const double pos = (double)positions[row];
        const double invf[8] = {1.0, 0.19392274474868576, 0.03760603093086393, 0.007292664737217109, 0.001414213562373095, 0.0002742481756762073, 5.318295896944988e-05, 1.031338537721246e-05};
#pragma unroll
        for (int i = 0; i < 8; ++i) {
            double rev = pos * invf[i] * 0.15915494309189535; rev -= floor(rev);
            const float fr = (float)rev; const float sn = __builtin_amdgcn_sinf(fr), cs = __builtin_amdgcn_cosf(fr);
            const float x1 = x[i], x2 = x[i + 8]; x[i] = x1 * cs - x2 * sn; x[i + 8] = x1 * sn + x2 * cs;
        }
        if (!which) {
#pragma unroll
            for (int i = 0; i < 64; ++i) x[i] *= C2;
        }
        store64(p, x);
    }
}
__device__ __forceinline__ void ph_conv(Frame& F, const Args& a, const int l) {
    const bf16* mlqk = (const bf16*)(a.ws + WS_MLQK); const float* cw = (const float*)a.in[6] + l * 4 * 1024;
    bf16* q2 = (bf16*)(a.ws + WS_MLQ2); bf16* k2 = (bf16*)(a.ws + WS_MLK2);
    for (size_t idx = (size_t)blockIdx.x * 512 + F.tid; idx < (size_t)M * 1024; idx += (size_t)F.G * 512) {
        const int c = (int)(idx & 1023), row = (int)(idx >> 10), t = row & (SEQ - 1);
        float y = 0.f;
#pragma unroll
        for (int j = 0; j < 4; ++j) { const int tt = t - 3 + j; if (tt >= 0) y += cw[j * 1024 + c] * bf2f(mlqk[(size_t)(row - 3 + j) * 1024 + c]); }
        y = y * sigmoidf_(y);
        if (c < 512) q2[(size_t)row * 512 + c] = (bf16)f2bf(y); else k2[(size_t)row * 512 + c - 512] = (bf16)f2bf(y * 0.08838834764831845f);
    }
}
__device__ __forceinline__ void ph_kmean(Frame& F, const Args& a) {
    const bf16* mbk = (const bf16*)(a.ws + WS_MBK); float* kmean = (float*)(a.ws + WS_KMEAN);
    for (int idx = blockIdx.x * 512 + F.tid; idx < 8 * 8 * 8 * 64; idx += F.G * 512) {
        const int d = idx & 63, blk = (idx >> 6) & 7, h = (idx >> 9) & 7, b = idx >> 12;
        float s = 0.f;
        for (int i = 0; i < 256; ++i) s += bf2f(mbk[(size_t)(b * SEQ + blk * 256 + i) * 512 + h * 64 + d]);
        kmean[idx] = s * (1.f / 256.f);
    }
}
__device__ __forceinline__ void ph_sb_naive(Frame& F, const Args& a) {
    bf16* sbq = (bf16*)(a.ws + WS_SBQ); const bf16* sbk = (const bf16*)(a.ws + WS_SBK); const bf16* sbv = (const bf16*)(a.ws + WS_SBV);
    for (int idx = blockIdx.x * 512 + F.tid; idx < M * 8; idx += F.G * 512) {
        const int row = idx >> 3, h = idx & 7, t = row & (SEQ - 1), base = row - t;
        float q[64], acc[64]; load64(sbq + (size_t)row * 512 + h * 64, q);
#pragma unroll
        for (int i = 0; i < 64; ++i) acc[i] = 0.f;
        float C = 0.f;
        for (int s = t - 1; s >= 0; --s) {
            const float z = dot64(q, sbk + (size_t)(base + s) * 512 + h * 64);
            const float sp = z > 0.f ? z + __log2f(1.f + exp2f(-z)) : __log2f(1.f + exp2f(z));
            C += sp; const float w = exp2f(z - C);
            axpy64(acc, 1.f, w, sbv + (size_t)(base + s) * 512 + h * 64);
            if (C > 150.f) break;
        }
        store64(sbq + (size_t)row * 512 + h * 64, acc);
    }
}
__device__ __forceinline__ void ph_moba_naive(Frame& F, const Args& a) {
    bf16* mbq = (bf16*)(a.ws + WS_MBQ); const bf16* mbk = (const bf16*)(a.ws + WS_MBK); const bf16* mbv = (const bf16*)(a.ws + WS_MBV); const float* kmean = (const float*)(a.ws + WS_KMEAN);
    for (int idx = blockIdx.x * 512 + F.tid; idx < M * 8; idx += F.G * 512) {
        const int row = idx >> 3, h = idx & 7, t = row & (SEQ - 1), base = row - t, b = row >> 11, own = t >> 8;
        float q[64], acc[64]; load64(mbq + (size_t)row * 512 + h * 64, q);
#pragma unroll
        for (int i = 0; i < 64; ++i) acc[i] = 0.f;
        unsigned sel = 0u;
        {
            float g[8];
#pragma unroll
            for (int blk = 0; blk < 8; ++blk) { float s = 0.f; const float* km = kmean + ((size_t)(b * 8 + h) * 8 + blk) * 64;
#pragma unroll
                for (int i = 0; i < 64; ++i) s += q[i] * km[i];
                g[blk] = blk < own ? s : -INFINITY; }
#pragma unroll
            for (int r = 0; r < 3; ++r) { float best = -INFINITY; int bi = -1;
#pragma unroll
                for (int blk = 0; blk < 8; ++blk) { const bool ok = !((sel >> blk) & 1u) && g[blk] > best; if (ok) { best = g[blk]; bi = blk; } }
                if (bi >= 0) sel |= 1u << bi; }
        }
        sel |= 1u << own;
        float m = -INFINITY, lsum = 0.f;
        for (int blk = 0; blk <= own; ++blk) {
            if (!((sel >> blk) & 1u)) continue;
            const int s1 = blk == own ? t : blk * 256 + 255;
            for (int s = blk * 256; s <= s1; ++s) {
                const float z = dot64(q, mbk + (size_t)(base + s) * 512 + h * 64);
                const float mn = fmaxf(m, z), sc = exp2f(m - mn), p = exp2f(z - mn);
                lsum = lsum * sc + p;
                axpy64(acc, sc, p, mbv + (size_t)(base + s) * 512 + h * 64);
                m = mn;
            }
        }
        const float il = 1.f / lsum;
#pragma unroll
        for (int i = 0; i < 64; ++i) acc[i] *= il;
        store64(mbq + (size_t)row * 512 + h * 64, acc);
    }
}
__device__ __forceinline__ void ph_mlstm_naive(Frame& F, const Args& a) {
    const bf16* q2 = (const bf16*)(a.ws + WS_MLQ2); const bf16* k2 = (const bf16*)(a.ws + WS_MLK2); const bf16* mlv = (const bf16*)(a.ws + WS_MLV); bf16* mlo = (bf16*)(a.ws + WS_MLO);
    const float* ifpre = (const float*)(a.ws + WS_IFPRE);
    for (int unit = blockIdx.x; unit < 32; unit += F.G) {
        const int b = unit >> 2, h = unit & 3, tid = F.tid, e = tid >> 2, dq = tid & 3;
        float Cst[32], nst[32];
#pragma unroll
        for (int j = 0; j < 32; ++j) { Cst[j] = 0.f; nst[j] = 0.f; }
        float m = 0.f;
        for (int t = 0; t < SEQ; ++t) {
            const size_t row = (size_t)b * SEQ + t;
            const float li = ifpre[row * 8 + h], fp = ifpre[row * 8 + 4 + h];
            const float lf = fp >= 0.f ? -log1pf(__expf(-fp)) : fp - log1pf(__expf(fp));
            const float mn = fmaxf(lf + m, li), fd = __expf(lf + m - mn), ii = __expf(li - mn); m = mn;
            const bf16* kp = k2 + row * 512 + h * 128 + dq * 32; const bf16* qp = q2 + row * 512 + h * 128 + dq * 32;
            const float ve = bf2f(mlv[row * 512 + h * 128 + e]) * ii;
            float num = 0.f, den = 0.f;
#pragma unroll
            for (int c4 = 0; c4 < 4; ++c4) {
                const uint4 kv = ((const uint4*)kp)[c4], qv = ((const uint4*)qp)[c4];
                const unsigned ku[4] = {kv.x, kv.y, kv.z, kv.w}, qu[4] = {qv.x, qv.y, qv.z, qv.w};
#pragma unroll
                for (int u = 0; u < 4; ++u) {
                    const float k0 = __uint_as_float(ku[u] << 16), k1 = __uint_as_float(ku[u] & 0xffff0000u), q0 = __uint_as_float(qu[u] << 16), q1 = __uint_as_float(qu[u] & 0xffff0000u);
                    const int j = c4 * 8 + u * 2;
                    Cst[j] = fd * Cst[j] + ve * k0; Cst[j + 1] = fd * Cst[j + 1] + ve * k1;
                    nst[j] = fd * nst[j] + ii * k0; nst[j + 1] = fd * nst[j + 1] + ii * k1;
                    num += Cst[j] * q0 + Cst[j + 1] * q1; den += nst[j] * q0 + nst[j + 1] * q1;
                }
            }
            num += __shfl_xor(num, 1); num += __shfl_xor(num, 2); den += __shfl_xor(den, 1); den += __shfl_xor(den, 2);
            const float o = num / fmaxf(fabsf(den), __expf(-m));
            if (dq == 0) { bf16* op = mlo + row * 512 + h * 128 + e; *op = (bf16)f2bf(o * sigmoidf_(bf2f(*op))); }
        }
    }
}
__device__ __forceinline__ void ph_router(Frame& F, const Args& a, const int l) {
    const float* hin = a.out; const float* g2 = (const float*)a.in[10] + l * DM; const float* w_rg = (const float*)a.in[11] + (size_t)l * DM * 4; const float* b_rg = (const float*)a.in[12] + l * 4;
    const float* w_re = (const float*)a.in[13] + (size_t)l * DM * 32; const float* b_re = (const float*)a.in[14] + l * 32;
    bf16* xn2 = (bf16*)(a.ws + WS_XN2); int* re = (int*)(a.ws + WS_RE); float* rw = (float*)(a.ws + WS_RW);
    const int lane = F.lane, r8 = lane >> 3, part = lane & 7, gw = F.vcu * NWAVES + F.wave, NGW = F.G * NWAVES;
    for (int grp = gw; grp < M / 8; grp += NGW) {
        const int row = grp * 8 + r8;
        const float* xp = hin + (size_t)row * DM + 4 * part; const float* gp = g2 + 4 * part; const float* wgp = w_rg + (size_t)(4 * part) * 4; const float* wep = w_re + (size_t)(4 * part) * 32;
        float lg[36]; float ss = 0.f;
#pragma unroll
        for (int o = 0; o < 36; ++o) lg[o] = 0.f;
#pragma unroll 1
        for (int c = 0; c < 32; ++c) {
            const f32x4 x4 = *(const GAS f32x4*)(xp + 32 * c), g4 = *(const GAS f32x4*)(gp + 32 * c);
            ss += (x4.x * x4.x + x4.y * x4.y) + (x4.z * x4.z + x4.w * x4.w);
            const f32x4 xg = x4 * g4;
#pragma unroll
            for (int u = 0; u < 4; ++u) { const float xv = xg[u];
                const f32x4 wg = *(const GAS f32x4*)(wgp + (size_t)(32 * c + u) * 4); lg[0] += xv * wg.x; lg[1] += xv * wg.y; lg[2] += xv * wg.z; lg[3] += xv * wg.w;
#pragma unroll
                for (int o4 = 0; o4 < 8; ++o4) { const f32x4 we = *(const GAS f32x4*)(wep + (size_t)(32 * c + u) * 32 + o4 * 4);
                    lg[4 + o4 * 4] += xv * we.x; lg[5 + o4 * 4] += xv * we.y; lg[6 + o4 * 4] += xv * we.z; lg[7 + o4 * 4] += xv * we.w; } }
        }
        ss += __shfl_xor(ss, 1); ss += __shfl_xor(ss, 2); ss += __shfl_xor(ss, 4);
        const float r = rsqrtf(ss * (1.f / DM) + RMS_EPS);
#pragma unroll
        for (int o = 0; o < 36; ++o) { float v = lg[o]; v += __shfl_xor(v, 1); v += __shfl_xor(v, 2); v += __shfl_xor(v, 4); lg[o] = v * r; }
        bf16* op = xn2 + (size_t)row * DM + 4 * part;
#pragma unroll 1
        for (int c = 0; c < 32; ++c) {
            const f32x4 x4 = *(const GAS f32x4*)(xp + 32 * c), g4 = *(const GAS f32x4*)(gp + 32 * c); const f32x4 y = x4 * g4 * r;
            *(GAS unsigned long long*)(op + 32 * c) = (unsigned long long)pk2(y.x, y.y) | ((unsigned long long)pk2(y.z, y.w) << 32);
        }
        float gm = -INFINITY; int gi = 0; float gl[4];
#pragma unroll
        for (int i = 0; i < 4; ++i) { gl[i] = lg[i] + b_rg[i]; if (gl[i] > gm) { gm = gl[i]; gi = i; } }
        float gs = 0.f;
#pragma unroll
        for (int i = 0; i < 4; ++i) gs += __expf(gl[i] - gm);
        const float gwt = 1.f / gs;
        float el[8];
#pragma unroll
        for (int j = 0; j < 8; ++j) { const float a0 = lg[4 + j] + b_re[j], a1 = lg[12 + j] + b_re[8 + j], a2 = lg[20 + j] + b_re[16 + j], a3 = lg[28 + j] + b_re[24 + j];
            el[j] = gi == 0 ? a0 : (gi == 1 ? a1 : (gi == 2 ? a2 : a3)); }
        float m1 = -INFINITY; int i1 = 0;
#pragma unroll
        for (int j = 0; j < 8; ++j) if (el[j] > m1) { m1 = el[j]; i1 = j; }
        float m2 = -INFINITY; int i2 = 0;
#pragma unroll
        for (int j = 0; j < 8; ++j) if (j != i1 && el[j] > m2) { m2 = el[j]; i2 = j; }
        const float p2 = __expf(m2 - m1);
        const float w1 = gwt / (1.f + p2), w2 = gwt * p2 / (1.f + p2);
        if (part == 0) { re[row * 2] = gi * 8 + i1; re[row * 2 + 1] = gi * 8 + i2; rw[row * 2] = w1; rw[row * 2 + 1] = w2; }
    }
}
__device__ __forceinline__ void ph_moe_naive(Frame& F, const Args& a, const int l) {
    const bf16* xn2 = (const bf16*)(a.ws + WS_XN2); const int* re = (const int*)(a.ws + WS_RE); const float* rw = (const float*)(a.ws + WS_RW);
    const float* w1 = (const float*)a.in[15] + (size_t)l * 32 * 1024 * 256; const float* w3 = (const float*)a.in[16] + (size_t)l * 32 * 1024 * 256; const float* w2 = (const float*)a.in[17] + (size_t)l * 32 * 256 * 1024;
    float* out = a.out;
    LAS float* xs = (LAS float*)F.lds; LAS float* tmp = xs + 1024; LAS float* hid = tmp + 512;
    const int tid = F.tid;
    for (int row = blockIdx.x; row < M; row += F.G) {
        xs[tid] = bf2f(xn2[(size_t)row * DM + tid]); xs[tid + 512] = bf2f(xn2[(size_t)row * DM + tid + 512]);
        __syncthreads();
        const int f = tid & 255, which = tid >> 8;
        for (int k = 0; k < 2; ++k) {
            const int e = re[row * 2 + k]; const float wgt = rw[row * 2 + k];
            const float* wp = (which ? w3 : w1) + (size_t)e * 1024 * 256 + f;
            float s = 0.f;
            for (int d = 0; d < 1024; ++d) s += xs[d] * wp[(size_t)d * 256];
            tmp[which * 256 + f] = s;
            __syncthreads();
            if (which == 0) { const float av = tmp[f]; hid[k * 256 + f] = av * sigmoidf_(av) * tmp[256 + f] * wgt; }
            __syncthreads();
        }
        const int e0 = re[row * 2], e1 = re[row * 2 + 1];
        for (int c = tid; c < 1024; c += 512) {
            float y = 0.f;
            const float* p0 = w2 + (size_t)e0 * 256 * 1024 + c; const float* p1 = w2 + (size_t)e1 * 256 * 1024 + c;
            for (int ff = 0; ff < 256; ++ff) y += hid[ff] * p0[(size_t)ff * 1024] + hid[256 + ff] * p1[(size_t)ff * 1024];
            out[(size_t)row * DM + c] += y;
        }
        __syncthreads();
    }
}

constexpr int NPH = 9;
template <int l> __device__ __forceinline__ void layer_body(Frame& F, const Args& args, const XcdBarrier& bar, const int plo, const int phi) {
    unsigned char* ws = args.ws;
        const int lo = plo - l * NPH, hi = phi - l * NPH;
#define IN(k) (lo <= (k) && (k) < hi)
#define SEAM(k) do { if ((k) + 1 + l * NPH < phi) xcd_barrier(bar); } while (0)
        const float* xin = l == 0 ? (const float*)args.in[0] : (const float*)args.out;
        if (IN(0)) { p0_prologue(F, args, l, xin); SEAM(0); }
        if (IN(1)) {
            pg8::Gemm g{(const pg8::bf16_t*)(ws + WS_XN), (const pg8::bf16_t*)(ws + WS_WTIN), M, 8192, DM}; pg8::StaticOrder S; S.init(M, 8192, F.G, (int)blockIdx.x);
            pg8::EpiInProj E{ws};
            pg8::gemm_phase<pg8::EpiInProj, pg8::StaticOrder, PG8_ALIGN, PG8_SP2>(F.lds + RING_OFF, g, S, E);
            SEAM(1);
        }
        if (IN(2)) { ph_prep_qk(F, args, l); ph_conv(F, args, l); SEAM(2); }
        if (IN(3)) { ph_kmean(F, args); ph_sb_naive(F, args); SEAM(3); }
        if (IN(4)) { ph_mlstm_naive(F, args); ph_moba_naive(F, args); SEAM(4); }
        if (IN(5)) {
            pg8::Gemm g{(const pg8::bf16_t*)(ws + WS_SBQ), (const pg8::bf16_t*)(ws + WS_WTBR), M, 1024, 512}; pg8::YOrder S{F.vcu, F.G};
            pg8::EpiYMerge E{(const pg8::bf16_t*)(ws + WS_GATES), (pg8::bf16_t*)(ws + WS_MERGED)};
            pg8::gemm_phase<pg8::EpiYMerge, pg8::YOrder, PG8_ALIGN, PG8_SP2>(F.lds + RING_OFF, g, S, E);
            SEAM(5);
        }
        if (IN(6)) {
            pg8::Gemm g{(const pg8::bf16_t*)(ws + WS_MERGED), (const pg8::bf16_t*)(ws + WS_WTOUT), M, DM, DM}; pg8::StaticOrder S; S.init(M, DM, F.G, (int)blockIdx.x);
            pg8::EpiResid32 E{xin, args.out};
            pg8::gemm_phase<pg8::EpiResid32, pg8::StaticOrder, PG8_ALIGN, PG8_SP2>(F.lds + RING_OFF, g, S, E);
            SEAM(6);
        }
        if (IN(7)) { ph_router(F, args, l); SEAM(7); }
        if (IN(8)) { ph_moe_naive(F, args, l); SEAM(8); }
#undef IN
#undef SEAM
}
__global__ void __launch_bounds__(NWAVES * 64, 2) mk(Args args) {
    extern __shared__ __attribute__((aligned(16))) unsigned char lds[];
    Frame F;
    F.lds = (LAS unsigned char*)lds; F.MISC = (volatile LAS unsigned*)(F.lds + MISC_OFF);
    F.tid = threadIdx.x; F.lane = F.tid & 63; F.wave = __builtin_amdgcn_readfirstlane(F.tid >> 6);
    F.G = gridDim.x; { const int bx = blockIdx.x; F.vcu = (F.G % 8 == 0) ? (bx % 8) * (F.G / 8) + bx / 8 : bx; }
    unsigned char* ws = args.ws; F.ctl = (gu32*)(ws + WS_CTL);
    for (int u = F.tid; u < (LDS_BYTES - LDSCTL_OFF) / 4; u += NWAVES * 64) ((LAS unsigned*)(F.lds + LDSCTL_OFF))[u] = 0u;
    __syncthreads();
    const int plo = args.ph_lo, phi = args.ph_hi;
    XcdBarrier bar; bar.bar = (unsigned*)(F.ctl + CW_BAR); bar.x = 0; bar.st = nullptr;
    if (phi - plo > 1) bar = xcd_barrier_post((unsigned*)(F.ctl + CW_BAR), F.MISC + 8);
    layer_body<0>(F, args, bar, plo, phi);
    layer_body<1>(F, args, bar, plo, phi);
}

#ifndef MK_ONE_LAUNCH
#define MK_ONE_LAUNCH 1
#endif
extern "C" void kernel_launch(void* const* d_in, const int* in_sizes, int n_in, void* d_out, int out_size, void* d_ws, size_t ws_size, hipStream_t stream) {
    static int grid = 0;
    if (grid == 0) {
        if (n_in != 18 || out_size != M * DM || ws_size < WS_END) { fprintf(stderr, "kernel_launch: unexpected shapes (n_in %d out %d ws %zu)\n", n_in, out_size, ws_size); grid = -1; return; }
        int dev = 0, cus = 0;
        if (hipGetDevice(&dev) != hipSuccess || hipDeviceGetAttribute(&cus, hipDeviceAttributeMultiprocessorCount, dev) != hipSuccess) { grid = -1; return; }
        if (hipFuncSetAttribute((const void*)mk, hipFuncAttributeMaxDynamicSharedMemorySize, LDS_BYTES) != hipSuccess) { grid = -1; return; }
        int per_cu = 0;
        if (hipOccupancyMaxActiveBlocksPerMultiprocessor(&per_cu, (const void*)mk, NWAVES * 64, LDS_BYTES) != hipSuccess || per_cu < 1) fprintf(stderr, "kernel_launch: occupancy query says %d blocks per CU\n", per_cu);
        (void)hipGetLastError();
        grid = cus;
    }
    if (grid < 0) return;
    (void)hipMemsetAsync((char*)d_ws + WS_CTL, 0, CTL_ZERO_BYTES, stream);
    Args a{};
    for (int i = 0; i < 18; ++i) a.in[i] = d_in[i];
    a.out = (float*)d_out; a.ws = (unsigned char*)d_ws; a.layer = 0;
#if MK_ONE_LAUNCH
    a.ph_lo = 0; a.ph_hi = DEPTH * NPH; hipLaunchKernelGGL(mk, dim3(grid), dim3(NWAVES * 64), LDS_BYTES, stream, a);
#else
    for (int p = 0; p < DEPTH * NPH; ++p) { a.ph_lo = p; a.ph_hi = p + 1; hipLaunchKernelGGL(mk, dim3(grid), dim3(NWAVES * 64), LDS_BYTES, stream, a); }
#endif
}
```

```cpp
#include <hip/hip_runtime.h>
#include <stdint.h>
#include <cstdio>
#include <cmath>

constexpr int BATCH = 8, SEQ = 2048, DM = 1024, M = BATCH * SEQ, W = 512, PIN = 8200, DEPTH = 2;
constexpr float RMS_EPS = 1e-6f;
constexpr float C2 = 0.18033688011112042f;
constexpr size_t MiB = 1u << 20;
constexpr size_t WS_CTL = 0, CTL_ZERO_BYTES = 1 * MiB;
constexpr size_t WS_IFPRE = 1 * MiB, WS_KMEAN = WS_IFPRE + 512 * 1024, WS_RE = WS_KMEAN + 128 * 1024, WS_RW = WS_RE + 128 * 1024;
constexpr size_t WS_XN = 4 * MiB, WS_WTIN = 36 * MiB;
constexpr size_t WS_SBQ = 52 * MiB, WS_SBK = 68 * MiB, WS_SBV = 84 * MiB, WS_MBQ = 100 * MiB, WS_MBK = 116 * MiB, WS_MBV = 132 * MiB;
constexpr size_t WS_MLO = 148 * MiB, WS_MLV = 164 * MiB, WS_MLQK = 180 * MiB, WS_GATES = 212 * MiB;
constexpr size_t WS_WTBR = 308 * MiB, WS_WTOUT = 311 * MiB, WS_END = 313 * MiB;
constexpr size_t WS_MLQ2 = WS_XN, WS_MLK2 = WS_XN + 16 * MiB, WS_MERGED = WS_MLQK, WS_XN2 = WS_XN;
constexpr size_t WS_WT13 = 52 * MiB, WS_WT2 = 84 * MiB, WS_XS = 100 * MiB, WS_HS = 181 * MiB, WS_YP = 202 * MiB;
constexpr size_t WS_SPAIR = 2 * MiB, WS_SW = 2 * MiB + 256 * 1024, WS_RANK = 2 * MiB + 512 * 1024;
constexpr int CW_CNT = 8192;
__device__ __forceinline__ int lane_id() { int x; asm volatile("v_mbcnt_lo_u32_b32 %0, -1, 0\n\tv_mbcnt_hi_u32_b32 %0, -1, %0" : "=v"(x)); return x; }
namespace pg8 {
#define PG8_LAS __attribute__((address_space(3)))
typedef unsigned short bf16_t;
typedef short bf16x8 __attribute__((ext_vector_type(8)));
typedef float f32x4 __attribute__((ext_vector_type(4)));
typedef unsigned u32x4 __attribute__((ext_vector_type(4)));
constexpr int BM = 256, BK = 64, HALF = 128, HTB = HALF * BK * 2  , STAGE_BYTES = 8 * HTB, NXCD = 8, WGM = 8;

__host__ __device__ __forceinline__ int lds_byte(int r, int c) { const int st = (r >> 4) * 2 + (c >> 5), rr = r & 15, cc = c & 31, ob = rr * 64 + cc * 2; return st * 1024 + (ob ^ (((ob >> 9) & 1) << 5)); }
__host__ __device__ __forceinline__ void stage_rc(int b, int& R, int& C) { const int st = b / 1024, sb = b % 1024, swz = sb ^ (((sb >> 9) & 1) << 5); R = (st >> 1) * 16 + swz / 64; C = (st & 1) * 32 + (swz % 64) / 2; }
__host__ __device__ __forceinline__ int perm32(int rho) { const int n = rho >> 4, i = rho & 15; return 8 * (i >> 2) + 4 * n + (i & 3); }

struct Unit { int pm, pn; };
struct Gemm { const bf16_t* A; const bf16_t* Bt; int M, N, K; };

struct StaticOrder {
    int nM, nN, nwg, G, c;
    __host__ __device__ void init(int M, int N, int G_, int c_) { nM = M / BM; nN = N / BM; nwg = nM * nN; G = G_; c = c_; }
    __host__ __device__ bool next(int i, Unit& u) const {
        const long L = (long)i * G + c; if (L >= nwg) return false;
        int wgid = (int)L; { const int q = nwg / NXCD, r = nwg % NXCD, xcd = wgid % NXCD, off = wgid / NXCD; wgid = (xcd < r ? xcd * (q + 1) : r * (q + 1) + (xcd - r) * q) + off; }
        const int nig = WGM * nN, gid = wgid / nig, fm = gid * WGM, gsz = (nM - fm) < WGM ? (nM - fm) : WGM;
        u.pm = fm + ((wgid % nig) % gsz); u.pn = (wgid % nig) / gsz; return true;
    }
    __device__ __forceinline__ void a_ready(const Unit&) const {}
    __device__ __forceinline__ void done(const Unit&) const {}
};

__device__ __forceinline__ unsigned cvt_pk_bf16(float lo, float hi) { unsigned r; asm volatile("v_cvt_pk_bf16_f32 %0, %1, %2" : "=v"(r) : "v"(lo), "v"(hi)); return r; }
typedef float f32x2 __attribute__((ext_vector_type(2)));
__device__ __forceinline__ float fast_sigmoid(float x) { return __builtin_amdgcn_rcpf(1.0f + __expf(-x)); }
struct EpiInProj {
    static constexpr bool PERM = true, AFTER_DRAIN = false;
    unsigned char* ws;
    __device__ __forceinline__ void operator()(const f32x4 (&acc)[2][2][4][2], const Unit& u, int wr, int wc, int fr, int fq) const {
        const int pn = u.pn; bf16_t* base; int ldc, colt; float sc = 1.f; bool sig = false;
        if (pn < 12) { base = (bf16_t*)(ws + WS_SBQ) + (size_t)(pn >> 1) * (8u << 20); ldc = 512; colt = (pn & 1) * 256; if (pn < 2) sc = C2; }
        else if (pn < 14) { base = (bf16_t*)(ws + WS_MLO); ldc = 512; colt = (pn & 1) * 256; }
        else if (pn < 16) { base = (bf16_t*)(ws + WS_MLV); ldc = 512; colt = (pn & 1) * 256; }
        else if (pn < 20) { base = (bf16_t*)(ws + WS_MLQK); ldc = 1024; colt = (pn - 16) * 256; }
        else { base = (bf16_t*)(ws + WS_GATES); ldc = 3072; colt = (pn - 20) * 256; sig = true; }
        const int row0 = u.pm * BM + wr * 64 + fr, col0 = colt + wc * 32 + 8 * fq;
#pragma unroll
        for (int ai = 0; ai < 2; ++ai)
#pragma unroll
            for (int m = 0; m < 4; ++m) { bf16_t* rowp = base + (size_t)(row0 + ai * HALF + m * 16) * ldc + col0;
#pragma unroll
                for (int bj = 0; bj < 2; ++bj) { f32x4 v0 = acc[ai][bj][m][0], v1 = acc[ai][bj][m][1];
                    if (sig) { v0 = (f32x4){fast_sigmoid(v0[0]), fast_sigmoid(v0[1]), fast_sigmoid(v0[2]), fast_sigmoid(v0[3])}; v1 = (f32x4){fast_sigmoid(v1[0]), fast_sigmoid(v1[1]), fast_sigmoid(v1[2]), fast_sigmoid(v1[3])}; }
                    else { v0 = v0 * sc; v1 = v1 * sc; }
                    u32x4 w; w.x = cvt_pk_bf16(v0[0], v0[1]); w.y = cvt_pk_bf16(v0[2], v0[3]); w.z = cvt_pk_bf16(v1[0], v1[1]); w.w = cvt_pk_bf16(v1[2], v1[3]);
                    *(u32x4*)(rowp + bj * HALF) = w; } }
    }
};
struct EpiYMerge {
    static constexpr bool PERM = true, AFTER_DRAIN = false;
    const bf16_t* gates; bf16_t* merged;
    __device__ __forceinline__ void operator()(const f32x4 (&acc)[2][2][4][2], const Unit& u, int wr, int wc, int fr, int fq) const {
        const int n = u.pn >> 2, pn = u.pn & 3, pm = u.pm - 192 * n;
        const int row0 = pm * BM + wr * 64 + fr, col0 = pn * BM + wc * 32 + 8 * fq;
#pragma unroll
        for (int ai = 0; ai < 2; ++ai)
#pragma unroll
            for (int m = 0; m < 4; ++m) { const size_t r = (size_t)(row0 + ai * HALF + m * 16);
#pragma unroll
                for (int bj = 0; bj < 2; ++bj) { const int c = col0 + bj * HALF;
                    const u32x4 gv = *(const u32x4*)(gates + r * 3072 + n * 1024 + c);
                    f32x4 v0 = acc[ai][bj][m][0], v1 = acc[ai][bj][m][1];
                    v0[0] *= __uint_as_float(gv.x << 16); v0[1] *= __uint_as_float(gv.x & 0xffff0000u); v0[2] *= __uint_as_float(gv.y << 16); v0[3] *= __uint_as_float(gv.y & 0xffff0000u);
                    v1[0] *= __uint_as_float(gv.z << 16); v1[1] *= __uint_as_float(gv.z & 0xffff0000u); v1[2] *= __uint_as_float(gv.w << 16); v1[3] *= __uint_as_float(gv.w & 0xffff0000u);
                    bf16_t* mp = merged + r * 1024 + c;
                    if (n > 0) { const u32x4 pv = *(const u32x4*)mp;
                        v0[0] += __uint_as_float(pv.x << 16); v0[1] += __uint_as_float(pv.x & 0xffff0000u); v0[2] += __uint_as_float(pv.y << 16); v0[3] += __uint_as_float(pv.y & 0xffff0000u);
                        v1[0] += __uint_as_float(pv.z << 16); v1[1] += __uint_as_float(pv.z & 0xffff0000u); v1[2] += __uint_as_float(pv.w << 16); v1[3] += __uint_as_float(pv.w & 0xffff0000u); }
                    u32x4 w; w.x = cvt_pk_bf16(v0[0], v0[1]); w.y = cvt_pk_bf16(v0[2], v0[3]); w.z = cvt_pk_bf16(v1[0], v1[1]); w.w = cvt_pk_bf16(v1[2], v1[3]);
                    *(u32x4*)mp = w; } }
    }
};
struct YOrder {
    int vcu, G;
    __device__ __forceinline__ bool next(int i, Unit& u) const { const int j = i / 3, n = i - 3 * j, tile = vcu + G * j; if (tile >= 256) return false; u.pm = (tile >> 2) + 192 * n; u.pn = (tile & 3) + 4 * n; return true; }
    __device__ __forceinline__ void a_ready(const Unit&) const {}
    __device__ __forceinline__ void done(const Unit&) const {}
};
struct EpiResid32 {
    static constexpr bool PERM = false, AFTER_DRAIN = false;
    const float* xin; float* out;
    __device__ __forceinline__ void operator()(const f32x4 (&acc)[2][2][4][2], const Unit& u, int wr, int wc, int fr, int fq) const {
        const int row0 = u.pm * BM + wr * 64 + fr, col0 = u.pn * BM + wc * 32 + 4 * fq;
#pragma unroll
        for (int ai = 0; ai < 2; ++ai)
#pragma unroll
            for (int m = 0; m < 4; ++m) { const size_t off = (size_t)(row0 + ai * HALF + m * 16) * 1024 + col0;
#pragma unroll
                for (int bj = 0; bj < 2; ++bj)
#pragma unroll
                    for (int n = 0; n < 2; ++n) { const f32x4 xv = *(const f32x4*)(xin + off + bj * HALF + n * 16); *(f32x4*)(out + off + bj * HALF + n * 16) = xv + acc[ai][bj][m][n]; } }
    }
};

struct EpiSwiGLU {
    static constexpr bool PERM = true, AFTER_DRAIN = false;
    bf16_t* Hs;
    __device__ __forceinline__ void operator()(const f32x4 (&acc)[2][2][4][2], const Unit& u, int wr, int wc, int fr, int fq) const {
        const int j = u.pn & 1; const int row0 = u.pm * BM + wr * 64 + fr, col0 = j * 128 + wc * 32 + 8 * fq;
#pragma unroll
        for (int ai = 0; ai < 2; ++ai)
#pragma unroll
            for (int m = 0; m < 4; ++m) { bf16_t* rowp = Hs + (size_t)(row0 + ai * HALF + m * 16) * 256 + col0;
                f32x4 h0, h1;
#pragma unroll
                for (int t = 0; t < 4; ++t) { const float a0 = acc[ai][0][m][0][t], a1 = acc[ai][0][m][1][t]; h0[t] = a0 * fast_sigmoid(a0) * acc[ai][1][m][0][t]; h1[t] = a1 * fast_sigmoid(a1) * acc[ai][1][m][1][t]; }
                u32x4 w; w.x = cvt_pk_bf16(h0[0], h0[1]); w.y = cvt_pk_bf16(h0[2], h0[3]); w.z = cvt_pk_bf16(h1[0], h1[1]); w.w = cvt_pk_bf16(h1[2], h1[3]);
                *(u32x4*)rowp = w; }
    }
};
struct EpiMoeOut {
    static constexpr bool PERM = true, AFTER_DRAIN = false;
    bf16_t* Yp; const int* spair; const float* sw; const PG8_LAS int* panelValid;
    __device__ __forceinline__ void operator()(const f32x4 (&acc)[2][2][4][2], const Unit& u, int wr, int wc, int fr, int fq) const {
        const int jn = u.pn & 3, valid = panelValid[u.pm]; const int rl0 = wr * 64 + fr, col0 = jn * 256 + wc * 32 + 8 * fq;
#pragma unroll
        for (int ai = 0; ai < 2; ++ai)
#pragma unroll
            for (int m = 0; m < 4; ++m) { const int rl = rl0 + ai * HALF + m * 16;
                if (rl < valid) { const int slot = u.pm * BM + rl; const int pair = spair[slot]; const float w = sw[slot]; bf16_t* rowp = Yp + (size_t)pair * 1024 + col0;
#pragma unroll
                    for (int bj = 0; bj < 2; ++bj) { const f32x4 v0 = acc[ai][bj][m][0] * w, v1 = acc[ai][bj][m][1] * w;
                        u32x4 o; o.x = cvt_pk_bf16(v0[0], v0[1]); o.y = cvt_pk_bf16(v0[2], v0[3]); o.z = cvt_pk_bf16(v1[0], v1[1]); o.w = cvt_pk_bf16(v1[2], v1[3]);
                        *(u32x4*)(rowp + bj * HALF) = o; } } }
    }
};
struct MoeOrder {
    int vcu, G, P, nper; const PG8_LAS int* panelE;
    __device__ __forceinline__ bool next(int i, Unit& u) const { const int idx = vcu + G * i; if (idx >= nper * P) return false; const int p = idx / nper, j = idx - p * nper; u.pm = p; u.pn = panelE[p] * nper + j; return true; }
    __device__ __forceinline__ void a_ready(const Unit&) const {}
    __device__ __forceinline__ void done(const Unit&) const {}
};
template <class Epi, class Sched, bool ALIGN_EPI = false, bool SP2 = false>
__device__ __forceinline__ void gemm_phase(PG8_LAS unsigned char* lds, const Gemm g, const Sched& S, const Epi& E, const int wid) {
    const int lane = lane_id(), tid = wid * 64 + lane, wr = wid >> 2, wc = wid & 3, fr = lane & 15, fq = lane >> 4;
    const int K = g.K, nt = K / BK;
    unsigned voffA[2], voffB[2];
#pragma unroll
    for (int i = 0; i < 2; ++i) { int R, C; stage_rc(tid * 16 + i * 8192, R, C); const int Rb = Epi::PERM ? ((R & ~31) + perm32(R & 31)) : R;
        voffA[i] = (unsigned)(R * K + C) * 2u; voffB[i] = (unsigned)(Rb * K + C) * 2u; }
    const size_t kstep = (size_t)(BK * 2);
    const size_t hstep = (size_t)HALF * K * 2;
    const size_t tstep = 2 * hstep;
    const unsigned ldsw = (unsigned)wid * 1024u;
    const int aoff = lds_byte(wr * 64 + fr, fq * 8), boff = lds_byte(wc * 32 + fr, fq * 8);
#define PG8_SA(b, h) (((b) * 2 + (h)) * HTB)
#define PG8_SB(b, h) ((4 + (b) * 2 + (h)) * HTB)
#define PG8_STAGE(bufoff, gbase, voff) do { _Pragma("unroll") for (int _i = 0; _i < 2; ++_i) \
        __builtin_amdgcn_global_load_lds((const unsigned*)((const char*)(gbase) + (voff)[_i]), (PG8_LAS unsigned*)(lds + (bufoff) + ldsw + _i * 8192), 16, 0, 0); } while (0)
#define PG8_LDA(dst, b, h) do { _Pragma("unroll") for (int m = 0; m < 4; ++m) _Pragma("unroll") for (int k = 0; k < 2; ++k) dst[m][k] = *(const PG8_LAS bf16x8*)(lds + PG8_SA(b, h) + aoff + m * 2048 + k * 1024); } while (0)
#define PG8_LDB(dst, b, h) do { _Pragma("unroll") for (int n = 0; n < 2; ++n) _Pragma("unroll") for (int k = 0; k < 2; ++k) dst[n][k] = *(const PG8_LAS bf16x8*)(lds + PG8_SB(b, h) + boff + n * 2048 + k * 1024); } while (0)
#define PG8_MMA(ai, bj, At, Bt) do { __builtin_amdgcn_s_setprio(1); _Pragma("unroll") for (int m = 0; m < 4; ++m) _Pragma("unroll") for (int n = 0; n < 2; ++n) _Pragma("unroll") for (int k = 0; k < 2; ++k) \
        acc[ai][bj][m][n] = __builtin_amdgcn_mfma_f32_16x16x32_bf16(Bt[n][k], At[m][k], acc[ai][bj][m][n], 0, 0, 0); __builtin_amdgcn_s_setprio(0); } while (0)
#define PG8_WAIT_V(n) asm volatile("s_waitcnt vmcnt(" #n ")" ::: "memory")
#define PG8_WAIT_L(n) asm volatile("s_waitcnt lgkmcnt(" #n ")" ::: "memory")
#define PG8_BAR __builtin_amdgcn_s_barrier()
#define PG8_SCHED __builtin_amdgcn_sched_barrier(0)
    Unit cur, nxt; int ui = 0;
    if (!S.next(0, cur)) return;
    f32x4 acc[2][2][4][2];
#pragma unroll
    for (int a = 0; a < 2; ++a)
#pragma unroll
        for (int b = 0; b < 2; ++b)
#pragma unroll
            for (int m = 0; m < 4; ++m)
#pragma unroll
                for (int n = 0; n < 2; ++n) acc[a][b][m][n] = (f32x4){0.f, 0.f, 0.f, 0.f};
    bf16x8 At[4][2], B0[2][2], B1[2][2];
    const char* cA = (const char*)g.A + (size_t)cur.pm * tstep; const char* cB = (const char*)g.Bt + (size_t)cur.pn * tstep;
    S.a_ready(cur);
    if constexpr (SP2) {
        PG8_STAGE(PG8_SB(0, 0), cB, voffB); PG8_STAGE(PG8_SB(0, 1), cB + hstep, voffB); PG8_STAGE(PG8_SA(0, 0), cA, voffA); PG8_STAGE(PG8_SA(0, 1), cA + hstep, voffA);
        if (wr == 1) PG8_BAR;
        PG8_WAIT_V(2); PG8_BAR;
        PG8_STAGE(PG8_SB(1, 0), cB + kstep, voffB); PG8_STAGE(PG8_SA(1, 0), cA + kstep, voffA); PG8_STAGE(PG8_SB(1, 1), cB + hstep + kstep, voffB);
        PG8_WAIT_V(6); PG8_BAR;
    } else {
        PG8_STAGE(PG8_SB(0, 0), cB, voffB); PG8_STAGE(PG8_SA(0, 0), cA, voffA); PG8_STAGE(PG8_SB(0, 1), cB + hstep, voffB); PG8_STAGE(PG8_SA(0, 1), cA + hstep, voffA);
        if (wr == 1) PG8_BAR;
        PG8_WAIT_V(4); PG8_BAR;
        PG8_STAGE(PG8_SB(1, 0), cB + kstep, voffB); PG8_STAGE(PG8_SA(1, 0), cA + kstep, voffA); PG8_STAGE(PG8_SB(1, 1), cB + hstep + kstep, voffB);
        PG8_WAIT_V(6); PG8_BAR;
    }
    for (;;) {
        const bool has_next = S.next(ui + 1, nxt);
        const char* nA = has_next ? (const char*)g.A + (size_t)nxt.pm * tstep : cA; const char* nB = has_next ? (const char*)g.Bt + (size_t)nxt.pn * tstep : cB;
        for (int t = 0; t < nt; t += 2) {
            const bool last = (t == nt - 2);
            const char* a1 = cA + (size_t)(t + 1) * kstep;
            const char* a2 = last ? nA : cA + (size_t)(t + 2) * kstep; const char* b2 = last ? nB : cB + (size_t)(t + 2) * kstep;
            const char* a3 = a2 + kstep; const char* b3 = b2 + kstep;
            if (last && has_next) S.a_ready(nxt);
            if constexpr (SP2) {
            PG8_LDB(B0, 0, 0); PG8_LDB(B1, 0, 1); PG8_SCHED; PG8_LDA(At, 0, 0); PG8_STAGE(PG8_SA(1, 1), a1 + hstep, voffA);
            PG8_WAIT_V(8); PG8_WAIT_L(0); PG8_BAR; PG8_MMA(0, 0, At, B0); PG8_MMA(0, 1, At, B1); PG8_BAR; PG8_SCHED;
            PG8_LDA(At, 0, 1); PG8_STAGE(PG8_SB(0, 0), b2, voffB); PG8_STAGE(PG8_SB(0, 1), b2 + hstep, voffB); PG8_STAGE(PG8_SA(0, 0), a2, voffA);
            PG8_WAIT_V(8); PG8_WAIT_L(0); PG8_BAR; PG8_MMA(1, 0, At, B0); PG8_MMA(1, 1, At, B1); PG8_BAR; PG8_SCHED;
            PG8_LDB(B0, 1, 0); PG8_LDB(B1, 1, 1); PG8_SCHED; PG8_LDA(At, 1, 0); PG8_STAGE(PG8_SA(0, 1), a2 + hstep, voffA);
            PG8_WAIT_V(8); PG8_WAIT_L(0); PG8_BAR; PG8_MMA(0, 0, At, B0); PG8_MMA(0, 1, At, B1); PG8_BAR; PG8_SCHED;
            PG8_LDA(At, 1, 1); PG8_STAGE(PG8_SB(1, 0), b3, voffB); PG8_STAGE(PG8_SB(1, 1), b3 + hstep, voffB); PG8_STAGE(PG8_SA(1, 0), a3, voffA);
            PG8_WAIT_V(8); PG8_WAIT_L(0); PG8_BAR; PG8_MMA(1, 0, At, B0); PG8_MMA(1, 1, At, B1); PG8_BAR; PG8_SCHED;
            } else {
            PG8_LDB(B0, 0, 0); PG8_SCHED; PG8_LDA(At, 0, 0); PG8_STAGE(PG8_SA(1, 1), a1 + hstep, voffA);
            PG8_WAIT_L(8); PG8_BAR; PG8_WAIT_L(0); PG8_MMA(0, 0, At, B0); PG8_BAR; PG8_SCHED;
            PG8_LDB(B1, 0, 1); PG8_STAGE(PG8_SB(0, 0), b2, voffB);
            PG8_BAR; PG8_WAIT_L(0); PG8_MMA(0, 1, At, B1); PG8_BAR;
            PG8_LDA(At, 0, 1); PG8_STAGE(PG8_SA(0, 0), a2, voffA);
            PG8_BAR; PG8_WAIT_L(0); PG8_MMA(1, 0, At, B0); PG8_BAR; PG8_SCHED;
            PG8_STAGE(PG8_SB(0, 1), b2 + hstep, voffB);
            PG8_WAIT_V(6); PG8_BAR; PG8_MMA(1, 1, At, B1); PG8_BAR;
            PG8_LDB(B0, 1, 0); PG8_SCHED; PG8_LDA(At, 1, 0); PG8_STAGE(PG8_SA(0, 1), a2 + hstep, voffA);
            PG8_WAIT_L(8); PG8_BAR; PG8_WAIT_L(0); PG8_MMA(0, 0, At, B0); PG8_BAR; PG8_SCHED;
            PG8_LDB(B1, 1, 1); PG8_STAGE(PG8_SB(1, 0), b3, voffB);
            PG8_BAR; PG8_WAIT_L(0); PG8_MMA(0, 1, At, B1); PG8_BAR;
            PG8_LDA(At, 1, 1); PG8_STAGE(PG8_SA(1, 0), a3, voffA);
            PG8_BAR; PG8_WAIT_L(0); PG8_MMA(1, 0, At, B0); PG8_BAR; PG8_SCHED;
            PG8_STAGE(PG8_SB(1, 1), b3 + hstep, voffB);
            PG8_WAIT_V(6); PG8_BAR; PG8_MMA(1, 1, At, B1); PG8_BAR;
            }
        }
        if constexpr (ALIGN_EPI) { if (wr == 0) PG8_BAR; }
        if constexpr (!Epi::AFTER_DRAIN) { E(acc, cur, wr, wc, fr, fq); S.done(cur); }
        if (!has_next) break;
#pragma unroll
        for (int a = 0; a < 2; ++a)
#pragma unroll
            for (int b = 0; b < 2; ++b)
#pragma unroll
                for (int m = 0; m < 4; ++m)
#pragma unroll
                    for (int n = 0; n < 2; ++n) acc[a][b][m][n] = (f32x4){0.f, 0.f, 0.f, 0.f};
        cur = nxt; cA = nA; cB = nB; ++ui;
        if constexpr (ALIGN_EPI) { if (wr == 1) PG8_BAR; }
    }
    PG8_WAIT_V(0);
    if constexpr (!ALIGN_EPI) { if (wr == 0) PG8_BAR; }
    PG8_BAR;
    if constexpr (Epi::AFTER_DRAIN) { E.fused(acc, cur, wr, wc, fr, fq, lds, wid, lane); S.done(cur); }
#undef PG8_SA
#undef PG8_SB
#undef PG8_STAGE
#undef PG8_LDA
#undef PG8_LDB
#undef PG8_MMA
#undef PG8_WAIT_V
#undef PG8_WAIT_L
#undef PG8_BAR
#undef PG8_SCHED
}
}

#ifndef PG8_SP2
#define PG8_SP2 true
#endif
#ifndef PG8_ALIGN
#define PG8_ALIGN true
#endif
#define GAS __attribute__((address_space(1)))
#define LAS __attribute__((address_space(3)))
typedef unsigned short bf16;
typedef unsigned v4u __attribute__((ext_vector_type(4)));
typedef float f32x4 __attribute__((ext_vector_type(4)));
typedef short bf16x8 __attribute__((ext_vector_type(8)));
typedef GAS unsigned gu32;
typedef GAS unsigned long long gu64;
#define RLX_AGENT __ATOMIC_RELAXED, __HIP_MEMORY_SCOPE_AGENT
#define LDS_WAIT() asm volatile("s_waitcnt lgkmcnt(0)" ::: "memory")
#define VM_WAIT() asm volatile("s_waitcnt vmcnt(0)" ::: "memory")
__device__ __forceinline__ unsigned long long rt() { return __builtin_amdgcn_s_memrealtime(); }
__device__ __forceinline__ unsigned f2bf(float f) { unsigned u = __builtin_bit_cast(unsigned, f); return (u + 0x7fffu + ((u >> 16) & 1u)) >> 16; }
__device__ __forceinline__ unsigned pk2(float lo, float hi) { return f2bf(lo) | (f2bf(hi) << 16); }

#define XB_TMO      128
#define XB_XCNT(j)  (256  + 64 * (j))
#define XB_XSUB(j)  (1280 + 64 * (j))
#define XB_XGEN(j)  (2304 + 64 * (j))
#define XB_TOP      3328
#define XB_TOPGEN   3392
#define XCD_BAR_WORDS 3456
#define XB_SPIN_CAP (1u << 18)

__device__ __forceinline__ unsigned xb_ld(unsigned* p)              { return __hip_atomic_load(p, __ATOMIC_RELAXED, __HIP_MEMORY_SCOPE_AGENT); }
__device__ __forceinline__ unsigned xb_add(unsigned* p, unsigned v) { return __hip_atomic_fetch_add(p, v, __ATOMIC_RELAXED, __HIP_MEMORY_SCOPE_AGENT); }
__device__ __forceinline__ unsigned xb_xcc_id() { return (unsigned)__builtin_amdgcn_s_getreg((3 << 11) | 20) & 0xFu; }
#define XB_SPIN(cond, bar) do { unsigned _sp = 0; while (cond) { __builtin_amdgcn_s_sleep(1); \
    if ((++_sp & 255u) == 0u) { if (xb_ld(&(bar)[XB_TMO])) break; if (_sp > XB_SPIN_CAP) { atomicAdd(&(bar)[XB_TMO], 1u); break; } } } } while (0)

struct XcdBarrier {
    unsigned* bar; unsigned x; unsigned w;
    volatile LAS unsigned* st;
};

__device__ __forceinline__ XcdBarrier xcd_barrier_post(unsigned* bar, volatile LAS unsigned* st, unsigned wave) {
    XcdBarrier b; b.bar = bar; b.x = xb_xcc_id(); b.st = st; b.w = wave;
    if (wave == 0u && lane_id() == 0) (void)xb_add(&bar[XB_XCNT(b.x)], 1u);
    return b;
}
__device__ __forceinline__ void xcd_barrier_complete(unsigned* bar, unsigned x, unsigned& nloc, unsigned& nx) {
    const unsigned G = gridDim.x * gridDim.y * gridDim.z;
    unsigned sum, cnt, mine, sp = 0u;
    for (;;) {
        sum = 0u; cnt = 0u; mine = 0u;
#pragma unroll
        for (unsigned j = 0; j < 16; ++j) { const unsigned c = xb_ld(&bar[XB_XCNT(j)]); sum += c; cnt += (c > 0u) ? 1u : 0u; mine = (j == x) ? c : mine; }
        if (sum == G) break;
        __builtin_amdgcn_s_sleep(1);
        if ((++sp & 255u) == 0u) { if (xb_ld(&bar[XB_TMO])) break; if (sp > XB_SPIN_CAP) { atomicAdd(&bar[XB_TMO], 1u); break; } }
    }
    nloc = mine > 0u ? mine : 1u; nx = cnt > 0u ? cnt : 1u;
}

__device__ __forceinline__ void xcd_barrier(const XcdBarrier& b) {
    asm volatile("s_waitcnt vmcnt(0)" ::: "memory");
    __syncthreads();
    if (b.w == 0u && lane_id() == 0) {
        unsigned* bar = b.bar;
        __builtin_amdgcn_s_waitcnt(0);
        unsigned nloc = b.st[0], nx = b.st[1];
        if (nloc == 0u) { xcd_barrier_complete(bar, b.x, nloc, nx); b.st[0] = nloc; b.st[1] = nx; }
        const unsigned old = xb_add(&bar[XB_XSUB(b.x)], 1u);
        const unsigned gen = old / nloc;
        if (old + 1u == (gen + 1u) * nloc) {
            __builtin_amdgcn_fence(__ATOMIC_RELEASE, "agent");
            asm volatile("s_waitcnt vmcnt(0)" ::: "memory");
            const unsigned og = xb_add(&bar[XB_TOP], 1u);
            const unsigned tg = og / nx;
            if (og + 1u == (tg + 1u) * nx) xb_add(&bar[XB_TOPGEN], 1u);
            else XB_SPIN(xb_ld(&bar[XB_TOPGEN]) == tg, bar);
            __builtin_amdgcn_fence(__ATOMIC_ACQUIRE, "agent");
            xb_add(&bar[XB_XGEN(b.x)], 1u);
            asm volatile("s_waitcnt vmcnt(0)" ::: "memory");
        } else {
            XB_SPIN(xb_ld(&bar[XB_XGEN(b.x)]) == gen, bar);
            __builtin_amdgcn_fence(__ATOMIC_ACQUIRE, "agent");
            asm volatile("s_waitcnt vmcnt(0)" ::: "memory");
        }
    }
    __syncthreads();
}
__device__ __forceinline__ float bf2f(bf16 v) { return __uint_as_float((unsigned)v << 16); }
__device__ __forceinline__ float sigmoidf_(float x) { return 1.0f / (1.0f + __expf(-x)); }
__device__ __forceinline__ float wave_sum(float v) {
#pragma unroll
    for (int o = 1; o < 64; o <<= 1) v += __shfl_xor(v, o);
    return v;
}
__device__ __forceinline__ void load64(const bf16* p, float (&x)[64]) {
#pragma unroll
    for (int i = 0; i < 8; ++i) { const uint4 v = ((const uint4*)p)[i];
        x[8 * i + 0] = __uint_as_float(v.x << 16); x[8 * i + 1] = __uint_as_float(v.x & 0xffff0000u);
        x[8 * i + 2] = __uint_as_float(v.y << 16); x[8 * i + 3] = __uint_as_float(v.y & 0xffff0000u);
        x[8 * i + 4] = __uint_as_float(v.z << 16); x[8 * i + 5] = __uint_as_float(v.z & 0xffff0000u);
        x[8 * i + 6] = __uint_as_float(v.w << 16); x[8 * i + 7] = __uint_as_float(v.w & 0xffff0000u); }
}
__device__ __forceinline__ void store64(bf16* p, const float (&x)[64]) {
#pragma unroll
    for (int i = 0; i < 8; ++i) { uint4 v;
        v.x = pk2(x[8 * i + 0], x[8 * i + 1]); v.y = pk2(x[8 * i + 2], x[8 * i + 3]); v.z = pk2(x[8 * i + 4], x[8 * i + 5]); v.w = pk2(x[8 * i + 6], x[8 * i + 7]);
        ((uint4*)p)[i] = v; }
}
typedef unsigned v2u __attribute__((ext_vector_type(2)));
constexpr int NWAVES = 8;
constexpr int RING_OFF = 0, RING_BYTES = 131072, LDSCTL_OFF = RING_BYTES, MISC_OFF = LDSCTL_OFF + 320, LDS_BYTES = 147456;
constexpr int CW_TMO = 0, CW_CODE = 1, CW_BAR = 4096;
struct Args { const void* in[18]; float* out; unsigned char* ws; int layer, ph_lo, ph_hi, pad; };
struct Frame {
    LAS unsigned char* lds; volatile LAS unsigned* MISC; gu32* ctl;
    int wave, vcu, G;
};
__device__ __forceinline__ void tr_item(const float* src, int ld, int k0, int nsrc0, bf16* dst, int Kdim, int ndst0, LAS float* scr, int lane) {
#pragma unroll 8
    for (int i = 0; i < 32; ++i) { const int kk = 2 * i + (lane >> 5); scr[kk * 33 + (lane & 31)] = src[(size_t)(k0 + kk) * ld + nsrc0 + (lane & 31)]; }
    LDS_WAIT(); asm volatile("" ::: "memory");
    const int c = lane & 7;
#pragma unroll
    for (int j = 0; j < 4; ++j) { const int n = (lane >> 3) + 8 * j; const LAS float* s = scr + (8 * c) * 33 + n;
        v4u o; o.x = pk2(s[0 * 33], s[1 * 33]); o.y = pk2(s[2 * 33], s[3 * 33]); o.z = pk2(s[4 * 33], s[5 * 33]); o.w = pk2(s[6 * 33], s[7 * 33]);
        *(GAS v4u*)(dst + (size_t)(ndst0 + n) * Kdim + k0 + 8 * c) = o; }
    LDS_WAIT(); asm volatile("" ::: "memory");
}
__device__ __forceinline__ int win_remap(int nd) { return nd < 3072 ? nd : (nd < 3584 ? nd + 1536 : (nd < 4096 ? nd + 512 : (nd < 5120 ? nd - 1024 : nd + 8))); }

template <bool ADD_MOE> __device__ __forceinline__ void p0_prologue(Frame& F, const Args& a, const int l, const float* xin) {
    const int LANE_ = lane_id(), TID_ = F.wave * 64 + LANE_; (void)TID_;
    LAS float* scr = (LAS float*)(F.lds + RING_OFF + F.wave * 16384);
    const int gw = F.vcu * NWAVES + F.wave, NGW = F.G * NWAVES;
    const float* w_in = (const float*)a.in[3] + (size_t)l * DM * PIN; const float* w_br = (const float*)a.in[8] + (size_t)l * 3 * 512 * 1024; const float* w_out = (const float*)a.in[9] + (size_t)l * DM * DM;
    bf16* WT_IN = (bf16*)(a.ws + WS_WTIN); bf16* WT_BR = (bf16*)(a.ws + WS_WTBR); bf16* WT_OUT = (bf16*)(a.ws + WS_WTOUT);
    constexpr int I_IN = 16 * 256, I_BR = 3 * 256, I_OUT = 16 * 32, NITEMS = I_IN + I_BR + I_OUT;
    for (int it = gw; it < NITEMS; it += NGW) {
        int r = it;
        if (r < I_IN) { const int kb = r >> 8, nb = r & 255; tr_item(w_in, PIN, 64 * kb, win_remap(32 * nb), WT_IN, DM, 32 * nb, scr, LANE_); continue; } r -= I_IN;
        if (r < I_BR) { const int n = r >> 8, rr = r & 255, kb = rr >> 5, nb = rr & 31; tr_item(w_br + (size_t)n * 512 * 1024, 1024, 64 * kb, 32 * nb, WT_BR + (size_t)n * 1024 * 512, 512, 32 * nb, scr, LANE_); continue; } r -= I_BR;
        { const int kb = r >> 5, nb = r & 31; tr_item(w_out, 1024, 64 * kb, 32 * nb, WT_OUT, DM, 32 * nb, scr, LANE_); }
    }
    const float* g1 = (const float*)a.in[2] + l * DM; const float* gate_b = (const float*)a.in[7] + l * 8;
    bf16* XN = (bf16*)(a.ws + WS_XN); float* IFPRE = (float*)(a.ws + WS_IFPRE);
    for (int m = gw; m < M; m += NGW) {
        const GAS f32x4* xr = (const GAS f32x4*)(xin + (size_t)m * DM) + LANE_;
        f32x4 v[4]; float s = 0.f;
#pragma unroll
        for (int j = 0; j < 4; ++j) v[j] = xr[64 * j];
        if (ADD_MOE) {
            const GAS v2u* y0 = (const GAS v2u*)(a.ws + WS_YP + (size_t)(2 * m) * 2048) + LANE_; const GAS v2u* y1 = (const GAS v2u*)(a.ws + WS_YP + (size_t)(2 * m + 1) * 2048) + LANE_;
#pragma unroll
            for (int j = 0; j < 4; ++j) { const v2u p0 = y0[64 * j], p1 = y1[64 * j];
                v[j].x += __uint_as_float(p0.x << 16) + __uint_as_float(p1.x << 16); v[j].y += __uint_as_float(p0.x & 0xffff0000u) + __uint_as_float(p1.x & 0xffff0000u);
                v[j].z += __uint_as_float(p0.y << 16) + __uint_as_float(p1.y << 16); v[j].w += __uint_as_float(p0.y & 0xffff0000u) + __uint_as_float(p1.y & 0xffff0000u);
                ((GAS f32x4*)(a.out + (size_t)m * DM))[LANE_ + 64 * j] = v[j]; }
        }
#pragma unroll
        for (int j = 0; j < 4; ++j) s += (v[j].x * v[j].x + v[j].y * v[j].y) + (v[j].z * v[j].z + v[j].w * v[j].w);
#pragma unroll
        for (int o = 1; o < 64; o <<= 1) s += __shfl_xor(s, o);
        const float rs = rsqrtf(s * (1.f / DM) + RMS_EPS);
        float ip[8];
#pragma unroll
        for (int o = 0; o < 8; ++o) ip[o] = 0.f;
        GAS unsigned long long* o8 = (GAS unsigned long long*)(XN + (size_t)m * DM) + LANE_;
#pragma unroll
        for (int j = 0; j < 4; ++j) { const f32x4 gg = ((const GAS f32x4*)g1)[LANE_ + 64 * j]; v[j] = v[j] * rs * gg;
            o8[64 * j] = (unsigned long long)pk2(v[j].x, v[j].y) | ((unsigned long long)pk2(v[j].z, v[j].w) << 32);
#pragma unroll
            for (int u = 0; u < 4; ++u) { const int d = (LANE_ + 64 * j) * 4 + u; const float xv = v[j][u];
                const f32x4 wa = *(const GAS f32x4*)(w_in + (size_t)d * PIN + 5120), wb = *(const GAS f32x4*)(w_in + (size_t)d * PIN + 5124);
                ip[0] += xv * wa.x; ip[1] += xv * wa.y; ip[2] += xv * wa.z; ip[3] += xv * wa.w; ip[4] += xv * wb.x; ip[5] += xv * wb.y; ip[6] += xv * wb.z; ip[7] += xv * wb.w; } }
#pragma unroll
        for (int o = 0; o < 8; ++o) {
#pragma unroll
            for (int sft = 1; sft < 64; sft <<= 1) ip[o] += __shfl_xor(ip[o], sft); }
        float val = ip[0];
#pragma unroll
        for (int o = 1; o < 8; ++o) val = LANE_ == o ? ip[o] : val;
        if (LANE_ < 8) IFPRE[(size_t)m * 8 + LANE_] = val + gate_b[LANE_];
    }
}


__device__ __forceinline__ float dot64(const float (&q)[64], const bf16* p) {
    float z = 0.f;
#pragma unroll
    for (int i = 0; i < 8; ++i) { const uint4 v = ((const uint4*)p)[i];
        z += q[8 * i + 0] * __uint_as_float(v.x << 16) + q[8 * i + 1] * __uint_as_float(v.x & 0xffff0000u) + q[8 * i + 2] * __uint_as_float(v.y << 16) + q[8 * i + 3] * __uint_as_float(v.y & 0xffff0000u)
           + q[8 * i + 4] * __uint_as_float(v.z << 16) + q[8 * i + 5] * __uint_as_float(v.z & 0xffff0000u) + q[8 * i + 6] * __uint_as_float(v.w << 16) + q[8 * i + 7] * __uint_as_float(v.w & 0xffff0000u);
        asm volatile("" ::: "memory"); }
    return z;
}
__device__ __forceinline__ void axpy64(float (&acc)[64], float sc, float p, const bf16* vp) {
#pragma unroll
    for (int i = 0; i < 8; ++i) { const uint4 v = ((const uint4*)vp)[i];
        acc[8 * i + 0] = acc[8 * i + 0] * sc + p * __uint_as_float(v.x << 16); acc[8 * i + 1] = acc[8 * i + 1] * sc + p * __uint_as_float(v.x & 0xffff0000u);
        acc[8 * i + 2] = acc[8 * i + 2] * sc + p * __uint_as_float(v.y << 16); acc[8 * i + 3] = acc[8 * i + 3] * sc + p * __uint_as_float(v.y & 0xffff0000u);
        acc[8 * i + 4] = acc[8 * i + 4] * sc + p * __uint_as_float(v.z << 16); acc[8 * i + 5] = acc[8 * i + 5] * sc + p * __uint_as_float(v.z & 0xffff0000u);
        acc[8 * i + 6] = acc[8 * i + 6] * sc + p * __uint_as_float(v.w << 16); acc[8 * i + 7] = acc[8 * i + 7] * sc + p * __uint_as_float(v.w & 0xffff0000u);
        asm volatile("" ::: "memory"); }
}

__device__ __forceinline__ void ph_prep_qk(Frame& F, const Args& a, const int l) {
    const int LANE_ = lane_id(), TID_ = F.wave * 64 + LANE_; (void)TID_;
    bf16* mbq = (bf16*)(a.ws + WS_MBQ); bf16* mbk = (bf16*)(a.ws + WS_MBK);
    const float* qn_g = (const float*)a.in[4] + l * 64; const float* kn_g = (const float*)a.in[5] + l * 64; const int* positions = (const int*)a.in[1];
    for (int idx = blockIdx.x * 512 + TID_; idx < M * 16; idx += F.G * 512) {
        const int row = idx >> 4, hh = idx & 15, which = hh >> 3, h = hh & 7;
        bf16* p = (which ? mbk : mbq) + (size_t)row * 512 + h * 64; const float* g = which ? kn_g : qn_g;
        float x[64]; load64(p, x);
        float ss = 0.f;
#pragma unroll
        for (int i = 0; i < 64; ++i) ss += x[i] * x[i];
        const float r = rsqrtf(ss * (1.f / 64.f) + RMS_EPS);
#pragma unroll
        for (int i = 0; i < 64; ++i) x[i] = x[i] * r * g[i];
        const double pos = (double)positions[row];
        const double invf[8] = {1.0, 0.19392274474868576, 0.03760603093086393, 0.007292664737217109, 0.001414213562373095, 0.0002742481756762073, 5.318295896944988e-05, 1.031338537721246e-05};
#pragma unroll
        for (int i = 0; i < 8; ++i) {
            double rev = pos * invf[i] * 0.15915494309189535; rev -= floor(rev);
            const float fr = (float)rev; const float sn = __builtin_amdgcn_sinf(fr), cs = __builtin_amdgcn_cosf(fr);
            const float x1 = x[i], x2 = x[i + 8]; x[i] = x1 * cs - x2 * sn; x[i + 8] = x1 * sn + x2 * cs;
        }
        if (!which) {
#pragma unroll
            for (int i = 0; i < 64; ++i) x[i] *= C2;
        }
        store64(p, x);
    }
}
__device__ __forceinline__ void ph_conv(Frame& F, const Args& a, const int l) {
    const int LANE_ = lane_id(), TID_ = F.wave * 64 + LANE_; (void)TID_;
    const bf16* mlqk = (const bf16*)(a.ws + WS_MLQK); const float* cw = (const float*)a.in[6] + l * 4 * 1024;
    bf16* q2 = (bf16*)(a.ws + WS_MLQ2); bf16* k2 = (bf16*)(a.ws + WS_MLK2);
    for (size_t idx = (size_t)blockIdx.x * 512 + TID_; idx < (size_t)M * 1024; idx += (size_t)F.G * 512) {
        const int c = (int)(idx & 1023), row = (int)(idx >> 10), t = row & (SEQ - 1);
        float y = 0.f;
#pragma unroll
        for (int j = 0; j < 4; ++j) { const int tt = t - 3 + j; if (tt >= 0) y += cw[j * 1024 + c] * bf2f(mlqk[(size_t)(row - 3 + j) * 1024 + c]); }
        y = y * sigmoidf_(y);
        if (c < 512) q2[(size_t)row * 512 + c] = (bf16)f2bf(y); else k2[(size_t)row * 512 + c - 512] = (bf16)f2bf(y * 0.08838834764831845f);
    }
}
__device__ __forceinline__ void ph_kmean(Frame& F, const Args& a) {
    const int LANE_ = lane_id(), TID_ = F.wave * 64 + LANE_; (void)TID_;
    const bf16* mbk = (const bf16*)(a.ws + WS_MBK); float* kmean = (float*)(a.ws + WS_KMEAN);
    for (int idx = blockIdx.x * 512 + TID_; idx < 8 * 8 * 8 * 64; idx += F.G * 512) {
        const int d = idx & 63, blk = (idx >> 6) & 7, h = (idx >> 9) & 7, b = idx >> 12;
        float s = 0.f;
        for (int i = 0; i < 256; ++i) s += bf2f(mbk[(size_t)(b * SEQ + blk * 256 + i) * 512 + h * 64 + d]);
        kmean[idx] = s * (1.f / 256.f);
    }
}
__device__ __forceinline__ void ph_sb_naive(Frame& F, const Args& a) {
    const int LANE_ = lane_id(), TID_ = F.wave * 64 + LANE_; (void)TID_;
    bf16* sbq = (bf16*)(a.ws + WS_SBQ); const bf16* sbk = (const bf16*)(a.ws + WS_SBK); const bf16* sbv = (const bf16*)(a.ws + WS_SBV);
    for (int idx = blockIdx.x * 512 + TID_; idx < M * 8; idx += F.G * 512) {
        const int row = idx >> 3, h = idx & 7, t = row & (SEQ - 1), base = row - t;
        float q[64], acc[64]; load64(sbq + (size_t)row * 512 + h * 64, q);
#pragma unroll
        for (int i = 0; i < 64; ++i) acc[i] = 0.f;
        float C = 0.f;
        for (int s = t - 1; s >= 0; --s) {
            const float z = dot64(q, sbk + (size_t)(base + s) * 512 + h * 64);
            const float sp = z > 0.f ? z + __log2f(1.f + exp2f(-z)) : __log2f(1.f + exp2f(z));
            C += sp; const float w = exp2f(z - C);
            axpy64(acc, 1.f, w, sbv + (size_t)(base + s) * 512 + h * 64);
            if (C > 150.f) break;
        }
        store64(sbq + (size_t)row * 512 + h * 64, acc);
    }
}
__device__ __forceinline__ void ph_moba_naive(Frame& F, const Args& a) {
    const int LANE_ = lane_id(), TID_ = F.wave * 64 + LANE_; (void)TID_;
    bf16* mbq = (bf16*)(a.ws + WS_MBQ); const bf16* mbk = (const bf16*)(a.ws + WS_MBK); const bf16* mbv = (const bf16*)(a.ws + WS_MBV); const float* kmean = (const float*)(a.ws + WS_KMEAN);
    for (int idx = blockIdx.x * 512 + TID_; idx < M * 8; idx += F.G * 512) {
        const int row = idx >> 3, h = idx & 7, t = row & (SEQ - 1), base = row - t, b = row >> 11, own = t >> 8;
        float q[64], acc[64]; load64(mbq + (size_t)row * 512 + h * 64, q);
#pragma unroll
        for (int i = 0; i < 64; ++i) acc[i] = 0.f;
        unsigned sel = 0u;
        {
            float g[8];
#pragma unroll
            for (int blk = 0; blk < 8; ++blk) { float s = 0.f; const float* km = kmean + ((size_t)(b * 8 + h) * 8 + blk) * 64;
#pragma unroll
                for (int i = 0; i < 64; ++i) s += q[i] * km[i];
                g[blk] = blk < own ? s : -INFINITY; }
#pragma unroll
            for (int r = 0; r < 3; ++r) { float best = -INFINITY; int bi = -1;
#pragma unroll
                for (int blk = 0; blk < 8; ++blk) { const bool ok = !((sel >> blk) & 1u) && g[blk] > best; if (ok) { best = g[blk]; bi = blk; } }
                if (bi >= 0) sel |= 1u << bi; }
        }
        sel |= 1u << own;
        float m = -INFINITY, lsum = 0.f;
        for (int blk = 0; blk <= own; ++blk) {
            if (!((sel >> blk) & 1u)) continue;
            const int s1 = blk == own ? t : blk * 256 + 255;
            for (int s = blk * 256; s <= s1; ++s) {
                const float z = dot64(q, mbk + (size_t)(base + s) * 512 + h * 64);
                const float mn = fmaxf(m, z), sc = exp2f(m - mn), p = exp2f(z - mn);
                lsum = lsum * sc + p;
                axpy64(acc, sc, p, mbv + (size_t)(base + s) * 512 + h * 64);
                m = mn;
            }
        }
        const float il = 1.f / lsum;
#pragma unroll
        for (int i = 0; i < 64; ++i) acc[i] *= il;
        store64(mbq + (size_t)row * 512 + h * 64, acc);
    }
}
__device__ __forceinline__ void ph_mlstm_naive(Frame& F, const Args& a) {
    const int LANE_ = lane_id(), TID_ = F.wave * 64 + LANE_; (void)TID_;
    const bf16* q2 = (const bf16*)(a.ws + WS_MLQ2); const bf16* k2 = (const bf16*)(a.ws + WS_MLK2); const bf16* mlv = (const bf16*)(a.ws + WS_MLV); bf16* mlo = (bf16*)(a.ws + WS_MLO);
    const float* ifpre = (const float*)(a.ws + WS_IFPRE);
    for (int unit = blockIdx.x; unit < 32; unit += F.G) {
        const int b = unit >> 2, h = unit & 3, tid = TID_, e = tid >> 2, dq = tid & 3;
        float Cst[32], nst[32];
#pragma unroll
        for (int j = 0; j < 32; ++j) { Cst[j] = 0.f; nst[j] = 0.f; }
        float m = 0.f;
        for (int t = 0; t < SEQ; ++t) {
            const size_t row = (size_t)b * SEQ + t;
            const float li = ifpre[row * 8 + h], fp = ifpre[row * 8 + 4 + h];
            const float lf = fp >= 0.f ? -log1pf(__expf(-fp)) : fp - log1pf(__expf(fp));
            const float mn = fmaxf(lf + m, li), fd = __expf(lf + m - mn), ii = __expf(li - mn); m = mn;
            const bf16* kp = k2 + row * 512 + h * 128 + dq * 32; const bf16* qp = q2 + row * 512 + h * 128 + dq * 32;
            const float ve = bf2f(mlv[row * 512 + h * 128 + e]) * ii;
            float num = 0.f, den = 0.f;
#pragma unroll
            for (int c4 = 0; c4 < 4; ++c4) {
                const uint4 kv = ((const uint4*)kp)[c4], qv = ((const uint4*)qp)[c4];
                const unsigned ku[4] = {kv.x, kv.y, kv.z, kv.w}, qu[4] = {qv.x, qv.y, qv.z, qv.w};
#pragma unroll
                for (int u = 0; u < 4; ++u) {
                    const float k0 = __uint_as_float(ku[u] << 16), k1 = __uint_as_float(ku[u] & 0xffff0000u), q0 = __uint_as_float(qu[u] << 16), q1 = __uint_as_float(qu[u] & 0xffff0000u);
                    const int j = c4 * 8 + u * 2;
                    Cst[j] = fd * Cst[j] + ve * k0; Cst[j + 1] = fd * Cst[j + 1] + ve * k1;
                    nst[j] = fd * nst[j] + ii * k0; nst[j + 1] = fd * nst[j + 1] + ii * k1;
                    num += Cst[j] * q0 + Cst[j + 1] * q1; den += nst[j] * q0 + nst[j + 1] * q1;
                }
            }
            num += __shfl_xor(num, 1); num += __shfl_xor(num, 2); den += __shfl_xor(den, 1); den += __shfl_xor(den, 2);
            const float o = num / fmaxf(fabsf(den), __expf(-m));
            if (dq == 0) { bf16* op = mlo + row * 512 + h * 128 + e; *op = (bf16)f2bf(o * sigmoidf_(bf2f(*op))); }
        }
    }
}
__device__ __forceinline__ void ph_router(Frame& F, const Args& a, const int l) {
    const int LANE_ = lane_id(), TID_ = F.wave * 64 + LANE_; (void)TID_;
    const float* hin = a.out; const float* g2 = (const float*)a.in[10] + l * DM; const float* w_rg = (const float*)a.in[11] + (size_t)l * DM * 4; const float* b_rg = (const float*)a.in[12] + l * 4;
    const float* w_re = (const float*)a.in[13] + (size_t)l * DM * 32; const float* b_re = (const float*)a.in[14] + l * 32;
    bf16* xn2 = (bf16*)(a.ws + WS_XN2); int* re = (int*)(a.ws + WS_RE); float* rw = (float*)(a.ws + WS_RW); int* rank = (int*)(a.ws + WS_RANK); unsigned* cnt = (unsigned*)(F.ctl + CW_CNT + 64 * l);
    const int lane = LANE_, r8 = lane >> 3, part = lane & 7, gw = F.vcu * NWAVES + F.wave, NGW = F.G * NWAVES;
    for (int grp = gw; grp < M / 8; grp += NGW) {
        const int row = grp * 8 + r8;
        const float* xp = hin + (size_t)row * DM + 4 * part; const float* gp = g2 + 4 * part; const float* wgp = w_rg + (size_t)(4 * part) * 4; const float* wep = w_re + (size_t)(4 * part) * 32;
        float lg[36]; float ss = 0.f;
#pragma unroll
        for (int o = 0; o < 36; ++o) lg[o] = 0.f;
#pragma unroll 1
        for (int c = 0; c < 32; ++c) {
            const f32x4 x4 = *(const GAS f32x4*)(xp + 32 * c), g4 = *(const GAS f32x4*)(gp + 32 * c);
            ss += (x4.x * x4.x + x4.y * x4.y) + (x4.z * x4.z + x4.w * x4.w);
            const f32x4 xg = x4 * g4;
#pragma unroll
            for (int u = 0; u < 4; ++u) { const float xv = xg[u];
                const f32x4 wg = *(const GAS f32x4*)(wgp + (size_t)(32 * c + u) * 4); lg[0] += xv * wg.x; lg[1] += xv * wg.y; lg[2] += xv * wg.z; lg[3] += xv * wg.w;
#pragma unroll
                for (int o4 = 0; o4 < 8; ++o4) { const f32x4 we = *(const GAS f32x4*)(wep + (size_t)(32 * c + u) * 32 + o4 * 4);
                    lg[4 + o4 * 4] += xv * we.x; lg[5 + o4 * 4] += xv * we.y; lg[6 + o4 * 4] += xv * we.z; lg[7 + o4 * 4] += xv * we.w; } }
        }
        ss += __shfl_xor(ss, 1); ss += __shfl_xor(ss, 2); ss += __shfl_xor(ss, 4);
        const float r = rsqrtf(ss * (1.f / DM) + RMS_EPS);
#pragma unroll
        for (int o = 0; o < 36; ++o) { float v = lg[o]; v += __shfl_xor(v, 1); v += __shfl_xor(v, 2); v += __shfl_xor(v, 4); lg[o] = v * r; }
        bf16* op = xn2 + (size_t)row * DM + 4 * part;
#pragma unroll 1
        for (int c = 0; c < 32; ++c) {
            const f32x4 x4 = *(const GAS f32x4*)(xp + 32 * c), g4 = *(const GAS f32x4*)(gp + 32 * c); const f32x4 y = x4 * g4 * r;
            *(GAS unsigned long long*)(op + 32 * c) = (unsigned long long)pk2(y.x, y.y) | ((unsigned long long)pk2(y.z, y.w) << 32);
        }
        float gm = -INFINITY; int gi = 0; float gl[4];
#pragma unroll
        for (int i = 0; i < 4; ++i) { gl[i] = lg[i] + b_rg[i]; if (gl[i] > gm) { gm = gl[i]; gi = i; } }
        float gs = 0.f;
#pragma unroll
        for (int i = 0; i < 4; ++i) gs += __expf(gl[i] - gm);
        const float gwt = 1.f / gs;
        float el[8];
#pragma unroll
        for (int j = 0; j < 8; ++j) { const float a0 = lg[4 + j] + b_re[j], a1 = lg[12 + j] + b_re[8 + j], a2 = lg[20 + j] + b_re[16 + j], a3 = lg[28 + j] + b_re[24 + j];
            el[j] = gi == 0 ? a0 : (gi == 1 ? a1 : (gi == 2 ? a2 : a3)); }
        float m1 = -INFINITY; int i1 = 0;
#pragma unroll
        for (int j = 0; j < 8; ++j) if (el[j] > m1) { m1 = el[j]; i1 = j; }
        float m2 = -INFINITY; int i2 = 0;
#pragma unroll
        for (int j = 0; j < 8; ++j) if (j != i1 && el[j] > m2) { m2 = el[j]; i2 = j; }
        const float p2 = __expf(m2 - m1);
        const float w1 = gwt / (1.f + p2), w2 = gwt * p2 / (1.f + p2);
        if (part == 0) { const int ea = gi * 8 + i1, eb = gi * 8 + i2; re[row * 2] = ea; re[row * 2 + 1] = eb; rw[row * 2] = w1; rw[row * 2 + 1] = w2;
            rank[row * 2] = (int)__hip_atomic_fetch_add(cnt + ea, 1u, __ATOMIC_RELAXED, __HIP_MEMORY_SCOPE_AGENT); rank[row * 2 + 1] = (int)__hip_atomic_fetch_add(cnt + eb, 1u, __ATOMIC_RELAXED, __HIP_MEMORY_SCOPE_AGENT); }
    }
}
__device__ __forceinline__ void ph_moe_weights(Frame& F, const Args& a, const int l) {
    const int LANE_ = lane_id(), TID_ = F.wave * 64 + LANE_; (void)TID_;
    LAS float* scr = (LAS float*)(F.lds + RING_OFF + F.wave * 16384);
    const int gw = F.vcu * NWAVES + F.wave, NGW = F.G * NWAVES;
    const float* w1 = (const float*)a.in[15] + (size_t)l * 32 * 1024 * 256; const float* w3 = (const float*)a.in[16] + (size_t)l * 32 * 1024 * 256; const float* w2 = (const float*)a.in[17] + (size_t)l * 32 * 256 * 1024;
    bf16* WT13 = (bf16*)(a.ws + WS_WT13); bf16* WT2 = (bf16*)(a.ws + WS_WT2);
    constexpr int I_13 = 32 * 2 * 128, I_2 = 32 * 128;
    for (int it = gw; it < I_13 + I_2; it += NGW) {
        if (it < I_13) { const int e = it >> 8, which = (it >> 7) & 1, rr = it & 127, kb = rr >> 3, nb = rr & 7, f0 = 32 * nb;
            tr_item((which ? w3 : w1) + (size_t)e * 1024 * 256, 256, 64 * kb, f0, WT13 + (size_t)e * 512 * 1024, 1024, (f0 >> 7) * 256 + which * 128 + (f0 & 127), scr, LANE_); }
        else { const int r = it - I_13, e = r >> 7, rr = r & 127, kb = rr >> 5, nb = rr & 31;
            tr_item(w2 + (size_t)e * 256 * 1024, 1024, 64 * kb, 32 * nb, WT2 + (size_t)e * 1024 * 256, 256, 32 * nb, scr, LANE_); }
    }
}
constexpr int MOE_TAB_OFF = LDSCTL_OFF + 1024;
__device__ __forceinline__ void moe_tables(Frame& F, const int l) {
    const int LANE_ = lane_id(), TID_ = F.wave * 64 + LANE_; (void)TID_;
    LAS int* tab = (LAS int*)(F.lds + MOE_TAB_OFF);
    if (F.wave == 0) {
        const int e = LANE_ & 31; const int c = (int)__hip_atomic_load(F.ctl + CW_CNT + 64 * l + e, RLX_AGENT); const int np = (c + 255) >> 8;
        int inc = np;
#pragma unroll
        for (int o = 1; o < 32; o <<= 1) { const int t = __shfl_up(inc, o); if ((LANE_ & 31) >= o) inc += t; }
        const int seg = inc - np;
        if (LANE_ < 32) { tab[32 + e] = seg; for (int j = 0; j < np; ++j) { tab[64 + seg + j] = e; const int rem = c - 256 * j; tab[256 + seg + j] = rem < 256 ? rem : 256; } }
        if (LANE_ == 31) tab[0] = inc;
    }
    LDS_WAIT(); __syncthreads();
}
__device__ __forceinline__ void ph_moe_gather(Frame& F, const Args& a, const int l) {
    const int LANE_ = lane_id(), TID_ = F.wave * 64 + LANE_; (void)TID_;
    moe_tables(F, l);
    const LAS int* tab = (const LAS int*)(F.lds + MOE_TAB_OFF);
    const int* re = (const int*)(a.ws + WS_RE); const float* rw = (const float*)(a.ws + WS_RW); const int* rank = (const int*)(a.ws + WS_RANK);
    int* spair = (int*)(a.ws + WS_SPAIR); float* sw = (float*)(a.ws + WS_SW);
    const int gw = F.vcu * NWAVES + F.wave, NGW = F.G * NWAVES;
    for (int p = gw; p < 2 * M; p += NGW) {
        const int e = re[p]; const int slot = tab[32 + e] * 256 + rank[p];
        const GAS v4u* src = (const GAS v4u*)(a.ws + WS_XN2 + (size_t)(p >> 1) * 2048); GAS v4u* dst = (GAS v4u*)(a.ws + WS_XS + (size_t)slot * 2048);
        const v4u v0 = src[LANE_], v1 = src[LANE_ + 64]; dst[LANE_] = v0; dst[LANE_ + 64] = v1;
        if (LANE_ == 0) { spair[slot] = p; sw[slot] = rw[p]; }
    }
}
__device__ __forceinline__ void ph_final(Frame& F, const Args& a) {
    const int LANE_ = lane_id(), TID_ = F.wave * 64 + LANE_; (void)TID_;
    const int gw = F.vcu * NWAVES + F.wave, NGW = F.G * NWAVES;
    for (int m = gw; m < M; m += NGW) {
        GAS f32x4* xr = (GAS f32x4*)(a.out + (size_t)m * DM) + LANE_;
        const GAS v2u* y0 = (const GAS v2u*)(a.ws + WS_YP + (size_t)(2 * m) * 2048) + LANE_; const GAS v2u* y1 = (const GAS v2u*)(a.ws + WS_YP + (size_t)(2 * m + 1) * 2048) + LANE_;
#pragma unroll
        for (int j = 0; j < 4; ++j) { f32x4 v = xr[64 * j]; const v2u p0 = y0[64 * j], p1 = y1[64 * j];
            v.x += __uint_as_float(p0.x << 16) + __uint_as_float(p1.x << 16); v.y += __uint_as_float(p0.x & 0xffff0000u) + __uint_as_float(p1.x & 0xffff0000u);
            v.z += __uint_as_float(p0.y << 16) + __uint_as_float(p1.y << 16); v.w += __uint_as_float(p0.y & 0xffff0000u) + __uint_as_float(p1.y & 0xffff0000u);
            xr[64 * j] = v; }
    }
}
constexpr int NPH = 11;
template <int l> __device__ __forceinline__ void layer_body(Frame& F, const Args& args, const XcdBarrier& bar, const int plo, const int phi) {
    const int LANE_ = lane_id(), TID_ = F.wave * 64 + LANE_; (void)TID_;
    unsigned char* ws = args.ws;
        const int lo = plo - l * NPH, hi = phi - l * NPH;
#define IN(k) (lo <= (k) && (k) < hi)
#define SEAM(k) do { if ((k) + 1 + l * NPH < phi) xcd_barrier(bar); } while (0)
        const float* xin = l == 0 ? (const float*)args.in[0] : (const float*)args.out;
        if (IN(0)) { p0_prologue<(l > 0)>(F, args, l, xin); SEAM(0); }
        if (IN(1)) {
            pg8::Gemm g{(const pg8::bf16_t*)(ws + WS_XN), (const pg8::bf16_t*)(ws + WS_WTIN), M, 8192, DM}; pg8::StaticOrder S; S.init(M, 8192, F.G, (int)blockIdx.x);
            pg8::EpiInProj E{ws};
            pg8::gemm_phase<pg8::EpiInProj, pg8::StaticOrder, PG8_ALIGN, PG8_SP2>(F.lds + RING_OFF, g, S, E, F.wave);
            SEAM(1);
        }
        if (IN(2)) { ph_prep_qk(F, args, l); ph_conv(F, args, l); SEAM(2); }
        if (IN(3)) { ph_kmean(F, args); ph_sb_naive(F, args); SEAM(3); }
        if (IN(4)) { ph_mlstm_naive(F, args); ph_moba_naive(F, args); SEAM(4); }
        if (IN(5)) {
            pg8::Gemm g{(const pg8::bf16_t*)(ws + WS_SBQ), (const pg8::bf16_t*)(ws + WS_WTBR), M, 1024, 512}; pg8::YOrder S{F.vcu, F.G};
            pg8::EpiYMerge E{(const pg8::bf16_t*)(ws + WS_GATES), (pg8::bf16_t*)(ws + WS_MERGED)};
            pg8::gemm_phase<pg8::EpiYMerge, pg8::YOrder, PG8_ALIGN, PG8_SP2>(F.lds + RING_OFF, g, S, E, F.wave);
            SEAM(5);
        }
        if (IN(6)) {
            pg8::Gemm g{(const pg8::bf16_t*)(ws + WS_MERGED), (const pg8::bf16_t*)(ws + WS_WTOUT), M, DM, DM}; pg8::StaticOrder S; S.init(M, DM, F.G, (int)blockIdx.x);
            pg8::EpiResid32 E{xin, args.out};
            pg8::gemm_phase<pg8::EpiResid32, pg8::StaticOrder, PG8_ALIGN, PG8_SP2>(F.lds + RING_OFF, g, S, E, F.wave);
            SEAM(6);
        }
        if (IN(7)) { ph_moe_weights(F, args, l); ph_router(F, args, l); SEAM(7); }
        if (IN(8)) { ph_moe_gather(F, args, l); SEAM(8); }
        if (IN(9)) {
            moe_tables(F, l); const LAS int* tab = (const LAS int*)(F.lds + MOE_TAB_OFF);
            pg8::Gemm g{(const pg8::bf16_t*)(ws + WS_XS), (const pg8::bf16_t*)(ws + WS_WT13), M, 512, DM}; pg8::MoeOrder S{F.vcu, F.G, tab[0], 2, tab + 64};
            pg8::EpiSwiGLU E{(pg8::bf16_t*)(ws + WS_HS)};
            pg8::gemm_phase<pg8::EpiSwiGLU, pg8::MoeOrder, PG8_ALIGN, PG8_SP2>(F.lds + RING_OFF, g, S, E, F.wave);
            SEAM(9);
        }
        if (IN(10)) {
            moe_tables(F, l); const LAS int* tab = (const LAS int*)(F.lds + MOE_TAB_OFF);
            pg8::Gemm g{(const pg8::bf16_t*)(ws + WS_HS), (const pg8::bf16_t*)(ws + WS_WT2), M, DM, 256}; pg8::MoeOrder S{F.vcu, F.G, tab[0], 4, tab + 64};
            pg8::EpiMoeOut E{(pg8::bf16_t*)(ws + WS_YP), (const int*)(ws + WS_SPAIR), (const float*)(ws + WS_SW), tab + 256};
            pg8::gemm_phase<pg8::EpiMoeOut, pg8::MoeOrder, PG8_ALIGN, PG8_SP2>(F.lds + RING_OFF, g, S, E, F.wave);
            SEAM(10);
        }
#undef IN
#undef SEAM
}
__global__ void __launch_bounds__(NWAVES * 64, 2) mk(Args args) {
    extern __shared__ __attribute__((aligned(16))) unsigned char lds[];
    Frame F;
    F.lds = (LAS unsigned char*)lds; F.MISC = (volatile LAS unsigned*)(F.lds + MISC_OFF);
    F.wave = __builtin_amdgcn_readfirstlane((int)threadIdx.x >> 6);
    const int LANE_ = lane_id(), TID_ = F.wave * 64 + LANE_;
    F.G = gridDim.x; { const int bx = blockIdx.x; F.vcu = (F.G % 8 == 0) ? (bx % 8) * (F.G / 8) + bx / 8 : bx; }
    unsigned char* ws = args.ws; F.ctl = (gu32*)(ws + WS_CTL);
    for (int u = TID_; u < (LDS_BYTES - LDSCTL_OFF) / 4; u += NWAVES * 64) ((LAS unsigned*)(F.lds + LDSCTL_OFF))[u] = 0u;
    __syncthreads();
    const int plo = args.ph_lo, phi = args.ph_hi;
    XcdBarrier bar; bar.bar = (unsigned*)(F.ctl + CW_BAR); bar.x = 0; bar.st = nullptr; bar.w = (unsigned)F.wave;
    if (phi - plo > 1) bar = xcd_barrier_post((unsigned*)(F.ctl + CW_BAR), F.MISC + 8, (unsigned)F.wave);
    layer_body<0>(F, args, bar, plo, phi);
    layer_body<1>(F, args, bar, plo, phi);
    if (plo <= DEPTH * NPH && DEPTH * NPH < phi) ph_final(F, args);
}

#ifndef MK_ONE_LAUNCH
#define MK_ONE_LAUNCH 1
#endif
extern "C" void kernel_launch(void* const* d_in, const int* in_sizes, int n_in, void* d_out, int out_size, void* d_ws, size_t ws_size, hipStream_t stream) {
    static int grid = 0;
    if (grid == 0) {
        if (n_in != 18 || out_size != M * DM || ws_size < WS_END) { fprintf(stderr, "kernel_launch: unexpected shapes (n_in %d out %d ws %zu)\n", n_in, out_size, ws_size); grid = -1; return; }
        int dev = 0, cus = 0;
        if (hipGetDevice(&dev) != hipSuccess || hipDeviceGetAttribute(&cus, hipDeviceAttributeMultiprocessorCount, dev) != hipSuccess) { grid = -1; return; }
        if (hipFuncSetAttribute((const void*)mk, hipFuncAttributeMaxDynamicSharedMemorySize, LDS_BYTES) != hipSuccess) { grid = -1; return; }
        int per_cu = 0;
        if (hipOccupancyMaxActiveBlocksPerMultiprocessor(&per_cu, (const void*)mk, NWAVES * 64, LDS_BYTES) != hipSuccess || per_cu < 1) fprintf(stderr, "kernel_launch: occupancy query says %d blocks per CU\n", per_cu);
        (void)hipGetLastError();
        grid = cus;
    }
    if (grid < 0) return;
    (void)hipMemsetAsync((char*)d_ws + WS_CTL, 0, CTL_ZERO_BYTES, stream);
    Args a{};
    for (int i = 0; i < 18; ++i) a.in[i] = d_in[i];
    a.out = (float*)d_out; a.ws = (unsigned char*)d_ws; a.layer = 0;
#if MK_ONE_LAUNCH
    a.ph_lo = 0; a.ph_hi = DEPTH * NPH + 1; hipLaunchKernelGGL(mk, dim3(grid), dim3(NWAVES * 64), LDS_BYTES, stream, a);
#else
    for (int p = 0; p < DEPTH * NPH + 1; ++p) { a.ph_lo = p; a.ph_hi = p + 1; hipLaunchKernelGGL(mk, dim3(grid), dim3(NWAVES * 64), LDS_BYTES, stream, a); }
#endif
}
```

```cpp
#include <hip/hip_runtime.h>
#include <stdint.h>
#include <cstdio>
#include <cmath>

constexpr int BATCH = 8, SEQ = 2048, DM = 1024, M = BATCH * SEQ, W = 512, PIN = 8200, DEPTH = 2;
constexpr float RMS_EPS = 1e-6f;
constexpr float C2 = 0.18033688011112042f;
constexpr size_t MiB = 1u << 20;
constexpr size_t WS_CTL = 0, CTL_ZERO_BYTES = 1 * MiB;
constexpr size_t WS_IFPRE = 1 * MiB, WS_KMEAN = WS_IFPRE + 512 * 1024, WS_RE = WS_KMEAN + 128 * 1024, WS_RW = WS_RE + 128 * 1024;
constexpr size_t WS_XN = 4 * MiB, WS_WTIN = 36 * MiB;
constexpr size_t WS_SBQ = 52 * MiB, WS_SBK = 68 * MiB, WS_SBV = 84 * MiB, WS_MBQ = 100 * MiB, WS_MBK = 116 * MiB, WS_MBV = 132 * MiB;
constexpr size_t WS_MLO = 148 * MiB, WS_MLV = 164 * MiB, WS_MLQK = 180 * MiB, WS_GATES = 212 * MiB;
constexpr size_t WS_WTBR = 308 * MiB, WS_WTOUT = 311 * MiB, WS_END = 313 * MiB;
constexpr size_t WS_MLQ2 = WS_XN, WS_MLK2 = WS_XN + 16 * MiB, WS_MERGED = WS_MLQK, WS_XN2 = WS_XN;
constexpr size_t WS_WT13 = 52 * MiB, WS_WT2 = 84 * MiB, WS_XS = 100 * MiB, WS_HS = 181 * MiB, WS_YP = 202 * MiB;
constexpr size_t WS_SPAIR = 2 * MiB, WS_SW = 2 * MiB + 256 * 1024, WS_RANK = 2 * MiB + 512 * 1024;
constexpr int CW_CNT = 8192;
__device__ __forceinline__ int lane_id() { int x; asm volatile("v_mbcnt_lo_u32_b32 %0, -1, 0\n\tv_mbcnt_hi_u32_b32 %0, -1, %0" : "=v"(x)); return x; }
namespace pg8 {
#define PG8_LAS __attribute__((address_space(3)))
typedef unsigned short bf16_t;
typedef short bf16x8 __attribute__((ext_vector_type(8)));
typedef float f32x4 __attribute__((ext_vector_type(4)));
typedef unsigned u32x4 __attribute__((ext_vector_type(4)));
constexpr int BM = 256, BK = 64, HALF = 128, HTB = HALF * BK * 2  , STAGE_BYTES = 8 * HTB, NXCD = 8, WGM = 8;

__host__ __device__ __forceinline__ int lds_byte(int r, int c) { const int st = (r >> 4) * 2 + (c >> 5), rr = r & 15, cc = c & 31, ob = rr * 64 + cc * 2; return st * 1024 + (ob ^ (((ob >> 9) & 1) << 5)); }
__host__ __device__ __forceinline__ void stage_rc(int b, int& R, int& C) { const int st = b / 1024, sb = b % 1024, swz = sb ^ (((sb >> 9) & 1) << 5); R = (st >> 1) * 16 + swz / 64; C = (st & 1) * 32 + (swz % 64) / 2; }
__host__ __device__ __forceinline__ int perm32(int rho) { const int n = rho >> 4, i = rho & 15; return 8 * (i >> 2) + 4 * n + (i & 3); }

struct Unit { int pm, pn; };
struct Gemm { const bf16_t* A; const bf16_t* Bt; int M, N, K; };

struct StaticOrder {
    int nM, nN, nwg, G, c;
    __host__ __device__ void init(int M, int N, int G_, int c_) { nM = M / BM; nN = N / BM; nwg = nM * nN; G = G_; c = c_; }
    __host__ __device__ bool next(int i, Unit& u) const {
        const long L = (long)i * G + c; if (L >= nwg) return false;
        int wgid = (int)L; { const int q = nwg / NXCD, r = nwg % NXCD, xcd = wgid % NXCD, off = wgid / NXCD; wgid = (xcd < r ? xcd * (q + 1) : r * (q + 1) + (xcd - r) * q) + off; }
        const int nig = WGM * nN, gid = wgid / nig, fm = gid * WGM, gsz = (nM - fm) < WGM ? (nM - fm) : WGM;
        u.pm = fm + ((wgid % nig) % gsz); u.pn = (wgid % nig) / gsz; return true;
    }
    __device__ __forceinline__ void a_ready(const Unit&) const {}
    __device__ __forceinline__ void done(const Unit&) const {}
};

__device__ __forceinline__ unsigned cvt_pk_bf16(float lo, float hi) { unsigned r; asm volatile("v_cvt_pk_bf16_f32 %0, %1, %2" : "=v"(r) : "v"(lo), "v"(hi)); return r; }
typedef float f32x2 __attribute__((ext_vector_type(2)));
__device__ __forceinline__ float fast_sigmoid(float x) { return __builtin_amdgcn_rcpf(1.0f + __expf(-x)); }
struct EpiInProj {
    static constexpr bool PERM = true, AFTER_DRAIN = false;
    unsigned char* ws;
    __device__ __forceinline__ void operator()(const f32x4 (&acc)[2][2][4][2], const Unit& u, int wr, int wc, int fr, int fq) const {
        const int pn = u.pn; bf16_t* base; int ldc, colt; float sc = 1.f; bool sig = false;
        if (pn < 12) { base = (bf16_t*)(ws + WS_SBQ) + (size_t)(pn >> 1) * (8u << 20); ldc = 512; colt = (pn & 1) * 256; if (pn < 2) sc = C2; }
        else if (pn < 14) { base = (bf16_t*)(ws + WS_MLO); ldc = 512; colt = (pn & 1) * 256; }
        else if (pn < 16) { base = (bf16_t*)(ws + WS_MLV); ldc = 512; colt = (pn & 1) * 256; }
        else if (pn < 20) { base = (bf16_t*)(ws + WS_MLQK); ldc = 1024; colt = (pn - 16) * 256; }
        else { base = (bf16_t*)(ws + WS_GATES); ldc = 3072; colt = (pn - 20) * 256; sig = true; }
        const int row0 = u.pm * BM + wr * 64 + fr, col0 = colt + wc * 32 + 8 * fq;
#pragma unroll
        for (int ai = 0; ai < 2; ++ai)
#pragma unroll
            for (int m = 0; m < 4; ++m) { bf16_t* rowp = base + (size_t)(row0 + ai * HALF + m * 16) * ldc + col0;
#pragma unroll
                for (int bj = 0; bj < 2; ++bj) { f32x4 v0 = acc[ai][bj][m][0], v1 = acc[ai][bj][m][1];
                    if (sig) { v0 = (f32x4){fast_sigmoid(v0[0]), fast_sigmoid(v0[1]), fast_sigmoid(v0[2]), fast_sigmoid(v0[3])}; v1 = (f32x4){fast_sigmoid(v1[0]), fast_sigmoid(v1[1]), fast_sigmoid(v1[2]), fast_sigmoid(v1[3])}; }
                    else { v0 = v0 * sc; v1 = v1 * sc; }
                    u32x4 w; w.x = cvt_pk_bf16(v0[0], v0[1]); w.y = cvt_pk_bf16(v0[2], v0[3]); w.z = cvt_pk_bf16(v1[0], v1[1]); w.w = cvt_pk_bf16(v1[2], v1[3]);
                    *(u32x4*)(rowp + bj * HALF) = w; } }
    }
};
struct EpiYMerge {
    static constexpr bool PERM = true, AFTER_DRAIN = false;
    const bf16_t* gates; bf16_t* merged;
    __device__ __forceinline__ void operator()(const f32x4 (&acc)[2][2][4][2], const Unit& u, int wr, int wc, int fr, int fq) const {
        const int n = u.pn >> 2, pn = u.pn & 3, pm = u.pm - 192 * n;
        const int row0 = pm * BM + wr * 64 + fr, col0 = pn * BM + wc * 32 + 8 * fq;
#pragma unroll
        for (int ai = 0; ai < 2; ++ai)
#pragma unroll
            for (int m = 0; m < 4; ++m) { const size_t r = (size_t)(row0 + ai * HALF + m * 16);
#pragma unroll
                for (int bj = 0; bj < 2; ++bj) { const int c = col0 + bj * HALF;
                    const u32x4 gv = *(const u32x4*)(gates + r * 3072 + n * 1024 + c);
                    f32x4 v0 = acc[ai][bj][m][0], v1 = acc[ai][bj][m][1];
                    v0[0] *= __uint_as_float(gv.x << 16); v0[1] *= __uint_as_float(gv.x & 0xffff0000u); v0[2] *= __uint_as_float(gv.y << 16); v0[3] *= __uint_as_float(gv.y & 0xffff0000u);
                    v1[0] *= __uint_as_float(gv.z << 16); v1[1] *= __uint_as_float(gv.z & 0xffff0000u); v1[2] *= __uint_as_float(gv.w << 16); v1[3] *= __uint_as_float(gv.w & 0xffff0000u);
                    bf16_t* mp = merged + r * 1024 + c;
                    if (n > 0) { const u32x4 pv = *(const u32x4*)mp;
                        v0[0] += __uint_as_float(pv.x << 16); v0[1] += __uint_as_float(pv.x & 0xffff0000u); v0[2] += __uint_as_float(pv.y << 16); v0[3] += __uint_as_float(pv.y & 0xffff0000u);
                        v1[0] += __uint_as_float(pv.z << 16); v1[1] += __uint_as_float(pv.z & 0xffff0000u); v1[2] += __uint_as_float(pv.w << 16); v1[3] += __uint_as_float(pv.w & 0xffff0000u); }
                    u32x4 w; w.x = cvt_pk_bf16(v0[0], v0[1]); w.y = cvt_pk_bf16(v0[2], v0[3]); w.z = cvt_pk_bf16(v1[0], v1[1]); w.w = cvt_pk_bf16(v1[2], v1[3]);
                    *(u32x4*)mp = w; } }
    }
};
struct YOrder {
    int vcu, G;
    __device__ __forceinline__ bool next(int i, Unit& u) const { const int j = i / 3, n = i - 3 * j, tile = vcu + G * j; if (tile >= 256) return false; u.pm = (tile >> 2) + 192 * n; u.pn = (tile & 3) + 4 * n; return true; }
    __device__ __forceinline__ void a_ready(const Unit&) const {}
    __device__ __forceinline__ void done(const Unit&) const {}
};
struct EpiResid32 {
    static constexpr bool PERM = false, AFTER_DRAIN = false;
    const float* xin; float* out;
    __device__ __forceinline__ void operator()(const f32x4 (&acc)[2][2][4][2], const Unit& u, int wr, int wc, int fr, int fq) const {
        const int row0 = u.pm * BM + wr * 64 + fr, col0 = u.pn * BM + wc * 32 + 4 * fq;
#pragma unroll
        for (int ai = 0; ai < 2; ++ai)
#pragma unroll
            for (int m = 0; m < 4; ++m) { const size_t off = (size_t)(row0 + ai * HALF + m * 16) * 1024 + col0;
#pragma unroll
                for (int bj = 0; bj < 2; ++bj)
#pragma unroll
                    for (int n = 0; n < 2; ++n) { const f32x4 xv = *(const f32x4*)(xin + off + bj * HALF + n * 16); *(f32x4*)(out + off + bj * HALF + n * 16) = xv + acc[ai][bj][m][n]; } }
    }
};

struct EpiSwiGLU {
    static constexpr bool PERM = true, AFTER_DRAIN = false;
    bf16_t* Hs;
    __device__ __forceinline__ void operator()(const f32x4 (&acc)[2][2][4][2], const Unit& u, int wr, int wc, int fr, int fq) const {
        const int j = u.pn & 1; const int row0 = u.pm * BM + wr * 64 + fr, col0 = j * 128 + wc * 32 + 8 * fq;
#pragma unroll
        for (int ai = 0; ai < 2; ++ai)
#pragma unroll
            for (int m = 0; m < 4; ++m) { bf16_t* rowp = Hs + (size_t)(row0 + ai * HALF + m * 16) * 256 + col0;
                f32x4 h0, h1;
#pragma unroll
                for (int t = 0; t < 4; ++t) { const float a0 = acc[ai][0][m][0][t], a1 = acc[ai][0][m][1][t]; h0[t] = a0 * fast_sigmoid(a0) * acc[ai][1][m][0][t]; h1[t] = a1 * fast_sigmoid(a1) * acc[ai][1][m][1][t]; }
                u32x4 w; w.x = cvt_pk_bf16(h0[0], h0[1]); w.y = cvt_pk_bf16(h0[2], h0[3]); w.z = cvt_pk_bf16(h1[0], h1[1]); w.w = cvt_pk_bf16(h1[2], h1[3]);
                *(u32x4*)rowp = w; }
    }
};
struct EpiMoeOut {
    static constexpr bool PERM = true, AFTER_DRAIN = false;
    bf16_t* Yp; const int* spair; const float* sw; const PG8_LAS int* panelValid;
    __device__ __forceinline__ void operator()(const f32x4 (&acc)[2][2][4][2], const Unit& u, int wr, int wc, int fr, int fq) const {
        const int jn = u.pn & 3, valid = panelValid[u.pm]; const int rl0 = wr * 64 + fr, col0 = jn * 256 + wc * 32 + 8 * fq;
#pragma unroll
        for (int ai = 0; ai < 2; ++ai)
#pragma unroll
            for (int m = 0; m < 4; ++m) { const int rl = rl0 + ai * HALF + m * 16;
                if (rl < valid) { const int slot = u.pm * BM + rl; const int pair = spair[slot]; const float w = sw[slot]; bf16_t* rowp = Yp + (size_t)pair * 1024 + col0;
#pragma unroll
                    for (int bj = 0; bj < 2; ++bj) { const f32x4 v0 = acc[ai][bj][m][0] * w, v1 = acc[ai][bj][m][1] * w;
                        u32x4 o; o.x = cvt_pk_bf16(v0[0], v0[1]); o.y = cvt_pk_bf16(v0[2], v0[3]); o.z = cvt_pk_bf16(v1[0], v1[1]); o.w = cvt_pk_bf16(v1[2], v1[3]);
                        *(u32x4*)(rowp + bj * HALF) = o; } } }
    }
};
struct MoeOrder {
    int vcu, G, P, nper; const PG8_LAS int* panelE;
    __device__ __forceinline__ bool next(int i, Unit& u) const { const int idx = vcu + G * i; if (idx >= nper * P) return false; const int p = idx / nper, j = idx - p * nper; u.pm = p; u.pn = panelE[p] * nper + j; return true; }
    __device__ __forceinline__ void a_ready(const Unit&) const {}
    __device__ __forceinline__ void done(const Unit&) const {}
};
template <class Epi, class Sched, bool ALIGN_EPI = false, bool SP2 = false>
__device__ __forceinline__ void gemm_phase(PG8_LAS unsigned char* lds, const Gemm g, const Sched& S, const Epi& E, const int wid) {
    const int lane = lane_id(), tid = wid * 64 + lane, wr = wid >> 2, wc = wid & 3, fr = lane & 15, fq = lane >> 4;
    const int K = g.K, nt = K / BK;
    unsigned voffA[2], voffB[2];
#pragma unroll
    for (int i = 0; i < 2; ++i) { int R, C; stage_rc(tid * 16 + i * 8192, R, C); const int Rb = Epi::PERM ? ((R & ~31) + perm32(R & 31)) : R;
        voffA[i] = (unsigned)(R * K + C) * 2u; voffB[i] = (unsigned)(Rb * K + C) * 2u; }
    const size_t kstep = (size_t)(BK * 2);
    const size_t hstep = (size_t)HALF * K * 2;
    const size_t tstep = 2 * hstep;
    const unsigned ldsw = (unsigned)wid * 1024u;
    const int aoff = lds_byte(wr * 64 + fr, fq * 8), boff = lds_byte(wc * 32 + fr, fq * 8);
#define PG8_SA(b, h) (((b) * 2 + (h)) * HTB)
#define PG8_SB(b, h) ((4 + (b) * 2 + (h)) * HTB)
#define PG8_STAGE(bufoff, gbase, voff) do { _Pragma("unroll") for (int _i = 0; _i < 2; ++_i) \
        __builtin_amdgcn_global_load_lds((const unsigned*)((const char*)(gbase) + (voff)[_i]), (PG8_LAS unsigned*)(lds + (bufoff) + ldsw + _i * 8192), 16, 0, 0); } while (0)
#define PG8_LDA(dst, b, h) do { _Pragma("unroll") for (int m = 0; m < 4; ++m) _Pragma("unroll") for (int k = 0; k < 2; ++k) dst[m][k] = *(const PG8_LAS bf16x8*)(lds + PG8_SA(b, h) + aoff + m * 2048 + k * 1024); } while (0)
#define PG8_LDB(dst, b, h) do { _Pragma("unroll") for (int n = 0; n < 2; ++n) _Pragma("unroll") for (int k = 0; k < 2; ++k) dst[n][k] = *(const PG8_LAS bf16x8*)(lds + PG8_SB(b, h) + boff + n * 2048 + k * 1024); } while (0)
#define PG8_MMA(ai, bj, At, Bt) do { __builtin_amdgcn_s_setprio(1); _Pragma("unroll") for (int m = 0; m < 4; ++m) _Pragma("unroll") for (int n = 0; n < 2; ++n) _Pragma("unroll") for (int k = 0; k < 2; ++k) \
        acc[ai][bj][m][n] = __builtin_amdgcn_mfma_f32_16x16x32_bf16(Bt[n][k], At[m][k], acc[ai][bj][m][n], 0, 0, 0); __builtin_amdgcn_s_setprio(0); } while (0)
#define PG8_WAIT_V(n) asm volatile("s_waitcnt vmcnt(" #n ")" ::: "memory")
#define PG8_WAIT_L(n) asm volatile("s_waitcnt lgkmcnt(" #n ")" ::: "memory")
#define PG8_BAR __builtin_amdgcn_s_barrier()
#define PG8_SCHED __builtin_amdgcn_sched_barrier(0)
    Unit cur, nxt; int ui = 0;
    if (!S.next(0, cur)) return;
    f32x4 acc[2][2][4][2];
#pragma unroll
    for (int a = 0; a < 2; ++a)
#pragma unroll
        for (int b = 0; b < 2; ++b)
#pragma unroll
            for (int m = 0; m < 4; ++m)
#pragma unroll
                for (int n = 0; n < 2; ++n) acc[a][b][m][n] = (f32x4){0.f, 0.f, 0.f, 0.f};
    bf16x8 At[4][2], B0[2][2], B1[2][2];
    const char* cA = (const char*)g.A + (size_t)cur.pm * tstep; const char* cB = (const char*)g.Bt + (size_t)cur.pn * tstep;
    S.a_ready(cur);
    if constexpr (SP2) {
        PG8_STAGE(PG8_SB(0, 0), cB, voffB); PG8_STAGE(PG8_SB(0, 1), cB + hstep, voffB); PG8_STAGE(PG8_SA(0, 0), cA, voffA); PG8_STAGE(PG8_SA(0, 1), cA + hstep, voffA);
        if (wr == 1) PG8_BAR;
        PG8_WAIT_V(2); PG8_BAR;
        PG8_STAGE(PG8_SB(1, 0), cB + kstep, voffB); PG8_STAGE(PG8_SA(1, 0), cA + kstep, voffA); PG8_STAGE(PG8_SB(1, 1), cB + hstep + kstep, voffB);
        PG8_WAIT_V(6); PG8_BAR;
    } else {
        PG8_STAGE(PG8_SB(0, 0), cB, voffB); PG8_STAGE(PG8_SA(0, 0), cA, voffA); PG8_STAGE(PG8_SB(0, 1), cB + hstep, voffB); PG8_STAGE(PG8_SA(0, 1), cA + hstep, voffA);
        if (wr == 1) PG8_BAR;
        PG8_WAIT_V(4); PG8_BAR;
        PG8_STAGE(PG8_SB(1, 0), cB + kstep, voffB); PG8_STAGE(PG8_SA(1, 0), cA + kstep, voffA); PG8_STAGE(PG8_SB(1, 1), cB + hstep + kstep, voffB);
        PG8_WAIT_V(6); PG8_BAR;
    }
    for (;;) {
        const bool has_next = S.next(ui + 1, nxt);
        const char* nA = has_next ? (const char*)g.A + (size_t)nxt.pm * tstep : cA; const char* nB = has_next ? (const char*)g.Bt + (size_t)nxt.pn * tstep : cB;
        for (int t = 0; t < nt; t += 2) {
            const bool last = (t == nt - 2);
            const char* a1 = cA + (size_t)(t + 1) * kstep;
            const char* a2 = last ? nA : cA + (size_t)(t + 2) * kstep; const char* b2 = last ? nB : cB + (size_t)(t + 2) * kstep;
            const char* a3 = a2 + kstep; const char* b3 = b2 + kstep;
            if (last && has_next) S.a_ready(nxt);
            if constexpr (SP2) {
            PG8_LDB(B0, 0, 0); PG8_LDB(B1, 0, 1); PG8_SCHED; PG8_LDA(At, 0, 0); PG8_STAGE(PG8_SA(1, 1), a1 + hstep, voffA);
            PG8_WAIT_V(8); PG8_WAIT_L(0); PG8_BAR; PG8_MMA(0, 0, At, B0); PG8_MMA(0, 1, At, B1); PG8_BAR; PG8_SCHED;
            PG8_LDA(At, 0, 1); PG8_STAGE(PG8_SB(0, 0), b2, voffB); PG8_STAGE(PG8_SB(0, 1), b2 + hstep, voffB); PG8_STAGE(PG8_SA(0, 0), a2, voffA);
            PG8_WAIT_V(8); PG8_WAIT_L(0); PG8_BAR; PG8_MMA(1, 0, At, B0); PG8_MMA(1, 1, At, B1); PG8_BAR; PG8_SCHED;
            PG8_LDB(B0, 1, 0); PG8_LDB(B1, 1, 1); PG8_SCHED; PG8_LDA(At, 1, 0); PG8_STAGE(PG8_SA(0, 1), a2 + hstep, voffA);
            PG8_WAIT_V(8); PG8_WAIT_L(0); PG8_BAR; PG8_MMA(0, 0, At, B0); PG8_MMA(0, 1, At, B1); PG8_BAR; PG8_SCHED;
            PG8_LDA(At, 1, 1); PG8_STAGE(PG8_SB(1, 0), b3, voffB); PG8_STAGE(PG8_SB(1, 1), b3 + hstep, voffB); PG8_STAGE(PG8_SA(1, 0), a3, voffA);
            PG8_WAIT_V(8); PG8_WAIT_L(0); PG8_BAR; PG8_MMA(1, 0, At, B0); PG8_MMA(1, 1, At, B1); PG8_BAR; PG8_SCHED;
            } else {
            PG8_LDB(B0, 0, 0); PG8_SCHED; PG8_LDA(At, 0, 0); PG8_STAGE(PG8_SA(1, 1), a1 + hstep, voffA);
            PG8_WAIT_L(8); PG8_BAR; PG8_WAIT_L(0); PG8_MMA(0, 0, At, B0); PG8_BAR; PG8_SCHED;
            PG8_LDB(B1, 0, 1); PG8_STAGE(PG8_SB(0, 0), b2, voffB);
            PG8_BAR; PG8_WAIT_L(0); PG8_MMA(0, 1, At, B1); PG8_BAR;
            PG8_LDA(At, 0, 1); PG8_STAGE(PG8_SA(0, 0), a2, voffA);
            PG8_BAR; PG8_WAIT_L(0); PG8_MMA(1, 0, At, B0); PG8_BAR; PG8_SCHED;
            PG8_STAGE(PG8_SB(0, 1), b2 + hstep, voffB);
            PG8_WAIT_V(6); PG8_BAR; PG8_MMA(1, 1, At, B1); PG8_BAR;
            PG8_LDB(B0, 1, 0); PG8_SCHED; PG8_LDA(At, 1, 0); PG8_STAGE(PG8_SA(0, 1), a2 + hstep, voffA);
            PG8_WAIT_L(8); PG8_BAR; PG8_WAIT_L(0); PG8_MMA(0, 0, At, B0); PG8_BAR; PG8_SCHED;
            PG8_LDB(B1, 1, 1); PG8_STAGE(PG8_SB(1, 0), b3, voffB);
            PG8_BAR; PG8_WAIT_L(0); PG8_MMA(0, 1, At, B1); PG8_BAR;
            PG8_LDA(At, 1, 1); PG8_STAGE(PG8_SA(1, 0), a3, voffA);
            PG8_BAR; PG8_WAIT_L(0); PG8_MMA(1, 0, At, B0); PG8_BAR; PG8_SCHED;
            PG8_STAGE(PG8_SB(1, 1), b3 + hstep, voffB);
            PG8_WAIT_V(6); PG8_BAR; PG8_MMA(1, 1, At, B1); PG8_BAR;
            }
        }
        if constexpr (ALIGN_EPI) { if (wr == 0) PG8_BAR; }
        if constexpr (!Epi::AFTER_DRAIN) { E(acc, cur, wr, wc, fr, fq); S.done(cur); }
        if (!has_next) break;
#pragma unroll
        for (int a = 0; a < 2; ++a)
#pragma unroll
            for (int b = 0; b < 2; ++b)
#pragma unroll
                for (int m = 0; m < 4; ++m)
#pragma unroll
                    for (int n = 0; n < 2; ++n) acc[a][b][m][n] = (f32x4){0.f, 0.f, 0.f, 0.f};
        cur = nxt; cA = nA; cB = nB; ++ui;
        if constexpr (ALIGN_EPI) { if (wr == 1) PG8_BAR; }
    }
    PG8_WAIT_V(0);
    if constexpr (!ALIGN_EPI) { if (wr == 0) PG8_BAR; }
    PG8_BAR;
    if constexpr (Epi::AFTER_DRAIN) { E.fused(acc, cur, wr, wc, fr, fq, lds, wid, lane); S.done(cur); }
#undef PG8_SA
#undef PG8_SB
#undef PG8_STAGE
#undef PG8_LDA
#undef PG8_LDB
#undef PG8_MMA
#undef PG8_WAIT_V
#undef PG8_WAIT_L
#undef PG8_BAR
#undef PG8_SCHED
}
}

#ifndef PG8_SP2
#define PG8_SP2 true
#endif
#ifndef PG8_ALIGN
#define PG8_ALIGN true
#endif
#define GAS __attribute__((address_space(1)))
#define LAS __attribute__((address_space(3)))
typedef unsigned short bf16;
typedef unsigned v4u __attribute__((ext_vector_type(4)));
typedef float f32x4 __attribute__((ext_vector_type(4)));
typedef short bf16x8 __attribute__((ext_vector_type(8)));
typedef GAS unsigned gu32;
typedef GAS unsigned long long gu64;
#define RLX_AGENT __ATOMIC_RELAXED, __HIP_MEMORY_SCOPE_AGENT
#define LDS_WAIT() asm volatile("s_waitcnt lgkmcnt(0)" ::: "memory")
#define VM_WAIT() asm volatile("s_waitcnt vmcnt(0)" ::: "memory")
__device__ __forceinline__ unsigned long long rt() { return __builtin_amdgcn_s_memrealtime(); }
__device__ __forceinline__ unsigned f2bf(float f) { unsigned u = __builtin_bit_cast(unsigned, f); return (u + 0x7fffu + ((u >> 16) & 1u)) >> 16; }
__device__ __forceinline__ unsigned pk2(float lo, float hi) { return f2bf(lo) | (f2bf(hi) << 16); }

#define XB_TMO      128
#define XB_XCNT(j)  (256  + 64 * (j))
#define XB_XSUB(j)  (1280 + 64 * (j))
#define XB_XGEN(j)  (2304 + 64 * (j))
#define XB_TOP      3328
#define XB_TOPGEN   3392
#define XCD_BAR_WORDS 3456
#define XB_SPIN_CAP (1u << 18)

__device__ __forceinline__ unsigned xb_ld(unsigned* p)              { return __hip_atomic_load(p, __ATOMIC_RELAXED, __HIP_MEMORY_SCOPE_AGENT); }
__device__ __forceinline__ unsigned xb_add(unsigned* p, unsigned v) { return __hip_atomic_fetch_add(p, v, __ATOMIC_RELAXED, __HIP_MEMORY_SCOPE_AGENT); }
__device__ __forceinline__ unsigned xb_xcc_id() { return (unsigned)__builtin_amdgcn_s_getreg((3 << 11) | 20) & 0xFu; }
#define XB_SPIN(cond, bar) do { unsigned _sp = 0; while (cond) { __builtin_amdgcn_s_sleep(1); \
    if ((++_sp & 255u) == 0u) { if (xb_ld(&(bar)[XB_TMO])) break; if (_sp > XB_SPIN_CAP) { atomicAdd(&(bar)[XB_TMO], 1u); break; } } } } while (0)

struct XcdBarrier {
    unsigned* bar; unsigned x; unsigned w;
    volatile LAS unsigned* st;
};

__device__ __forceinline__ XcdBarrier xcd_barrier_post(unsigned* bar, volatile LAS unsigned* st, unsigned wave) {
    XcdBarrier b; b.bar = bar; b.x = xb_xcc_id(); b.st = st; b.w = wave;
    if (wave == 0u && lane_id() == 0) (void)xb_add(&bar[XB_XCNT(b.x)], 1u);
    return b;
}
__device__ __forceinline__ void xcd_barrier_complete(unsigned* bar, unsigned x, unsigned& nloc, unsigned& nx) {
    const unsigned G = gridDim.x * gridDim.y * gridDim.z;
    unsigned sum, cnt, mine, sp = 0u;
    for (;;) {
        sum = 0u; cnt = 0u; mine = 0u;
#pragma unroll
        for (unsigned j = 0; j < 16; ++j) { const unsigned c = xb_ld(&bar[XB_XCNT(j)]); sum += c; cnt += (c > 0u) ? 1u : 0u; mine = (j == x) ? c : mine; }
        if (sum == G) break;
        __builtin_amdgcn_s_sleep(1);
        if ((++sp & 255u) == 0u) { if (xb_ld(&bar[XB_TMO])) break; if (sp > XB_SPIN_CAP) { atomicAdd(&bar[XB_TMO], 1u); break; } }
    }
    nloc = mine > 0u ? mine : 1u; nx = cnt > 0u ? cnt : 1u;
}

__device__ __forceinline__ void xcd_barrier(const XcdBarrier& b) {
    asm volatile("s_waitcnt vmcnt(0)" ::: "memory");
    __syncthreads();
    if (b.w == 0u && lane_id() == 0) {
        unsigned* bar = b.bar;
        __builtin_amdgcn_s_waitcnt(0);
        unsigned nloc = b.st[0], nx = b.st[1];
        if (nloc == 0u) { xcd_barrier_complete(bar, b.x, nloc, nx); b.st[0] = nloc; b.st[1] = nx; }
        const unsigned old = xb_add(&bar[XB_XSUB(b.x)], 1u);
        const unsigned gen = old / nloc;
        if (old + 1u == (gen + 1u) * nloc) {
            __builtin_amdgcn_fence(__ATOMIC_RELEASE, "agent");
            asm volatile("s_waitcnt vmcnt(0)" ::: "memory");
            const unsigned og = xb_add(&bar[XB_TOP], 1u);
            const unsigned tg = og / nx;
            if (og + 1u == (tg + 1u) * nx) xb_add(&bar[XB_TOPGEN], 1u);
            else XB_SPIN(xb_ld(&bar[XB_TOPGEN]) == tg, bar);
            __builtin_amdgcn_fence(__ATOMIC_ACQUIRE, "agent");
            xb_add(&bar[XB_XGEN(b.x)], 1u);
            asm volatile("s_waitcnt vmcnt(0)" ::: "memory");
        } else {
            XB_SPIN(xb_ld(&bar[XB_XGEN(b.x)]) == gen, bar);
            __builtin_amdgcn_fence(__ATOMIC_ACQUIRE, "agent");
            asm volatile("s_waitcnt vmcnt(0)" ::: "memory");
        }
    }
    __syncthreads();
}
#include <hip/hip_bf16.h>
#include <cmath>
namespace attn_body {
using bf16=__hip_bfloat16;
using bf16x8=__attribute__((ext_vector_type(8)))short;
using s16x4=__attribute__((ext_vector_type(4)))short;
using f32x16=__attribute__((ext_vector_type(16)))float;
using u32x4=__attribute__((ext_vector_type(4)))unsigned;
constexpr int BATCH=8,NHEAD=8,SEQ=2048,D=64,DM=NHEAD*D;
constexpr int NW=8,QBLK=32,QB=QBLK*NW,KVBLK=64,NQB=SEQ/QB;
constexpr int ATTN_PITCH=DM, ATTN_UNIT_ROWS=QB;
__device__ __forceinline__ int crow(int r,int hi){return (r&3)+8*(r>>2)+4*hi;}
#define SBAR() __builtin_amdgcn_sched_barrier(0)
__device__ __forceinline__ void cmask(f32x16&p0,f32x16&p1,int jb,int qrel,int hi){
  const float NEG=-INFINITY; int kb=64*jb+4*hi;
  #pragma unroll
  for(int r=0;r<16;++r){int kv=kb+(r&3)+8*(r>>2); if(kv>qrel)p0[r]=NEG; if(kv+32>qrel)p1[r]=NEG;}
}

constexpr int NSLOT=3, SLOTB=8192;
constexpr int LDS_K=0, LDS_V=NSLOT*SLOTB, LDS_WS=2*NSLOT*SLOTB, LDS_OST=LDS_WS+NW*64*4, LDS_BYTES=LDS_OST+NW*4096;
constexpr float C2=0.125f*1.4426950408889634f;
__device__ __forceinline__ void glds16(const void*gsrc,unsigned lds_dst){unsigned keep;
  asm volatile("s_mov_b32 %0, m0\n\ts_mov_b32 m0, %2\n\ts_nop 0\n\tglobal_load_lds_dwordx4 %1, off\n\ts_mov_b32 m0, %0":"=&s"(keep):"v"(gsrc),"s"(lds_dst):"memory");}
__device__ __forceinline__ float max3f(float a,float b,float c){float r;asm("v_max3_f32 %0, %1, %2, %3":"=v"(r):"v"(a),"v"(b),"v"(c));return r;}
__device__ __forceinline__ float max2f(float a,float b){float r;asm("v_max_f32_e32 %0, %1, %2":"=v"(r):"v"(a),"v"(b));return r;}
__device__ __forceinline__ float fadd_s(float a,float b){float r;asm("v_add_f32_e32 %0, %1, %2":"=v"(r):"v"(a),"v"(b));return r;}
__device__ __forceinline__ float fsub_s(float a,float b){float r;asm("v_sub_f32_e32 %0, %1, %2":"=v"(r):"v"(a),"v"(b));return r;}
typedef float f32x2_t __attribute__((ext_vector_type(2))); typedef __bf16 bf16x2_t __attribute__((ext_vector_type(2)));
__device__ __forceinline__ unsigned cvtpk_s(float lo,float hi){f32x2_t v={lo,hi};bf16x2_t b=__builtin_convertvector(v,bf16x2_t);return __builtin_bit_cast(unsigned,b);}
#define WAIT_BAR(N) asm volatile("s_waitcnt vmcnt(" #N ") lgkmcnt(0)\n\ts_barrier":::"memory")

__device__ __forceinline__ void qkt(f32x16&p0,f32x16&p1,const char*Kslot,const bf16x8*qr,const f32x16&negm,int r32,int hi){
  const char*kb=Kslot+hi*1024+r32*16;
  #pragma unroll
  for(int d0=0;d0<4;++d0){
    const bf16x8 b0=*reinterpret_cast<const bf16x8*>(kb+d0*2048);
    const bf16x8 b1=*reinterpret_cast<const bf16x8*>(kb+d0*2048+512);
    if(d0==0){p0=__builtin_amdgcn_mfma_f32_32x32x16_bf16(b0,qr[0],negm,0,0,0);p1=__builtin_amdgcn_mfma_f32_32x32x16_bf16(b1,qr[0],negm,0,0,0);}
    else{p0=__builtin_amdgcn_mfma_f32_32x32x16_bf16(b0,qr[d0],p0,0,0,0);p1=__builtin_amdgcn_mfma_f32_32x32x16_bf16(b1,qr[d0],p1,0,0,0);}}
}
typedef __attribute__((address_space(3))) const char* lds_cptr;
typedef short v4i16_t __attribute__((ext_vector_type(4)));
__device__ __forceinline__ void kload8(bf16x8*kf,lds_cptr kp){
  kf[0]=*(const __attribute__((address_space(3))) bf16x8*)(kp);      kf[1]=*(const __attribute__((address_space(3))) bf16x8*)(kp+512);
  kf[2]=*(const __attribute__((address_space(3))) bf16x8*)(kp+2048); kf[3]=*(const __attribute__((address_space(3))) bf16x8*)(kp+2560);
  kf[4]=*(const __attribute__((address_space(3))) bf16x8*)(kp+4096); kf[5]=*(const __attribute__((address_space(3))) bf16x8*)(kp+4608);
  kf[6]=*(const __attribute__((address_space(3))) bf16x8*)(kp+6144); kf[7]=*(const __attribute__((address_space(3))) bf16x8*)(kp+6656);
}
__device__ __forceinline__ void kload2(bf16x8*kf,lds_cptr kp,int j){ kf[2*j]=*(const __attribute__((address_space(3))) bf16x8*)(kp+j*2048); kf[2*j+1]=*(const __attribute__((address_space(3))) bf16x8*)(kp+j*2048+512); }
__device__ __forceinline__ s16x4 vtr(lds_cptr p){ return __builtin_bit_cast(s16x4,__builtin_amdgcn_ds_read_tr16_b64_v4i16((__attribute__((address_space(3))) v4i16_t*)p)); }
__device__ __forceinline__ float rowmax(const f32x16&p0,const f32x16&p1){
  float a=max3f(p0[0],p0[1],p1[0]),b=max3f(p0[2],p0[3],p1[1]);a=max3f(a,p1[2],p1[3]);
  #pragma unroll
  for(int r=4;r<16;r+=4){a=max3f(a,p0[r],p0[r+1]);b=max3f(b,p0[r+2],p0[r+3]);a=max3f(a,p1[r],p1[r+1]);b=max3f(b,p1[r+2],p1[r+3]);}
  const float m=max2f(a,b);
  auto rr=__builtin_amdgcn_permlane32_swap(__float_as_uint(m),__float_as_uint(m),false,false);
  return max2f(__uint_as_float(rr[0]),__uint_as_float(rr[1]));
}
__device__ __forceinline__ void pv(f32x16*o,int vb,bf16x8 pa0,bf16x8 pa1,bf16x8 pa2,bf16x8 pa3){
  #pragma unroll
  for(int d0=0;d0<2;++d0){s16x4 lo[4],hi[4];
    #pragma unroll
    for(int ks=0;ks<4;++ks){
      asm volatile("ds_read_b64_tr_b16 %0,%1 offset:%c2":"=&v"(lo[ks]):"v"(vb),"i"(d0*4096+ks*1024):"memory");
      asm volatile("ds_read_b64_tr_b16 %0,%1 offset:%c2":"=&v"(hi[ks]):"v"(vb),"i"(d0*4096+ks*1024+512):"memory");}
    asm volatile("s_waitcnt lgkmcnt(0)":::"memory");SBAR();
    #define PK(k) (bf16x8){lo[k][0],lo[k][1],lo[k][2],lo[k][3],hi[k][0],hi[k][1],hi[k][2],hi[k][3]}
    o[d0]=__builtin_amdgcn_mfma_f32_32x32x16_bf16(pa0,PK(0),o[d0],0,0,0);
    o[d0]=__builtin_amdgcn_mfma_f32_32x32x16_bf16(pa1,PK(1),o[d0],0,0,0);
    o[d0]=__builtin_amdgcn_mfma_f32_32x32x16_bf16(pa2,PK(2),o[d0],0,0,0);
    o[d0]=__builtin_amdgcn_mfma_f32_32x32x16_bf16(pa3,PK(3),o[d0],0,0,0);
    #undef PK
  }
}

#ifndef ATTN_STORE16
#define ATTN_STORE16(p,v) (*(u32x4*)(p)=(v))
#endif
template<int THRL> __device__ __forceinline__ void attn_unit(int b,int h,int qb,const bf16*Q,const bf16*__restrict__ K,const bf16*__restrict__ V,bf16*O,char*shm,const float*__restrict__ kmean,const int wid){
  const int lane=lane_id(),r32=lane&31,hi=lane>>5;
  const long rowbase=(long)b*SEQ; const int q0=qb*QB;
  const bf16*Qw=Q+(rowbase+q0+wid*QBLK)*DM+h*D;
  const bf16*Kh=K+rowbase*DM+h*D,*Vh=V+rowbase*DM+h*D;
  const unsigned lds0=(unsigned)(uintptr_t)shm;
  float*wsf=(float*)(shm+LDS_WS)+wid*64;
  const bf16*ksrc=Kh+(long)lane*DM+wid*8;
  const bf16*vsrc=Vh+(long)(16*(wid&3)+(lane>>2))*DM+(wid>>2)*32+(lane&3)*8;
  const unsigned kdst=lds0+LDS_K+wid*1024, vdst=lds0+LDS_V+wid*1024;
  #define DMA_K(t,slot) glds16(ksrc+(long)(t)*KVBLK*DM,(unsigned)__builtin_amdgcn_readfirstlane(kdst+(slot)))
  #define DMA_V(t,slot) glds16(vsrc+(long)(t)*KVBLK*DM,(unsigned)__builtin_amdgcn_readfirstlane(vdst+(slot)))
  const int vb0=(int)(lds0+LDS_V)+((lane>>4)&1)*32+(lane&3)*8+(4*hi+((lane&15)>>2))*64;
  const char*Kbase=shm+LDS_K; bf16x8 kf[8];
  const lds_cptr shm3=(lds_cptr)shm; const lds_cptr kp0=shm3+LDS_K+hi*1024+r32*16; const lds_cptr vp0=shm3+LDS_V+((lane>>4)&1)*32+(lane&3)*8+(4*hi+((lane&15)>>2))*64;
  const int NT=(q0+QB)/KVBLK;
  DMA_K(0,0);DMA_V(0,0);DMA_K(1,SLOTB);
  bf16x8 qr[4];
  #pragma unroll
  for(int d0=0;d0<4;++d0)qr[d0]=*reinterpret_cast<const bf16x8*>(&Qw[(long)r32*DM+d0*16+hi*8]);
  unsigned sel=0xffu;
  if(qb>3){
    float g[8];
    #pragma unroll
    for(int blk=0;blk<7;++blk){ float sdot=0.f;
      if(blk<qb){ const float*km=kmean+((long)(b*NHEAD+h)*8+blk)*64+hi*8;
        #pragma unroll
        for(int d0=0;d0<4;++d0){ const float4 ka=*(const float4*)(km+d0*16), kb=*(const float4*)(km+d0*16+4); const bf16x8 qv=qr[d0];
          sdot+=__uint_as_float((unsigned)(unsigned short)qv[0]<<16)*ka.x+__uint_as_float((unsigned)(unsigned short)qv[1]<<16)*ka.y+__uint_as_float((unsigned)(unsigned short)qv[2]<<16)*ka.z+__uint_as_float((unsigned)(unsigned short)qv[3]<<16)*ka.w
               +__uint_as_float((unsigned)(unsigned short)qv[4]<<16)*kb.x+__uint_as_float((unsigned)(unsigned short)qv[5]<<16)*kb.y+__uint_as_float((unsigned)(unsigned short)qv[6]<<16)*kb.z+__uint_as_float((unsigned)(unsigned short)qv[7]<<16)*kb.w; }
        auto rr=__builtin_amdgcn_permlane32_swap(__float_as_uint(sdot),__float_as_uint(sdot),false,false); sdot=__uint_as_float(rr[0])+__uint_as_float(rr[1]); }
      g[blk]=blk<qb?sdot:-INFINITY; }
    g[7]=-INFINITY; sel=0u;
    #pragma unroll
    for(int rnd=0;rnd<3;++rnd){ float best=-INFINITY; int bi=-1;
      #pragma unroll
      for(int blk=0;blk<8;++blk){ const bool ok=!((sel>>blk)&1u)&&g[blk]>best; if(ok){best=g[blk];bi=blk;} }
      if(bi>=0)sel|=1u<<bi; }
  }
  #define BMASK(P0,P1,t) do{ const int blk_=(t)>>2; if(blk_<qb){ if(!((sel>>blk_)&1u)){ _Pragma("unroll") for(int r=0;r<16;++r){P0[r]=-1000.f;P1[r]=-1000.f;} } } }while(0)
  float mhat=0.f,l_reg=0.f;f32x16 o[2];o[0]=f32x16{};o[1]=f32x16{};const f32x16 zero16=f32x16{};
  const int qrel=wid*QBLK+r32;
  #define CMASK(P0,P1,t) do{int jb_=(t)-(NT-4); if(jb_>=0)cmask(P0,P1,jb_,qrel,hi);}while(0)
  bool resc=false;
  #define START(P0,P1) do{ const float rm=rowmax(P0,P1); resc=false; \
    { const float dl=rm; mhat=fadd_s(mhat,dl); \
      _Pragma("unroll") for(int r=0;r<16;++r){P0[r]=fsub_s(P0[r],dl);P1[r]=fsub_s(P1[r],dl);} \
      } \
    _Pragma("unroll") for(int r=0;r<16;++r)P0[r]=__builtin_amdgcn_exp2f(P0[r]); }while(0)
  #define RESC() do{ if(resc){ asm volatile("s_waitcnt lgkmcnt(0)":::"memory"); \
      _Pragma("unroll") for(int d_=0;d_<2;++d_) _Pragma("unroll") for(int r=0;r<16;++r)o[d_][r]*=wsf[crow(r,hi)]; } }while(0)
  f32x16 pA0,pA1,pB0,pB1;
  int sl_prev=0,sl_cur=0,sl_next=SLOTB;
  #define ROT() do{sl_prev=sl_cur;sl_cur=sl_next;sl_next=(sl_next==(NSLOT-1)*SLOTB)?0:sl_next+SLOTB;}while(0)
  DMA_K(2,2*SLOTB);
  WAIT_BAR(3);
  qkt(pA0,pA1,Kbase,qr,zero16,r32,hi);asm volatile("s_nop 15\n\ts_nop 7":"+v"(pA0),"+v"(pA1));CMASK(pA0,pA1,0);BMASK(pA0,pA1,0);
  START(pA0,pA1);
  _Pragma("unroll") for(int r=0;r<16;++r)pA1[r]=__builtin_amdgcn_exp2f(pA1[r]);
  WAIT_BAR(0);
  DMA_K(3,0);DMA_V(1,SLOTB);
  ROT();
  kload8(kf,kp0+sl_cur);
  WAIT_BAR(2);
  s16x4 vlo[8],vhi[8]; u32x4 pw0,pw1,pw2,pw3;
  #define PKW(P,B) cvtpk_s(P[B],P[B+1])
  #define PAF(k) __builtin_bit_cast(bf16x8,pw##k)
  #define VFR(i) (bf16x8){vlo[i][0],vlo[i][1],vlo[i][2],vlo[i][3],vhi[i][0],vhi[i][1],vhi[i][2],vhi[i][3]}
  #define PIN(x) asm volatile("":"+v"(x))
  #define MX3(a,b,c) __builtin_fmaxf(__builtin_fmaxf((a),(b)),(c))
  #define GAPA(MF,A0,A1,A2,A3,W0,W1,PW) do{ MF; sacc+=A0; sacc+=A1; sacc+=A2; sacc+=A3; PIN(sacc); W0; W1; PIN(PW); SBAR(); }while(0)
  #define EX(v) __builtin_amdgcn_exp2f(v)
  #define GAPB(MF,X,B) do{ MF; X[B]=EX(X[B]); X[B+1]=EX(X[B+1]); X[B+2]=EX(X[B+2]); X[B+3]=EX(X[B+3]); PIN(X); SBAR(); }while(0)
  #define VRD(i) do{ vlo[i]=vtr(vp_+(((i)>>2)*4096+((i)&3)*1024)); vhi[i]=vtr(vp_+(((i)>>2)*4096+((i)&3)*1024+512)); }while(0)
  #define KRD(G,j) do{ if(G){ kload2(kf,kp0+sl_next,j); SBAR(); } }while(0)
  #define STEP(C0,C1,P0,P1,t,GK,GV,GL) do{ SBAR(); \
    const lds_cptr vp_=vp0+sl_prev; \
    float sacc=(P0[0]+P0[1]); \
    GAPA(C0=__builtin_amdgcn_mfma_f32_32x32x16_bf16(kf[0],qr[0],zero16,0,0,0), P0[2],P0[3],P0[4],P0[5],     pw0[0]=PKW(P0,0), pw0[1]=PKW(P0,2), pw0); \
    GAPA(C1=__builtin_amdgcn_mfma_f32_32x32x16_bf16(kf[1],qr[0],zero16,0,0,0), P0[6],P0[7],P0[8],P0[9],     pw0[2]=PKW(P0,4), pw0[3]=PKW(P0,6), pw0); \
    GAPA(C0=__builtin_amdgcn_mfma_f32_32x32x16_bf16(kf[2],qr[1],C0,0,0,0),   P0[10],P0[11],P0[12],P0[13], pw1[0]=PKW(P0,8), pw1[1]=PKW(P0,10), pw1); \
    GAPA(C1=__builtin_amdgcn_mfma_f32_32x32x16_bf16(kf[3],qr[1],C1,0,0,0),   P0[14],P0[15],P1[0],P1[1],   pw1[2]=PKW(P0,12),pw1[3]=PKW(P0,14), pw1); \
    GAPA(C0=__builtin_amdgcn_mfma_f32_32x32x16_bf16(kf[4],qr[2],C0,0,0,0),   P1[2],P1[3],P1[4],P1[5],     pw2[0]=PKW(P1,0), pw2[1]=PKW(P1,2), pw2); \
    GAPA(C1=__builtin_amdgcn_mfma_f32_32x32x16_bf16(kf[5],qr[2],C1,0,0,0),   P1[6],P1[7],P1[8],P1[9],     pw2[2]=PKW(P1,4), pw2[3]=PKW(P1,6), pw2); \
    VRD(0); SBAR(); GAPA(C0=__builtin_amdgcn_mfma_f32_32x32x16_bf16(kf[6],qr[3],C0,0,0,0),   P1[10],P1[11],P1[12],P1[13], pw3[0]=PKW(P1,8), pw3[1]=PKW(P1,10), pw3); \
    VRD(4); SBAR(); GAPA(C1=__builtin_amdgcn_mfma_f32_32x32x16_bf16(kf[7],qr[3],C1,0,0,0),   P1[14],P1[15],0.f,0.f,       pw3[2]=PKW(P1,12),pw3[3]=PKW(P1,14), pw3); \
    l_reg+=sacc; \
    _Pragma("unroll") for(int r=0;r<16;++r){C0[r]-=mhat;C1[r]-=mhat;} \
    if(GK){DMA_K((t)+3,sl_cur);} if(GV){DMA_V((t)+1,sl_next);} \
    CMASK(C0,C1,t); BMASK(C0,C1,t); \
    { float a=MX3(C0[0],C0[1],C1[0]),b=MX3(C0[2],C0[3],C1[1]); a=MX3(a,C1[2],C1[3]); \
      _Pragma("unroll") for(int r=4;r<16;r+=4){a=MX3(a,C0[r],C0[r+1]);b=MX3(b,C0[r+2],C0[r+3]);a=MX3(a,C1[r],C1[r+1]);b=MX3(b,C1[r+2],C1[r+3]);} \
      float rm=__builtin_fmaxf(a,b); { auto rr=__builtin_amdgcn_permlane32_swap(__float_as_uint(rm),__float_as_uint(rm),false,false); rm=__builtin_fmaxf(__uint_as_float(rr[0]),__uint_as_float(rr[1])); } \
      resc=false; \
      if(__builtin_expect(__any(rm>(float)THRL),0)){ const float dl=__builtin_fmaxf(rm,0.f); mhat+=dl; \
        _Pragma("unroll") for(int r=0;r<16;++r){C0[r]-=dl;C1[r]-=dl;} \
        const float f=__builtin_amdgcn_exp2f(-dl); l_reg*=f; if(hi==0)wsf[r32]=f; resc=true; } } \
    SBAR(); \
    VRD(1); SBAR(); GAPB(o[0]=__builtin_amdgcn_mfma_f32_32x32x16_bf16(PAF(0),VFR(0),o[0],0,0,0), C0,0); \
    VRD(5); SBAR(); GAPB(o[1]=__builtin_amdgcn_mfma_f32_32x32x16_bf16(PAF(0),VFR(4),o[1],0,0,0), C0,4); \
    VRD(2); SBAR(); KRD(GL,0); GAPB(o[0]=__builtin_amdgcn_mfma_f32_32x32x16_bf16(PAF(1),VFR(1),o[0],0,0,0), C0,8); \
    VRD(6); SBAR(); KRD(GL,1); GAPB(o[1]=__builtin_amdgcn_mfma_f32_32x32x16_bf16(PAF(1),VFR(5),o[1],0,0,0), C0,12); \
    VRD(3); SBAR(); KRD(GL,2); GAPB(o[0]=__builtin_amdgcn_mfma_f32_32x32x16_bf16(PAF(2),VFR(2),o[0],0,0,0), C1,0); \
    VRD(7); SBAR(); KRD(GL,3); GAPB(o[1]=__builtin_amdgcn_mfma_f32_32x32x16_bf16(PAF(2),VFR(6),o[1],0,0,0), C1,4); \
    GAPB(o[0]=__builtin_amdgcn_mfma_f32_32x32x16_bf16(PAF(3),VFR(3),o[0],0,0,0), C1,8); \
    GAPB(o[1]=__builtin_amdgcn_mfma_f32_32x32x16_bf16(PAF(3),VFR(7),o[1],0,0,0), C1,12); \
    }while(0)
  int t=1;
  #undef CMASK
  #define CMASK(P0,P1,t) do{}while(0)
  for(;t+5<NT;t+=2){
    STEP(pB0,pB1,pA0,pA1,t,true,true,true);     WAIT_BAR(2); RESC(); ROT();
    STEP(pA0,pA1,pB0,pB1,t+1,true,true,true);   WAIT_BAR(2); RESC(); ROT();
  }
  #undef CMASK
  const int laneB=lane_id(); const int qrelB=wid*QBLK+(laneB&31), hiB=laneB>>5;
  #define CMASK(P0,P1,t) do{int jb_=(t)-(NT-4); if(jb_>=0)cmask(P0,P1,jb_,qrelB,hiB);}while(0)
  #define ENDW(tt) do{ if((tt)+3<NT){WAIT_BAR(2);} else if((tt)+2<NT){WAIT_BAR(1);} else {WAIT_BAR(0);} }while(0)
  for(;t+1<NT;t+=2){
    STEP(pB0,pB1,pA0,pA1,t,(t+3<NT),(t+1<NT),(t+1<NT));       ENDW(t);   RESC(); ROT();
    STEP(pA0,pA1,pB0,pB1,t+1,(t+4<NT),(t+2<NT),(t+2<NT));     ENDW(t+1); RESC(); ROT();
  }
  STEP(pB0,pB1,pA0,pA1,NT-1,false,false,false); RESC();
  { float sacc=pB0[0]+pB0[1]; _Pragma("unroll") for(int r=2;r<16;++r)sacc+=pB0[r]; _Pragma("unroll") for(int r=0;r<16;++r)sacc+=pB1[r]; l_reg+=sacc;
    pw0=(u32x4){PKW(pB0,0),PKW(pB0,2),PKW(pB0,4),PKW(pB0,6)};pw1=(u32x4){PKW(pB0,8),PKW(pB0,10),PKW(pB0,12),PKW(pB0,14)};pw2=(u32x4){PKW(pB1,0),PKW(pB1,2),PKW(pB1,4),PKW(pB1,6)};pw3=(u32x4){PKW(pB1,8),PKW(pB1,10),PKW(pB1,12),PKW(pB1,14)};
    SBAR(); pv(o,vb0+sl_cur,PAF(0),PAF(1),PAF(2),PAF(3)); }
  #undef PKW
  #undef PAF
  #undef VFR
  #undef PIN
  #undef MX3
  #undef GAPA
  #undef GAPB
  #undef EX
  #undef VRD
  #undef KRD
  #undef STEP
  #undef ENDW
  {auto rr=__builtin_amdgcn_permlane32_swap(__float_as_uint(l_reg),__float_as_uint(l_reg),false,false);l_reg=__uint_as_float(rr[0])+__uint_as_float(rr[1]);}
  const int laneE=lane_id(); const int r32E=laneE&31, hiE=laneE>>5; float*wsfE=(float*)(shm+LDS_WS)+wid*64;
  if(hiE==0)wsfE[32+r32E]=l_reg;asm volatile("s_waitcnt lgkmcnt(0)":::"memory");
  float rli[16];
  #pragma unroll
  for(int r=0;r<16;++r)rli[r]=__builtin_amdgcn_rcpf(wsfE[32+crow(r,hiE)]);
  bf16*Ow=O+(rowbase+q0+wid*QBLK)*DM+h*D;
  { bf16*stg=(bf16*)(shm+LDS_OST)+wid*2048;
    #pragma unroll
    for(int r=0;r<16;++r){const int orow=crow(r,hiE);
      #pragma unroll
      for(int d0=0;d0<2;++d0)stg[orow*64+d0*32+r32E]=__float2bfloat16(o[d0][r]*rli[r]);}
    asm volatile("s_waitcnt lgkmcnt(0)":::"memory");
    #pragma unroll
    for(int i=0;i<4;++i){const int row=i*8+(laneE>>3),ch=laneE&7; const u32x4 v=*(const u32x4*)(stg+row*64+ch*8); ATTN_STORE16(Ow+(long)row*DM+ch*8,v);} }
  asm volatile("s_waitcnt lgkmcnt(0)\n\ts_barrier":::"memory");
  #undef BMASK
  #undef DMA_K
  #undef DMA_V
  #undef CMASK
  #undef START
  #undef RESC
  #undef ROT
}
constexpr int ATTN_LDS_BYTES=LDS_BYTES;
struct AttnTensors { const bf16* Q; const bf16* K; const bf16* V; bf16* O; };
struct AttnUnit { int bh; int qb; };
struct StaticOrder {
  int vcu,G;
  __device__ __forceinline__ explicit StaticOrder(int grid,int block):vcu((grid%8==0)?(block%8)*(grid/8)+block/8:block),G(grid){}
  __device__ __forceinline__ bool next(int i,AttnUnit&u)const{ const int v=vcu+G*(i>>1); if(v>=256)return false; const int s=v&3; u.bh=v>>2; u.qb=(i&1)?7-s:s; return true; }
  __device__ __forceinline__ void a_ready(const AttnUnit&)const{}
  __device__ __forceinline__ void done(const AttnUnit&)const{}
};
template<class Sched,int THRL=8> __device__ __forceinline__ void attn_phase(char*lds,const AttnTensors&T,const Sched&S,const float*kmean,const int wid){
  AttnUnit u;
  for(int i=0;S.next(i,u);++i){ S.a_ready(u); attn_unit<THRL>(u.bh/NHEAD,u.bh%NHEAD,u.qb,T.Q,T.K,T.V,T.O,lds,kmean,wid); S.done(u); }
}
#undef SBAR
#undef WAIT_BAR
}
__device__ __forceinline__ float bf2f(bf16 v) { return __uint_as_float((unsigned)v << 16); }
__device__ __forceinline__ float sigmoidf_(float x) { return 1.0f / (1.0f + __expf(-x)); }
__device__ __forceinline__ float wave_sum(float v) {
#pragma unroll
    for (int o = 1; o < 64; o <<= 1) v += __shfl_xor(v, o);
    return v;
}
__device__ __forceinline__ void load64(const bf16* p, float (&x)[64]) {
#pragma unroll
    for (int i = 0; i < 8; ++i) { const uint4 v = ((const uint4*)p)[i];
        x[8 * i + 0] = __uint_as_float(v.x << 16); x[8 * i + 1] = __uint_as_float(v.x & 0xffff0000u);
        x[8 * i + 2] = __uint_as_float(v.y << 16); x[8 * i + 3] = __uint_as_float(v.y & 0xffff0000u);
        x[8 * i + 4] = __uint_as_float(v.z << 16); x[8 * i + 5] = __uint_as_float(v.z & 0xffff0000u);
        x[8 * i + 6] = __uint_as_float(v.w << 16); x[8 * i + 7] = __uint_as_float(v.w & 0xffff0000u); }
}
__device__ __forceinline__ void store64(bf16* p, const float (&x)[64]) {
#pragma unroll
    for (int i = 0; i < 8; ++i) { uint4 v;
        v.x = pk2(x[8 * i + 0], x[8 * i + 1]); v.y = pk2(x[8 * i + 2], x[8 * i + 3]); v.z = pk2(x[8 * i + 4], x[8 * i + 5]); v.w = pk2(x[8 * i + 6], x[8 * i + 7]);
        ((uint4*)p)[i] = v; }
}
typedef unsigned v2u __attribute__((ext_vector_type(2)));
constexpr int NWAVES = 8;
constexpr int RING_OFF = 0, RING_BYTES = 131072, LDSCTL_OFF = RING_BYTES, MISC_OFF = LDSCTL_OFF + 320, LDS_BYTES = 147456;
constexpr int CW_TMO = 0, CW_CODE = 1, CW_BAR = 4096;
__device__ __forceinline__ const void* karg_ptr(int i) { const void* const volatile __attribute__((address_space(4)))* k = (const void* const volatile __attribute__((address_space(4)))*)__builtin_amdgcn_kernarg_segment_ptr(); return k[i]; }
#define KARG(i) karg_ptr(i)
struct Args { const void* in[18]; float* out; unsigned char* ws; int layer, ph_lo, ph_hi, pad; };
struct Frame {
    LAS unsigned char* lds; volatile LAS unsigned* MISC; gu32* ctl;
    int wave, vcu, G;
};
__device__ __forceinline__ void tr_item(const float* src, int ld, int k0, int nsrc0, bf16* dst, int Kdim, int ndst0, LAS float* scr, int lane) {
#pragma unroll 8
    for (int i = 0; i < 32; ++i) { const int kk = 2 * i + (lane >> 5); scr[kk * 33 + (lane & 31)] = src[(size_t)(k0 + kk) * ld + nsrc0 + (lane & 31)]; }
    LDS_WAIT(); asm volatile("" ::: "memory");
    const int c = lane & 7;
#pragma unroll
    for (int j = 0; j < 4; ++j) { const int n = (lane >> 3) + 8 * j; const LAS float* s = scr + (8 * c) * 33 + n;
        v4u o; o.x = pk2(s[0 * 33], s[1 * 33]); o.y = pk2(s[2 * 33], s[3 * 33]); o.z = pk2(s[4 * 33], s[5 * 33]); o.w = pk2(s[6 * 33], s[7 * 33]);
        *(GAS v4u*)(dst + (size_t)(ndst0 + n) * Kdim + k0 + 8 * c) = o; }
    LDS_WAIT(); asm volatile("" ::: "memory");
}
__device__ __forceinline__ int win_remap(int nd) { return nd < 3072 ? nd : (nd < 3584 ? nd + 1536 : (nd < 4096 ? nd + 512 : (nd < 5120 ? nd - 1024 : nd + 8))); }

template <bool ADD_MOE> __device__ __forceinline__ void p0_prologue(Frame& F, const Args& a, const int l, const float* xin) {
    const int LANE_ = lane_id(), TID_ = F.wave * 64 + LANE_; (void)TID_;
    LAS float* scr = (LAS float*)(F.lds + RING_OFF + F.wave * 16384);
    const int gw = F.vcu * NWAVES + F.wave, NGW = F.G * NWAVES;
    const float* w_in = (const float*)KARG(3) + (size_t)l * DM * PIN; const float* w_br = (const float*)KARG(8) + (size_t)l * 3 * 512 * 1024; const float* w_out = (const float*)KARG(9) + (size_t)l * DM * DM;
    bf16* WT_IN = (bf16*)(((unsigned char*)KARG(19)) + WS_WTIN); bf16* WT_BR = (bf16*)(((unsigned char*)KARG(19)) + WS_WTBR); bf16* WT_OUT = (bf16*)(((unsigned char*)KARG(19)) + WS_WTOUT);
    constexpr int I_IN = 16 * 256, I_BR = 3 * 256, I_OUT = 16 * 32, NITEMS = I_IN + I_BR + I_OUT;
    for (int it = gw; it < NITEMS; it += NGW) {
        int r = it;
        if (r < I_IN) { const int kb = r >> 8, nb = r & 255; tr_item(w_in, PIN, 64 * kb, win_remap(32 * nb), WT_IN, DM, 32 * nb, scr, LANE_); continue; } r -= I_IN;
        if (r < I_BR) { const int n = r >> 8, rr = r & 255, kb = rr >> 5, nb = rr & 31; tr_item(w_br + (size_t)n * 512 * 1024, 1024, 64 * kb, 32 * nb, WT_BR + (size_t)n * 1024 * 512, 512, 32 * nb, scr, LANE_); continue; } r -= I_BR;
        { const int kb = r >> 5, nb = r & 31; tr_item(w_out, 1024, 64 * kb, 32 * nb, WT_OUT, DM, 32 * nb, scr, LANE_); }
    }
    const float* g1 = (const float*)KARG(2) + l * DM; const float* gate_b = (const float*)KARG(7) + l * 8;
    bf16* XN = (bf16*)(((unsigned char*)KARG(19)) + WS_XN); float* IFPRE = (float*)(((unsigned char*)KARG(19)) + WS_IFPRE);
    for (int m = gw; m < M; m += NGW) {
        const GAS f32x4* xr = (const GAS f32x4*)(xin + (size_t)m * DM) + LANE_;
        f32x4 v[4]; float s = 0.f;
#pragma unroll
        for (int j = 0; j < 4; ++j) v[j] = xr[64 * j];
        if (ADD_MOE) {
            const GAS v2u* y0 = (const GAS v2u*)(((unsigned char*)KARG(19)) + WS_YP + (size_t)(2 * m) * 2048) + LANE_; const GAS v2u* y1 = (const GAS v2u*)(((unsigned char*)KARG(19)) + WS_YP + (size_t)(2 * m + 1) * 2048) + LANE_;
#pragma unroll
            for (int j = 0; j < 4; ++j) { const v2u p0 = y0[64 * j], p1 = y1[64 * j];
                v[j].x += __uint_as_float(p0.x << 16) + __uint_as_float(p1.x << 16); v[j].y += __uint_as_float(p0.x & 0xffff0000u) + __uint_as_float(p1.x & 0xffff0000u);
                v[j].z += __uint_as_float(p0.y << 16) + __uint_as_float(p1.y << 16); v[j].w += __uint_as_float(p0.y & 0xffff0000u) + __uint_as_float(p1.y & 0xffff0000u);
                ((GAS f32x4*)(((float*)KARG(18)) + (size_t)m * DM))[LANE_ + 64 * j] = v[j]; }
        }
#pragma unroll
        for (int j = 0; j < 4; ++j) s += (v[j].x * v[j].x + v[j].y * v[j].y) + (v[j].z * v[j].z + v[j].w * v[j].w);
#pragma unroll
        for (int o = 1; o < 64; o <<= 1) s += __shfl_xor(s, o);
        const float rs = rsqrtf(s * (1.f / DM) + RMS_EPS);
        float ip[8];
#pragma unroll
        for (int o = 0; o < 8; ++o) ip[o] = 0.f;
        GAS unsigned long long* o8 = (GAS unsigned long long*)(XN + (size_t)m * DM) + LANE_;
#pragma unroll
        for (int j = 0; j < 4; ++j) { const f32x4 gg = ((const GAS f32x4*)g1)[LANE_ + 64 * j]; v[j] = v[j] * rs * gg;
            o8[64 * j] = (unsigned long long)pk2(v[j].x, v[j].y) | ((unsigned long long)pk2(v[j].z, v[j].w) << 32);
#pragma unroll
            for (int u = 0; u < 4; ++u) { const int d = (LANE_ + 64 * j) * 4 + u; const float xv = v[j][u];
                const f32x4 wa = *(const GAS f32x4*)(w_in + (size_t)d * PIN + 5120), wb = *(const GAS f32x4*)(w_in + (size_t)d * PIN + 5124);
                ip[0] += xv * wa.x; ip[1] += xv * wa.y; ip[2] += xv * wa.z; ip[3] += xv * wa.w; ip[4] += xv * wb.x; ip[5] += xv * wb.y; ip[6] += xv * wb.z; ip[7] += xv * wb.w; } }
#pragma unroll
        for (int o = 0; o < 8; ++o) {
#pragma unroll
            for (int sft = 1; sft < 64; sft <<= 1) ip[o] += __shfl_xor(ip[o], sft); }
        float val = ip[0];
#pragma unroll
        for (int o = 1; o < 8; ++o) val = LANE_ == o ? ip[o] : val;
        if (LANE_ < 8) IFPRE[(size_t)m * 8 + LANE_] = val + gate_b[LANE_];
    }
}


__device__ __forceinline__ float dot64(const float (&q)[64], const bf16* p) {
    float z = 0.f;
#pragma unroll
    for (int i = 0; i < 8; ++i) { const uint4 v = ((const uint4*)p)[i];
        z += q[8 * i + 0] * __uint_as_float(v.x << 16) + q[8 * i + 1] * __uint_as_float(v.x & 0xffff0000u) + q[8 * i + 2] * __uint_as_float(v.y << 16) + q[8 * i + 3] * __uint_as_float(v.y & 0xffff0000u)
           + q[8 * i + 4] * __uint_as_float(v.z << 16) + q[8 * i + 5] * __uint_as_float(v.z & 0xffff0000u) + q[8 * i + 6] * __uint_as_float(v.w << 16) + q[8 * i + 7] * __uint_as_float(v.w & 0xffff0000u);
        asm volatile("" ::: "memory"); }
    return z;
}
__device__ __forceinline__ void axpy64(float (&acc)[64], float sc, float p, const bf16* vp) {
#pragma unroll
    for (int i = 0; i < 8; ++i) { const uint4 v = ((const uint4*)vp)[i];
        acc[8 * i + 0] = acc[8 * i + 0] * sc + p * __uint_as_float(v.x << 16); acc[8 * i + 1] = acc[8 * i + 1] * sc + p * __uint_as_float(v.x & 0xffff0000u);
        acc[8 * i + 2] = acc[8 * i + 2] * sc + p * __uint_as_float(v.y << 16); acc[8 * i + 3] = acc[8 * i + 3] * sc + p * __uint_as_float(v.y & 0xffff0000u);
        acc[8 * i + 4] = acc[8 * i + 4] * sc + p * __uint_as_float(v.z << 16); acc[8 * i + 5] = acc[8 * i + 5] * sc + p * __uint_as_float(v.z & 0xffff0000u);
        acc[8 * i + 6] = acc[8 * i + 6] * sc + p * __uint_as_float(v.w << 16); acc[8 * i + 7] = acc[8 * i + 7] * sc + p * __uint_as_float(v.w & 0xffff0000u);
        asm volatile("" ::: "memory"); }
}

__device__ __forceinline__ void ph_prep_qk(Frame& F, const Args& a, const int l) {
    const int LANE_ = lane_id(), TID_ = F.wave * 64 + LANE_; (void)TID_;
    bf16* mbq = (bf16*)(((unsigned char*)KARG(19)) + WS_MBQ); bf16* mbk = (bf16*)(((unsigned char*)KARG(19)) + WS_MBK);
    const float* qn_g = (const float*)KARG(4) + l * 64; const float* kn_g = (const float*)KARG(5) + l * 64; const int* positions = (const int*)KARG(1);
    for (int idx = blockIdx.x * 512 + TID_; idx < M * 16; idx += F.G * 512) {
        const int row = idx >> 4, hh = idx & 15, which = hh >> 3, h = hh & 7;
        bf16* p = (which ? mbk : mbq) + (size_t)row * 512 + h * 64; const float* g = which ? kn_g : qn_g;
        float x[64]; load64(p, x);
        float ss = 0.f;
#pragma unroll
        for (int i = 0; i < 64; ++i) ss += x[i] * x[i];
        const float r = rsqrtf(ss * (1.f / 64.f) + RMS_EPS);
#pragma unroll
        for (int i = 0; i < 64; ++i) x[i] = x[i] * r * g[i];
        const double pos = (double)positions[row];
        const double invf[8] = {1.0, 0.19392274474868576, 0.03760603093086393, 0.007292664737217109, 0.001414213562373095, 0.0002742481756762073, 5.318295896944988e-05, 1.031338537721246e-05};
#pragma unroll
        for (int i = 0; i < 8; ++i) {
            double rev = pos * invf[i] * 0.15915494309189535; rev -= floor(rev);
            const float fr = (float)rev; const float sn = __builtin_amdgcn_sinf(fr), cs = __builtin_amdgcn_cosf(fr);
            const float x1 = x[i], x2 = x[i + 8]; x[i] = x1 * cs - x2 * sn; x[i + 8] = x1 * sn + x2 * cs;
        }
        if (!which) {
#pragma unroll
            for (int i = 0; i < 64; ++i) x[i] *= C2;
        }
        store64(p, x);
    }
}
__device__ __forceinline__ void ph_conv(Frame& F, const Args& a, const int l) {
    const int LANE_ = lane_id(), TID_ = F.wave * 64 + LANE_; (void)TID_;
    const bf16* mlqk = (const bf16*)(((unsigned char*)KARG(19)) + WS_MLQK); const float* cw = (const float*)KARG(6) + l * 4 * 1024;
    bf16* q2 = (bf16*)(((unsigned char*)KARG(19)) + WS_MLQ2); bf16* k2 = (bf16*)(((unsigned char*)KARG(19)) + WS_MLK2);
    for (size_t idx = (size_t)blockIdx.x * 512 + TID_; idx < (size_t)M * 1024; idx += (size_t)F.G * 512) {
        const int c = (int)(idx & 1023), row = (int)(idx >> 10), t = row & (SEQ - 1);
        float y = 0.f;
#pragma unroll
        for (int j = 0; j < 4; ++j) { const int tt = t - 3 + j; if (tt >= 0) y += cw[j * 1024 + c] * bf2f(mlqk[(size_t)(row - 3 + j) * 1024 + c]); }
        y = y * sigmoidf_(y);
        if (c < 512) q2[(size_t)row * 512 + c] = (bf16)f2bf(y); else k2[(size_t)row * 512 + c - 512] = (bf16)f2bf(y * 0.08838834764831845f);
    }
}
__device__ __forceinline__ void ph_kmean(Frame& F, const Args& a) {
    const int LANE_ = lane_id(), TID_ = F.wave * 64 + LANE_; (void)TID_;
    const bf16* mbk = (const bf16*)(((unsigned char*)KARG(19)) + WS_MBK); float* kmean = (float*)(((unsigned char*)KARG(19)) + WS_KMEAN);
    for (int idx = blockIdx.x * 512 + TID_; idx < 8 * 8 * 8 * 64; idx += F.G * 512) {
        const int d = idx & 63, blk = (idx >> 6) & 7, h = (idx >> 9) & 7, b = idx >> 12;
        float s = 0.f;
        for (int i = 0; i < 256; ++i) s += bf2f(mbk[(size_t)(b * SEQ + blk * 256 + i) * 512 + h * 64 + d]);
        kmean[idx] = s * (1.f / 256.f);
    }
}
__device__ __forceinline__ void ph_sb_naive(Frame& F, const Args& a) {
    const int LANE_ = lane_id(), TID_ = F.wave * 64 + LANE_; (void)TID_;
    bf16* sbq = (bf16*)(((unsigned char*)KARG(19)) + WS_SBQ); const bf16* sbk = (const bf16*)(((unsigned char*)KARG(19)) + WS_SBK); const bf16* sbv = (const bf16*)(((unsigned char*)KARG(19)) + WS_SBV);
    for (int idx = blockIdx.x * 512 + TID_; idx < M * 8; idx += F.G * 512) {
        const int row = idx >> 3, h = idx & 7, t = row & (SEQ - 1), base = row - t;
        float q[64], acc[64]; load64(sbq + (size_t)row * 512 + h * 64, q);
#pragma unroll
        for (int i = 0; i < 64; ++i) acc[i] = 0.f;
        float C = 0.f;
        for (int s = t - 1; s >= 0; --s) {
            const float z = dot64(q, sbk + (size_t)(base + s) * 512 + h * 64);
            const float sp = z > 0.f ? z + __log2f(1.f + exp2f(-z)) : __log2f(1.f + exp2f(z));
            C += sp; const float w = exp2f(z - C);
            axpy64(acc, 1.f, w, sbv + (size_t)(base + s) * 512 + h * 64);
            if (C > 150.f) break;
        }
        store64(sbq + (size_t)row * 512 + h * 64, acc);
    }
}
__device__ __forceinline__ void ph_moba_naive(Frame& F, const Args& a) {
    const int LANE_ = lane_id(), TID_ = F.wave * 64 + LANE_; (void)TID_;
    bf16* mbq = (bf16*)(((unsigned char*)KARG(19)) + WS_MBQ); const bf16* mbk = (const bf16*)(((unsigned char*)KARG(19)) + WS_MBK); const bf16* mbv = (const bf16*)(((unsigned char*)KARG(19)) + WS_MBV); const float* kmean = (const float*)(((unsigned char*)KARG(19)) + WS_KMEAN);
    for (int idx = blockIdx.x * 512 + TID_; idx < M * 8; idx += F.G * 512) {
        const int row = idx >> 3, h = idx & 7, t = row & (SEQ - 1), base = row - t, b = row >> 11, own = t >> 8;
        float q[64], acc[64]; load64(mbq + (size_t)row * 512 + h * 64, q);
#pragma unroll
        for (int i = 0; i < 64; ++i) acc[i] = 0.f;
        unsigned sel = 0u;
        {
            float g[8];
#pragma unroll
            for (int blk = 0; blk < 8; ++blk) { float s = 0.f; const float* km = kmean + ((size_t)(b * 8 + h) * 8 + blk) * 64;
#pragma unroll
                for (int i = 0; i < 64; ++i) s += q[i] * km[i];
                g[blk] = blk < own ? s : -INFINITY; }
#pragma unroll
            for (int r = 0; r < 3; ++r) { float best = -INFINITY; int bi = -1;
#pragma unroll
                for (int blk = 0; blk < 8; ++blk) { const bool ok = !((sel >> blk) & 1u) && g[blk] > best; if (ok) { best = g[blk]; bi = blk; } }
                if (bi >= 0) sel |= 1u << bi; }
        }
        sel |= 1u << own;
        float m = -INFINITY, lsum = 0.f;
        for (int blk = 0; blk <= own; ++blk) {
            if (!((sel >> blk) & 1u)) continue;
            const int s1 = blk == own ? t : blk * 256 + 255;
            for (int s = blk * 256; s <= s1; ++s) {
                const float z = dot64(q, mbk + (size_t)(base + s) * 512 + h * 64);
                const float mn = fmaxf(m, z), sc = exp2f(m - mn), p = exp2f(z - mn);
                lsum = lsum * sc + p;
                axpy64(acc, sc, p, mbv + (size_t)(base + s) * 512 + h * 64);
                m = mn;
            }
        }
        const float il = 1.f / lsum;
#pragma unroll
        for (int i = 0; i < 64; ++i) acc[i] *= il;
        store64(mbq + (size_t)row * 512 + h * 64, acc);
    }
}
__device__ __forceinline__ void ph_mlstm_naive(Frame& F, const Args& a) {
    const int LANE_ = lane_id(), TID_ = F.wave * 64 + LANE_; (void)TID_;
    const bf16* q2 = (const bf16*)(((unsigned char*)KARG(19)) + WS_MLQ2); const bf16* k2 = (const bf16*)(((unsigned char*)KARG(19)) + WS_MLK2); const bf16* mlv = (const bf16*)(((unsigned char*)KARG(19)) + WS_MLV); bf16* mlo = (bf16*)(((unsigned char*)KARG(19)) + WS_MLO);
    const float* ifpre = (const float*)(((unsigned char*)KARG(19)) + WS_IFPRE);
    for (int unit = blockIdx.x; unit < 32; unit += F.G) {
        const int b = unit >> 2, h = unit & 3, tid = TID_, e = tid >> 2, dq = tid & 3;
        float Cst[32], nst[32];
#pragma unroll
        for (int j = 0; j < 32; ++j) { Cst[j] = 0.f; nst[j] = 0.f; }
        float m = 0.f;
        for (int t = 0; t < SEQ; ++t) {
            const size_t row = (size_t)b * SEQ + t;
            const float li = ifpre[row * 8 + h], fp = ifpre[row * 8 + 4 + h];
            const float lf = fp >= 0.f ? -log1pf(__expf(-fp)) : fp - log1pf(__expf(fp));
            const float mn = fmaxf(lf + m, li), fd = __expf(lf + m - mn), ii = __expf(li - mn); m = mn;
            const bf16* kp = k2 + row * 512 + h * 128 + dq * 32; const bf16* qp = q2 + row * 512 + h * 128 + dq * 32;
            const float ve = bf2f(mlv[row * 512 + h * 128 + e]) * ii;
            float num = 0.f, den = 0.f;
#pragma unroll
            for (int c4 = 0; c4 < 4; ++c4) {
                const uint4 kv = ((const uint4*)kp)[c4], qv = ((const uint4*)qp)[c4];
                const unsigned ku[4] = {kv.x, kv.y, kv.z, kv.w}, qu[4] = {qv.x, qv.y, qv.z, qv.w};
#pragma unroll
                for (int u = 0; u < 4; ++u) {
                    const float k0 = __uint_as_float(ku[u] << 16), k1 = __uint_as_float(ku[u] & 0xffff0000u), q0 = __uint_as_float(qu[u] << 16), q1 = __uint_as_float(qu[u] & 0xffff0000u);
                    const int j = c4 * 8 + u * 2;
                    Cst[j] = fd * Cst[j] + ve * k0; Cst[j + 1] = fd * Cst[j + 1] + ve * k1;
                    nst[j] = fd * nst[j] + ii * k0; nst[j + 1] = fd * nst[j + 1] + ii * k1;
                    num += Cst[j] * q0 + Cst[j + 1] * q1; den += nst[j] * q0 + nst[j + 1] * q1;
                }
            }
            num += __shfl_xor(num, 1); num += __shfl_xor(num, 2); den += __shfl_xor(den, 1); den += __shfl_xor(den, 2);
            const float o = num / fmaxf(fabsf(den), __expf(-m));
            if (dq == 0) { bf16* op = mlo + row * 512 + h * 128 + e; *op = (bf16)f2bf(o * sigmoidf_(bf2f(*op))); }
        }
    }
}
__device__ __forceinline__ void ph_router(Frame& F, const Args& a, const int l) {
    const int LANE_ = lane_id(), TID_ = F.wave * 64 + LANE_; (void)TID_;
    const float* hin = ((float*)KARG(18)); const float* g2 = (const float*)KARG(10) + l * DM; const float* w_rg = (const float*)KARG(11) + (size_t)l * DM * 4; const float* b_rg = (const float*)KARG(12) + l * 4;
    const float* w_re = (const float*)KARG(13) + (size_t)l * DM * 32; const float* b_re = (const float*)KARG(14) + l * 32;
    bf16* xn2 = (bf16*)(((unsigned char*)KARG(19)) + WS_XN2); int* re = (int*)(((unsigned char*)KARG(19)) + WS_RE); float* rw = (float*)(((unsigned char*)KARG(19)) + WS_RW); int* rank = (int*)(((unsigned char*)KARG(19)) + WS_RANK); unsigned* cnt = (unsigned*)(F.ctl + CW_CNT + 64 * l);
    const int lane = LANE_, r8 = lane >> 3, part = lane & 7, gw = F.vcu * NWAVES + F.wave, NGW = F.G * NWAVES;
    for (int grp = gw; grp < M / 8; grp += NGW) {
        const int row = grp * 8 + r8;
        const float* xp = hin + (size_t)row * DM + 4 * part; const float* gp = g2 + 4 * part; const float* wgp = w_rg + (size_t)(4 * part) * 4; const float* wep = w_re + (size_t)(4 * part) * 32;
        float lg[36]; float ss = 0.f;
#pragma unroll
        for (int o = 0; o < 36; ++o) lg[o] = 0.f;
#pragma unroll 1
        for (int c = 0; c < 32; ++c) {
            const f32x4 x4 = *(const GAS f32x4*)(xp + 32 * c), g4 = *(const GAS f32x4*)(gp + 32 * c);
            ss += (x4.x * x4.x + x4.y * x4.y) + (x4.z * x4.z + x4.w * x4.w);
            const f32x4 xg = x4 * g4;
#pragma unroll
            for (int u = 0; u < 4; ++u) { const float xv = xg[u];
                const f32x4 wg = *(const GAS f32x4*)(wgp + (size_t)(32 * c + u) * 4); lg[0] += xv * wg.x; lg[1] += xv * wg.y; lg[2] += xv * wg.z; lg[3] += xv * wg.w;
#pragma unroll
                for (int o4 = 0; o4 < 8; ++o4) { const f32x4 we = *(const GAS f32x4*)(wep + (size_t)(32 * c + u) * 32 + o4 * 4);
                    lg[4 + o4 * 4] += xv * we.x; lg[5 + o4 * 4] += xv * we.y; lg[6 + o4 * 4] += xv * we.z; lg[7 + o4 * 4] += xv * we.w; } }
        }
        ss += __shfl_xor(ss, 1); ss += __shfl_xor(ss, 2); ss += __shfl_xor(ss, 4);
        const float r = rsqrtf(ss * (1.f / DM) + RMS_EPS);
#pragma unroll
        for (int o = 0; o < 36; ++o) { float v = lg[o]; v += __shfl_xor(v, 1); v += __shfl_xor(v, 2); v += __shfl_xor(v, 4); lg[o] = v * r; }
        bf16* op = xn2 + (size_t)row * DM + 4 * part;
#pragma unroll 1
        for (int c = 0; c < 32; ++c) {
            const f32x4 x4 = *(const GAS f32x4*)(xp + 32 * c), g4 = *(const GAS f32x4*)(gp + 32 * c); const f32x4 y = x4 * g4 * r;
            *(GAS unsigned long long*)(op + 32 * c) = (unsigned long long)pk2(y.x, y.y) | ((unsigned long long)pk2(y.z, y.w) << 32);
        }
        float gm = -INFINITY; int gi = 0; float gl[4];
#pragma unroll
        for (int i = 0; i < 4; ++i) { gl[i] = lg[i] + b_rg[i]; if (gl[i] > gm) { gm = gl[i]; gi = i; } }
        float gs = 0.f;
#pragma unroll
        for (int i = 0; i < 4; ++i) gs += __expf(gl[i] - gm);
        const float gwt = 1.f / gs;
        float el[8];
#pragma unroll
        for (int j = 0; j < 8; ++j) { const float a0 = lg[4 + j] + b_re[j], a1 = lg[12 + j] + b_re[8 + j], a2 = lg[20 + j] + b_re[16 + j], a3 = lg[28 + j] + b_re[24 + j];
            el[j] = gi == 0 ? a0 : (gi == 1 ? a1 : (gi == 2 ? a2 : a3)); }
        float m1 = -INFINITY; int i1 = 0;
#pragma unroll
        for (int j = 0; j < 8; ++j) if (el[j] > m1) { m1 = el[j]; i1 = j; }
        float m2 = -INFINITY; int i2 = 0;
#pragma unroll
        for (int j = 0; j < 8; ++j) if (j != i1 && el[j] > m2) { m2 = el[j]; i2 = j; }
        const float p2 = __expf(m2 - m1);
        const float w1 = gwt / (1.f + p2), w2 = gwt * p2 / (1.f + p2);
        if (part == 0) { const int ea = gi * 8 + i1, eb = gi * 8 + i2; re[row * 2] = ea; re[row * 2 + 1] = eb; rw[row * 2] = w1; rw[row * 2 + 1] = w2;
            rank[row * 2] = (int)__hip_atomic_fetch_add(cnt + ea, 1u, __ATOMIC_RELAXED, __HIP_MEMORY_SCOPE_AGENT); rank[row * 2 + 1] = (int)__hip_atomic_fetch_add(cnt + eb, 1u, __ATOMIC_RELAXED, __HIP_MEMORY_SCOPE_AGENT); }
    }
}
__device__ __forceinline__ void ph_moe_weights(Frame& F, const Args& a, const int l) {
    const int LANE_ = lane_id(), TID_ = F.wave * 64 + LANE_; (void)TID_;
    LAS float* scr = (LAS float*)(F.lds + RING_OFF + F.wave * 16384);
    const int gw = F.vcu * NWAVES + F.wave, NGW = F.G * NWAVES;
    const float* w1 = (const float*)KARG(15) + (size_t)l * 32 * 1024 * 256; const float* w3 = (const float*)KARG(16) + (size_t)l * 32 * 1024 * 256; const float* w2 = (const float*)KARG(17) + (size_t)l * 32 * 256 * 1024;
    bf16* WT13 = (bf16*)(((unsigned char*)KARG(19)) + WS_WT13); bf16* WT2 = (bf16*)(((unsigned char*)KARG(19)) + WS_WT2);
    constexpr int I_13 = 32 * 2 * 128, I_2 = 32 * 128;
    for (int it = gw; it < I_13 + I_2; it += NGW) {
        if (it < I_13) { const int e = it >> 8, which = (it >> 7) & 1, rr = it & 127, kb = rr >> 3, nb = rr & 7, f0 = 32 * nb;
            tr_item((which ? w3 : w1) + (size_t)e * 1024 * 256, 256, 64 * kb, f0, WT13 + (size_t)e * 512 * 1024, 1024, (f0 >> 7) * 256 + which * 128 + (f0 & 127), scr, LANE_); }
        else { const int r = it - I_13, e = r >> 7, rr = r & 127, kb = rr >> 5, nb = rr & 31;
            tr_item(w2 + (size_t)e * 256 * 1024, 1024, 64 * kb, 32 * nb, WT2 + (size_t)e * 1024 * 256, 256, 32 * nb, scr, LANE_); }
    }
}
constexpr int MOE_TAB_OFF = LDSCTL_OFF + 1024;
__device__ __forceinline__ void moe_tables(Frame& F, const int l) {
    const int LANE_ = lane_id(), TID_ = F.wave * 64 + LANE_; (void)TID_;
    LAS int* tab = (LAS int*)(F.lds + MOE_TAB_OFF);
    if (F.wave == 0) {
        const int e = LANE_ & 31; const int c = (int)__hip_atomic_load(F.ctl + CW_CNT + 64 * l + e, RLX_AGENT); const int np = (c + 255) >> 8;
        int inc = np;
#pragma unroll
        for (int o = 1; o < 32; o <<= 1) { const int t = __shfl_up(inc, o); if ((LANE_ & 31) >= o) inc += t; }
        const int seg = inc - np;
        if (LANE_ < 32) { tab[32 + e] = seg; for (int j = 0; j < np; ++j) { tab[64 + seg + j] = e; const int rem = c - 256 * j; tab[256 + seg + j] = rem < 256 ? rem : 256; } }
        if (LANE_ == 31) tab[0] = inc;
    }
    LDS_WAIT(); __syncthreads();
}
__device__ __forceinline__ void ph_moe_gather(Frame& F, const Args& a, const int l) {
    const int LANE_ = lane_id(), TID_ = F.wave * 64 + LANE_; (void)TID_;
    moe_tables(F, l);
    const LAS int* tab = (const LAS int*)(F.lds + MOE_TAB_OFF);
    const int* re = (const int*)(((unsigned char*)KARG(19)) + WS_RE); const float* rw = (const float*)(((unsigned char*)KARG(19)) + WS_RW); const int* rank = (const int*)(((unsigned char*)KARG(19)) + WS_RANK);
    int* spair = (int*)(((unsigned char*)KARG(19)) + WS_SPAIR); float* sw = (float*)(((unsigned char*)KARG(19)) + WS_SW);
    const int gw = F.vcu * NWAVES + F.wave, NGW = F.G * NWAVES;
    for (int p = gw; p < 2 * M; p += NGW) {
        const int e = re[p]; const int slot = tab[32 + e] * 256 + rank[p];
        const GAS v4u* src = (const GAS v4u*)(((unsigned char*)KARG(19)) + WS_XN2 + (size_t)(p >> 1) * 2048); GAS v4u* dst = (GAS v4u*)(((unsigned char*)KARG(19)) + WS_XS + (size_t)slot * 2048);
        const v4u v0 = src[LANE_], v1 = src[LANE_ + 64]; dst[LANE_] = v0; dst[LANE_ + 64] = v1;
        if (LANE_ == 0) { spair[slot] = p; sw[slot] = rw[p]; }
    }
}
__device__ __forceinline__ void ph_final(Frame& F, const Args& a) {
    const int LANE_ = lane_id(), TID_ = F.wave * 64 + LANE_; (void)TID_;
    const int gw = F.vcu * NWAVES + F.wave, NGW = F.G * NWAVES;
    for (int m = gw; m < M; m += NGW) {
        GAS f32x4* xr = (GAS f32x4*)(((float*)KARG(18)) + (size_t)m * DM) + LANE_;
        const GAS v2u* y0 = (const GAS v2u*)(((unsigned char*)KARG(19)) + WS_YP + (size_t)(2 * m) * 2048) + LANE_; const GAS v2u* y1 = (const GAS v2u*)(((unsigned char*)KARG(19)) + WS_YP + (size_t)(2 * m + 1) * 2048) + LANE_;
#pragma unroll
        for (int j = 0; j < 4; ++j) { f32x4 v = xr[64 * j]; const v2u p0 = y0[64 * j], p1 = y1[64 * j];
            v.x += __uint_as_float(p0.x << 16) + __uint_as_float(p1.x << 16); v.y += __uint_as_float(p0.x & 0xffff0000u) + __uint_as_float(p1.x & 0xffff0000u);
            v.z += __uint_as_float(p0.y << 16) + __uint_as_float(p1.y << 16); v.w += __uint_as_float(p0.y & 0xffff0000u) + __uint_as_float(p1.y & 0xffff0000u);
            xr[64 * j] = v; }
    }
}
constexpr int NPH = 11;
template <int l> __device__ __forceinline__ void layer_body(Frame& F, const Args& args, const XcdBarrier& bar, const int plo, const int phi) {
    const int LANE_ = lane_id(), TID_ = F.wave * 64 + LANE_; (void)TID_;
    unsigned char* ws = ((unsigned char*)KARG(19));
        const int lo = plo - l * NPH, hi = phi - l * NPH;
#define IN(k) (lo <= (k) && (k) < hi)
#define SEAM(k) do { if ((k) + 1 + l * NPH < phi) xcd_barrier(bar); } while (0)
        const float* xin = l == 0 ? (const float*)KARG(0) : (const float*)((float*)KARG(18));
        if (IN(0)) { p0_prologue<(l > 0)>(F, args, l, xin); SEAM(0); }
        if (IN(1)) {
            pg8::Gemm g{(const pg8::bf16_t*)(ws + WS_XN), (const pg8::bf16_t*)(ws + WS_WTIN), M, 8192, DM}; pg8::StaticOrder S; S.init(M, 8192, F.G, (int)blockIdx.x);
            pg8::EpiInProj E{ws};
            pg8::gemm_phase<pg8::EpiInProj, pg8::StaticOrder, PG8_ALIGN, PG8_SP2>(F.lds + RING_OFF, g, S, E, F.wave);
            SEAM(1);
        }
        if (IN(2)) { ph_prep_qk(F, args, l); ph_conv(F, args, l); SEAM(2); }
        if (IN(3)) { ph_kmean(F, args); ph_sb_naive(F, args); SEAM(3); }
        if (IN(4)) {
            ph_mlstm_naive(F, args);
            const attn_body::AttnTensors AT{(const attn_body::bf16*)(ws + WS_MBQ), (const attn_body::bf16*)(ws + WS_MBK), (const attn_body::bf16*)(ws + WS_MBV), (attn_body::bf16*)(ws + WS_MBQ)};
            const attn_body::StaticOrder S((int)F.G, (int)blockIdx.x);
            attn_body::attn_phase<attn_body::StaticOrder>((char*)F.lds + RING_OFF, AT, S, (const float*)(ws + WS_KMEAN), F.wave);
            SEAM(4);
        }
        if (IN(5)) {
            pg8::Gemm g{(const pg8::bf16_t*)(ws + WS_SBQ), (const pg8::bf16_t*)(ws + WS_WTBR), M, 1024, 512}; pg8::YOrder S{F.vcu, F.G};
            pg8::EpiYMerge E{(const pg8::bf16_t*)(ws + WS_GATES), (pg8::bf16_t*)(ws + WS_MERGED)};
            pg8::gemm_phase<pg8::EpiYMerge, pg8::YOrder, PG8_ALIGN, PG8_SP2>(F.lds + RING_OFF, g, S, E, F.wave);
            SEAM(5);
        }
        if (IN(6)) {
            pg8::Gemm g{(const pg8::bf16_t*)(ws + WS_MERGED), (const pg8::bf16_t*)(ws + WS_WTOUT), M, DM, DM}; pg8::StaticOrder S; S.init(M, DM, F.G, (int)blockIdx.x);
            pg8::EpiResid32 E{xin, ((float*)KARG(18))};
            pg8::gemm_phase<pg8::EpiResid32, pg8::StaticOrder, PG8_ALIGN, PG8_SP2>(F.lds + RING_OFF, g, S, E, F.wave);
            SEAM(6);
        }
        if (IN(7)) { ph_moe_weights(F, args, l); ph_router(F, args, l); SEAM(7); }
        if (IN(8)) { ph_moe_gather(F, args, l); SEAM(8); }
        if (IN(9)) {
            moe_tables(F, l); const LAS int* tab = (const LAS int*)(F.lds + MOE_TAB_OFF);
            pg8::Gemm g{(const pg8::bf16_t*)(ws + WS_XS), (const pg8::bf16_t*)(ws + WS_WT13), M, 512, DM}; pg8::MoeOrder S{F.vcu, F.G, tab[0], 2, tab + 64};
            pg8::EpiSwiGLU E{(pg8::bf16_t*)(ws + WS_HS)};
            pg8::gemm_phase<pg8::EpiSwiGLU, pg8::MoeOrder, PG8_ALIGN, PG8_SP2>(F.lds + RING_OFF, g, S, E, F.wave);
            SEAM(9);
        }
        if (IN(10)) {
            moe_tables(F, l); const LAS int* tab = (const LAS int*)(F.lds + MOE_TAB_OFF);
            pg8::Gemm g{(const pg8::bf16_t*)(ws + WS_HS), (const pg8::bf16_t*)(ws + WS_WT2), M, DM, 256}; pg8::MoeOrder S{F.vcu, F.G, tab[0], 4, tab + 64};
            pg8::EpiMoeOut E{(pg8::bf16_t*)(ws + WS_YP), (const int*)(ws + WS_SPAIR), (const float*)(ws + WS_SW), tab + 256};
            pg8::gemm_phase<pg8::EpiMoeOut, pg8::MoeOrder, PG8_ALIGN, PG8_SP2>(F.lds + RING_OFF, g, S, E, F.wave);
            SEAM(10);
        }
#undef IN
#undef SEAM
}
__global__ void __launch_bounds__(NWAVES * 64, 2) mk(Args args) {
    extern __shared__ __attribute__((aligned(16))) unsigned char lds[];
    Frame F;
    F.lds = (LAS unsigned char*)lds; F.MISC = (volatile LAS unsigned*)(F.lds + MISC_OFF);
    F.wave = __builtin_amdgcn_readfirstlane((int)threadIdx.x >> 6);
    const int LANE_ = lane_id(), TID_ = F.wave * 64 + LANE_;
    F.G = gridDim.x; { const int bx = blockIdx.x; F.vcu = (F.G % 8 == 0) ? (bx % 8) * (F.G / 8) + bx / 8 : bx; }
    unsigned char* ws = ((unsigned char*)KARG(19)); F.ctl = (gu32*)(ws + WS_CTL);
    for (int u = TID_; u < (LDS_BYTES - LDSCTL_OFF) / 4; u += NWAVES * 64) ((LAS unsigned*)(F.lds + LDSCTL_OFF))[u] = 0u;
    __syncthreads();
    const int plo = args.ph_lo, phi = args.ph_hi;
    XcdBarrier bar; bar.bar = (unsigned*)(F.ctl + CW_BAR); bar.x = 0; bar.st = nullptr; bar.w = (unsigned)F.wave;
    if (phi - plo > 1) bar = xcd_barrier_post((unsigned*)(F.ctl + CW_BAR), F.MISC + 8, (unsigned)F.wave);
    layer_body<0>(F, args, bar, plo, phi);
    layer_body<1>(F, args, bar, plo, phi);
    if (plo <= DEPTH * NPH && DEPTH * NPH < phi) ph_final(F, args);
}

#ifndef MK_ONE_LAUNCH
#define MK_ONE_LAUNCH 1
#endif
extern "C" void kernel_launch(void* const* d_in, const int* in_sizes, int n_in, void* d_out, int out_size, void* d_ws, size_t ws_size, hipStream_t stream) {
    static int grid = 0;
    if (grid == 0) {
        if (n_in != 18 || out_size != M * DM || ws_size < WS_END) { fprintf(stderr, "kernel_launch: unexpected shapes (n_in %d out %d ws %zu)\n", n_in, out_size, ws_size); grid = -1; return; }
        int dev = 0, cus = 0;
        if (hipGetDevice(&dev) != hipSuccess || hipDeviceGetAttribute(&cus, hipDeviceAttributeMultiprocessorCount, dev) != hipSuccess) { grid = -1; return; }
        if (hipFuncSetAttribute((const void*)mk, hipFuncAttributeMaxDynamicSharedMemorySize, LDS_BYTES) != hipSuccess) { grid = -1; return; }
        int per_cu = 0;
        if (hipOccupancyMaxActiveBlocksPerMultiprocessor(&per_cu, (const void*)mk, NWAVES * 64, LDS_BYTES) != hipSuccess || per_cu < 1) fprintf(stderr, "kernel_launch: occupancy query says %d blocks per CU\n", per_cu);
        (void)hipGetLastError();
        grid = cus;
    }
    if (grid < 0) return;
    (void)hipMemsetAsync((char*)d_ws + WS_CTL, 0, CTL_ZERO_BYTES, stream);
    Args a{};
    for (int i = 0; i < 18; ++i) a.in[i] = d_in[i];
    a.out = (float*)d_out; a.ws = (unsigned char*)d_ws; a.layer = 0;
#if MK_ONE_LAUNCH
    a.ph_lo = 0; a.ph_hi = DEPTH * NPH + 1; hipLaunchKernelGGL(mk, dim3(grid), dim3(NWAVES * 64), LDS_BYTES, stream, a);
#else
    for (int p = 0; p < DEPTH * NPH + 1; ++p) { a.ph_lo = p; a.ph_hi = p + 1; hipLaunchKernelGGL(mk, dim3(grid), dim3(NWAVES * 64), LDS_BYTES, stream, a); }
#endif
}
```

```cpp
#include <hip/hip_runtime.h>
#include <stdint.h>
#include <cstdio>
#include <cmath>

constexpr int BATCH = 8, SEQ = 2048, DM = 1024, M = BATCH * SEQ, W = 512, PIN = 8200, DEPTH = 2;
constexpr float RMS_EPS = 1e-6f;
constexpr float C2 = 0.18033688011112042f;
constexpr size_t MiB = 1u << 20;
constexpr size_t WS_CTL = 0, CTL_ZERO_BYTES = 1 * MiB;
constexpr size_t WS_IFPRE = 1 * MiB, WS_KMEAN = WS_IFPRE + 512 * 1024, WS_RE = WS_KMEAN + 128 * 1024, WS_RW = WS_RE + 128 * 1024;
constexpr size_t WS_XN = 4 * MiB, WS_WTIN = 36 * MiB;
constexpr size_t WS_SBQ = 52 * MiB, WS_SBK = 68 * MiB, WS_SBV = 84 * MiB, WS_MBQ = 100 * MiB, WS_MBK = 116 * MiB, WS_MBV = 132 * MiB;
constexpr size_t WS_MLO = 148 * MiB, WS_MLV = 164 * MiB, WS_MLQK = 180 * MiB, WS_GATES = 212 * MiB;
constexpr size_t WS_WTBR = 308 * MiB, WS_WTOUT = 311 * MiB, WS_END = 313 * MiB;
constexpr size_t WS_MLQ2 = WS_XN, WS_MLK2 = WS_XN + 16 * MiB, WS_MERGED = WS_MLQK, WS_XN2 = WS_XN;
constexpr size_t WS_WT13 = 52 * MiB, WS_WT2 = 84 * MiB, WS_XS = 100 * MiB, WS_HS = 181 * MiB, WS_YP = 202 * MiB;
constexpr size_t WS_SPAIR = 2 * MiB, WS_SW = 2 * MiB + 256 * 1024, WS_RANK = 2 * MiB + 512 * 1024;
constexpr size_t WS_MLDN = 2 * MiB, WS_MLDEC = 2 * MiB + 640 * 1024, WS_MLWK = 2 * MiB + 768 * 1024, WS_MLSCAL = 3 * MiB, WS_MLCST = WS_MLQK;
constexpr int CW_CNT = 8192;
__device__ __forceinline__ int lane_id() { int x; asm volatile("v_mbcnt_lo_u32_b32 %0, -1, 0\n\tv_mbcnt_hi_u32_b32 %0, -1, %0" : "=v"(x)); return x; }
namespace pg8 {
#define PG8_LAS __attribute__((address_space(3)))
typedef unsigned short bf16_t;
typedef short bf16x8 __attribute__((ext_vector_type(8)));
typedef float f32x4 __attribute__((ext_vector_type(4)));
typedef unsigned u32x4 __attribute__((ext_vector_type(4)));
constexpr int BM = 256, BK = 64, HALF = 128, HTB = HALF * BK * 2  , STAGE_BYTES = 8 * HTB, NXCD = 8, WGM = 8;

__host__ __device__ __forceinline__ int lds_byte(int r, int c) { const int st = (r >> 4) * 2 + (c >> 5), rr = r & 15, cc = c & 31, ob = rr * 64 + cc * 2; return st * 1024 + (ob ^ (((ob >> 9) & 1) << 5)); }
__host__ __device__ __forceinline__ void stage_rc(int b, int& R, int& C) { const int st = b / 1024, sb = b % 1024, swz = sb ^ (((sb >> 9) & 1) << 5); R = (st >> 1) * 16 + swz / 64; C = (st & 1) * 32 + (swz % 64) / 2; }
__host__ __device__ __forceinline__ int perm32(int rho) { const int n = rho >> 4, i = rho & 15; return 8 * (i >> 2) + 4 * n + (i & 3); }

struct Unit { int pm, pn; };
struct Gemm { const bf16_t* A; const bf16_t* Bt; int M, N, K; };

struct StaticOrder {
    int nM, nN, nwg, G, c;
    __host__ __device__ void init(int M, int N, int G_, int c_) { nM = M / BM; nN = N / BM; nwg = nM * nN; G = G_; c = c_; }
    __host__ __device__ bool next(int i, Unit& u) const {
        const long L = (long)i * G + c; if (L >= nwg) return false;
        int wgid = (int)L; { const int q = nwg / NXCD, r = nwg % NXCD, xcd = wgid % NXCD, off = wgid / NXCD; wgid = (xcd < r ? xcd * (q + 1) : r * (q + 1) + (xcd - r) * q) + off; }
        const int nig = WGM * nN, gid = wgid / nig, fm = gid * WGM, gsz = (nM - fm) < WGM ? (nM - fm) : WGM;
        u.pm = fm + ((wgid % nig) % gsz); u.pn = (wgid % nig) / gsz; return true;
    }
    __device__ __forceinline__ void a_ready(const Unit&) const {}
    __device__ __forceinline__ void done(const Unit&) const {}
};

__device__ __forceinline__ unsigned cvt_pk_bf16(float lo, float hi) { unsigned r; asm volatile("v_cvt_pk_bf16_f32 %0, %1, %2" : "=v"(r) : "v"(lo), "v"(hi)); return r; }
typedef float f32x2 __attribute__((ext_vector_type(2)));
__device__ __forceinline__ float fast_sigmoid(float x) { return __builtin_amdgcn_rcpf(1.0f + __expf(-x)); }
struct EpiInProj {
    static constexpr bool PERM = true, AFTER_DRAIN = false;
    unsigned char* ws;
    __device__ __forceinline__ void operator()(const f32x4 (&acc)[2][2][4][2], const Unit& u, int wr, int wc, int fr, int fq) const {
        const int pn = u.pn; bf16_t* base; int ldc, colt; float sc = 1.f; bool sig = false;
        if (pn < 12) { base = (bf16_t*)(ws + WS_SBQ) + (size_t)(pn >> 1) * (8u << 20); ldc = 512; colt = (pn & 1) * 256; if (pn < 2) sc = C2; }
        else if (pn < 14) { base = (bf16_t*)(ws + WS_MLO); ldc = 512; colt = (pn & 1) * 256; }
        else if (pn < 16) { base = (bf16_t*)(ws + WS_MLV); ldc = 512; colt = (pn & 1) * 256; }
        else if (pn < 20) { base = (bf16_t*)(ws + WS_MLQK); ldc = 1024; colt = (pn - 16) * 256; }
        else { base = (bf16_t*)(ws + WS_GATES); ldc = 3072; colt = (pn - 20) * 256; sig = true; }
        const int row0 = u.pm * BM + wr * 64 + fr, col0 = colt + wc * 32 + 8 * fq;
#pragma unroll
        for (int ai = 0; ai < 2; ++ai)
#pragma unroll
            for (int m = 0; m < 4; ++m) { bf16_t* rowp = base + (size_t)(row0 + ai * HALF + m * 16) * ldc + col0;
#pragma unroll
                for (int bj = 0; bj < 2; ++bj) { f32x4 v0 = acc[ai][bj][m][0], v1 = acc[ai][bj][m][1];
                    if (sig) { v0 = (f32x4){fast_sigmoid(v0[0]), fast_sigmoid(v0[1]), fast_sigmoid(v0[2]), fast_sigmoid(v0[3])}; v1 = (f32x4){fast_sigmoid(v1[0]), fast_sigmoid(v1[1]), fast_sigmoid(v1[2]), fast_sigmoid(v1[3])}; }
                    else { v0 = v0 * sc; v1 = v1 * sc; }
                    u32x4 w; w.x = cvt_pk_bf16(v0[0], v0[1]); w.y = cvt_pk_bf16(v0[2], v0[3]); w.z = cvt_pk_bf16(v1[0], v1[1]); w.w = cvt_pk_bf16(v1[2], v1[3]);
                    *(u32x4*)(rowp + bj * HALF) = w; } }
    }
};
struct EpiYMerge {
    static constexpr bool PERM = true, AFTER_DRAIN = false;
    const bf16_t* gates; bf16_t* merged;
    __device__ __forceinline__ void operator()(const f32x4 (&acc)[2][2][4][2], const Unit& u, int wr, int wc, int fr, int fq) const {
        const int n = u.pn >> 2, pn = u.pn & 3, pm = u.pm - 192 * n;
        const int row0 = pm * BM + wr * 64 + fr, col0 = pn * BM + wc * 32 + 8 * fq;
#pragma unroll
        for (int ai = 0; ai < 2; ++ai)
#pragma unroll
            for (int m = 0; m < 4; ++m) { const size_t r = (size_t)(row0 + ai * HALF + m * 16);
#pragma unroll
                for (int bj = 0; bj < 2; ++bj) { const int c = col0 + bj * HALF;
                    const u32x4 gv = *(const u32x4*)(gates + r * 3072 + n * 1024 + c);
                    f32x4 v0 = acc[ai][bj][m][0], v1 = acc[ai][bj][m][1];
                    v0[0] *= __uint_as_float(gv.x << 16); v0[1] *= __uint_as_float(gv.x & 0xffff0000u); v0[2] *= __uint_as_float(gv.y << 16); v0[3] *= __uint_as_float(gv.y & 0xffff0000u);
                    v1[0] *= __uint_as_float(gv.z << 16); v1[1] *= __uint_as_float(gv.z & 0xffff0000u); v1[2] *= __uint_as_float(gv.w << 16); v1[3] *= __uint_as_float(gv.w & 0xffff0000u);
                    bf16_t* mp = merged + r * 1024 + c;
                    if (n > 0) { const u32x4 pv = *(const u32x4*)mp;
                        v0[0] += __uint_as_float(pv.x << 16); v0[1] += __uint_as_float(pv.x & 0xffff0000u); v0[2] += __uint_as_float(pv.y << 16); v0[3] += __uint_as_float(pv.y & 0xffff0000u);
                        v1[0] += __uint_as_float(pv.z << 16); v1[1] += __uint_as_float(pv.z & 0xffff0000u); v1[2] += __uint_as_float(pv.w << 16); v1[3] += __uint_as_float(pv.w & 0xffff0000u); }
                    u32x4 w; w.x = cvt_pk_bf16(v0[0], v0[1]); w.y = cvt_pk_bf16(v0[2], v0[3]); w.z = cvt_pk_bf16(v1[0], v1[1]); w.w = cvt_pk_bf16(v1[2], v1[3]);
                    *(u32x4*)mp = w; } }
    }
};
struct YOrder {
    int vcu, G;
    __device__ __forceinline__ bool next(int i, Unit& u) const { const int j = i / 3, n = i - 3 * j, tile = vcu + G * j; if (tile >= 256) return false; u.pm = (tile >> 2) + 192 * n; u.pn = (tile & 3) + 4 * n; return true; }
    __device__ __forceinline__ void a_ready(const Unit&) const {}
    __device__ __forceinline__ void done(const Unit&) const {}
};
struct EpiResid32 {
    static constexpr bool PERM = false, AFTER_DRAIN = false;
    const float* xin; float* out;
    __device__ __forceinline__ void operator()(const f32x4 (&acc)[2][2][4][2], const Unit& u, int wr, int wc, int fr, int fq) const {
        const int row0 = u.pm * BM + wr * 64 + fr, col0 = u.pn * BM + wc * 32 + 4 * fq;
#pragma unroll
        for (int ai = 0; ai < 2; ++ai)
#pragma unroll
            for (int m = 0; m < 4; ++m) { const size_t off = (size_t)(row0 + ai * HALF + m * 16) * 1024 + col0;
#pragma unroll
                for (int bj = 0; bj < 2; ++bj)
#pragma unroll
                    for (int n = 0; n < 2; ++n) { const f32x4 xv = *(const f32x4*)(xin + off + bj * HALF + n * 16); *(f32x4*)(out + off + bj * HALF + n * 16) = xv + acc[ai][bj][m][n]; } }
    }
};

struct EpiSwiGLU {
    static constexpr bool PERM = true, AFTER_DRAIN = false;
    bf16_t* Hs;
    __device__ __forceinline__ void operator()(const f32x4 (&acc)[2][2][4][2], const Unit& u, int wr, int wc, int fr, int fq) const {
        const int j = u.pn & 1; const int row0 = u.pm * BM + wr * 64 + fr, col0 = j * 128 + wc * 32 + 8 * fq;
#pragma unroll
        for (int ai = 0; ai < 2; ++ai)
#pragma unroll
            for (int m = 0; m < 4; ++m) { bf16_t* rowp = Hs + (size_t)(row0 + ai * HALF + m * 16) * 256 + col0;
                f32x4 h0, h1;
#pragma unroll
                for (int t = 0; t < 4; ++t) { const float a0 = acc[ai][0][m][0][t], a1 = acc[ai][0][m][1][t]; h0[t] = a0 * fast_sigmoid(a0) * acc[ai][1][m][0][t]; h1[t] = a1 * fast_sigmoid(a1) * acc[ai][1][m][1][t]; }
                u32x4 w; w.x = cvt_pk_bf16(h0[0], h0[1]); w.y = cvt_pk_bf16(h0[2], h0[3]); w.z = cvt_pk_bf16(h1[0], h1[1]); w.w = cvt_pk_bf16(h1[2], h1[3]);
                *(u32x4*)rowp = w; }
    }
};
struct EpiMoeOut {
    static constexpr bool PERM = true, AFTER_DRAIN = false;
    bf16_t* Yp; const int* spair; const float* sw; const PG8_LAS int* panelValid;
    __device__ __forceinline__ void operator()(const f32x4 (&acc)[2][2][4][2], const Unit& u, int wr, int wc, int fr, int fq) const {
        const int jn = u.pn & 3, valid = panelValid[u.pm]; const int rl0 = wr * 64 + fr, col0 = jn * 256 + wc * 32 + 8 * fq;
#pragma unroll
        for (int ai = 0; ai < 2; ++ai)
#pragma unroll
            for (int m = 0; m < 4; ++m) { const int rl = rl0 + ai * HALF + m * 16;
                if (rl < valid) { const int slot = u.pm * BM + rl; const int pair = spair[slot]; const float w = sw[slot]; bf16_t* rowp = Yp + (size_t)pair * 1024 + col0;
#pragma unroll
                    for (int bj = 0; bj < 2; ++bj) { const f32x4 v0 = acc[ai][bj][m][0] * w, v1 = acc[ai][bj][m][1] * w;
                        u32x4 o; o.x = cvt_pk_bf16(v0[0], v0[1]); o.y = cvt_pk_bf16(v0[2], v0[3]); o.z = cvt_pk_bf16(v1[0], v1[1]); o.w = cvt_pk_bf16(v1[2], v1[3]);
                        *(u32x4*)(rowp + bj * HALF) = o; } } }
    }
};
struct MoeOrder {
    int vcu, G, P, nper; const PG8_LAS int* panelE;
    __device__ __forceinline__ bool next(int i, Unit& u) const { const int idx = vcu + G * i; if (idx >= nper * P) return false; const int p = idx / nper, j = idx - p * nper; u.pm = p; u.pn = panelE[p] * nper + j; return true; }
    __device__ __forceinline__ void a_ready(const Unit&) const {}
    __device__ __forceinline__ void done(const Unit&) const {}
};
template <class Epi, class Sched, bool ALIGN_EPI = false, bool SP2 = false>
__device__ __forceinline__ void gemm_phase(PG8_LAS unsigned char* lds, const Gemm g, const Sched& S, const Epi& E, const int wid) {
    const int lane = lane_id(), tid = wid * 64 + lane, wr = wid >> 2, wc = wid & 3, fr = lane & 15, fq = lane >> 4;
    const int K = g.K, nt = K / BK;
    unsigned voffA[2], voffB[2];
#pragma unroll
    for (int i = 0; i < 2; ++i) { int R, C; stage_rc(tid * 16 + i * 8192, R, C); const int Rb = Epi::PERM ? ((R & ~31) + perm32(R & 31)) : R;
        voffA[i] = (unsigned)(R * K + C) * 2u; voffB[i] = (unsigned)(Rb * K + C) * 2u; }
    const size_t kstep = (size_t)(BK * 2);
    const size_t hstep = (size_t)HALF * K * 2;
    const size_t tstep = 2 * hstep;
    const unsigned ldsw = (unsigned)wid * 1024u;
    const int aoff = lds_byte(wr * 64 + fr, fq * 8), boff = lds_byte(wc * 32 + fr, fq * 8);
#define PG8_SA(b, h) (((b) * 2 + (h)) * HTB)
#define PG8_SB(b, h) ((4 + (b) * 2 + (h)) * HTB)
#define PG8_STAGE(bufoff, gbase, voff) do { _Pragma("unroll") for (int _i = 0; _i < 2; ++_i) \
        __builtin_amdgcn_global_load_lds((const unsigned*)((const char*)(gbase) + (voff)[_i]), (PG8_LAS unsigned*)(lds + (bufoff) + ldsw + _i * 8192), 16, 0, 0); } while (0)
#define PG8_LDA(dst, b, h) do { _Pragma("unroll") for (int m = 0; m < 4; ++m) _Pragma("unroll") for (int k = 0; k < 2; ++k) dst[m][k] = *(const PG8_LAS bf16x8*)(lds + PG8_SA(b, h) + aoff + m * 2048 + k * 1024); } while (0)
#define PG8_LDB(dst, b, h) do { _Pragma("unroll") for (int n = 0; n < 2; ++n) _Pragma("unroll") for (int k = 0; k < 2; ++k) dst[n][k] = *(const PG8_LAS bf16x8*)(lds + PG8_SB(b, h) + boff + n * 2048 + k * 1024); } while (0)
#define PG8_MMA(ai, bj, At, Bt) do { __builtin_amdgcn_s_setprio(1); _Pragma("unroll") for (int m = 0; m < 4; ++m) _Pragma("unroll") for (int n = 0; n < 2; ++n) _Pragma("unroll") for (int k = 0; k < 2; ++k) \
        acc[ai][bj][m][n] = __builtin_amdgcn_mfma_f32_16x16x32_bf16(Bt[n][k], At[m][k], acc[ai][bj][m][n], 0, 0, 0); __builtin_amdgcn_s_setprio(0); } while (0)
#define PG8_WAIT_V(n) asm volatile("s_waitcnt vmcnt(" #n ")" ::: "memory")
#define PG8_WAIT_L(n) asm volatile("s_waitcnt lgkmcnt(" #n ")" ::: "memory")
#define PG8_BAR __builtin_amdgcn_s_barrier()
#define PG8_SCHED __builtin_amdgcn_sched_barrier(0)
    Unit cur, nxt; int ui = 0;
    if (!S.next(0, cur)) return;
    f32x4 acc[2][2][4][2];
#pragma unroll
    for (int a = 0; a < 2; ++a)
#pragma unroll
        for (int b = 0; b < 2; ++b)
#pragma unroll
            for (int m = 0; m < 4; ++m)
#pragma unroll
                for (int n = 0; n < 2; ++n) acc[a][b][m][n] = (f32x4){0.f, 0.f, 0.f, 0.f};
    bf16x8 At[4][2], B0[2][2], B1[2][2];
    const char* cA = (const char*)g.A + (size_t)cur.pm * tstep; const char* cB = (const char*)g.Bt + (size_t)cur.pn * tstep;
    S.a_ready(cur);
    if constexpr (SP2) {
        PG8_STAGE(PG8_SB(0, 0), cB, voffB); PG8_STAGE(PG8_SB(0, 1), cB + hstep, voffB); PG8_STAGE(PG8_SA(0, 0), cA, voffA); PG8_STAGE(PG8_SA(0, 1), cA + hstep, voffA);
        if (wr == 1) PG8_BAR;
        PG8_WAIT_V(2); PG8_BAR;
        PG8_STAGE(PG8_SB(1, 0), cB + kstep, voffB); PG8_STAGE(PG8_SA(1, 0), cA + kstep, voffA); PG8_STAGE(PG8_SB(1, 1), cB + hstep + kstep, voffB);
        PG8_WAIT_V(6); PG8_BAR;
    } else {
        PG8_STAGE(PG8_SB(0, 0), cB, voffB); PG8_STAGE(PG8_SA(0, 0), cA, voffA); PG8_STAGE(PG8_SB(0, 1), cB + hstep, voffB); PG8_STAGE(PG8_SA(0, 1), cA + hstep, voffA);
        if (wr == 1) PG8_BAR;
        PG8_WAIT_V(4); PG8_BAR;
        PG8_STAGE(PG8_SB(1, 0), cB + kstep, voffB); PG8_STAGE(PG8_SA(1, 0), cA + kstep, voffA); PG8_STAGE(PG8_SB(1, 1), cB + hstep + kstep, voffB);
        PG8_WAIT_V(6); PG8_BAR;
    }
    for (;;) {
        const bool has_next = S.next(ui + 1, nxt);
        const char* nA = has_next ? (const char*)g.A + (size_t)nxt.pm * tstep : cA; const char* nB = has_next ? (const char*)g.Bt + (size_t)nxt.pn * tstep : cB;
        for (int t = 0; t < nt; t += 2) {
            const bool last = (t == nt - 2);
            const char* a1 = cA + (size_t)(t + 1) * kstep;
            const char* a2 = last ? nA : cA + (size_t)(t + 2) * kstep; const char* b2 = last ? nB : cB + (size_t)(t + 2) * kstep;
            const char* a3 = a2 + kstep; const char* b3 = b2 + kstep;
            if (last && has_next) S.a_ready(nxt);
            if constexpr (SP2) {
            PG8_LDB(B0, 0, 0); PG8_LDB(B1, 0, 1); PG8_SCHED; PG8_LDA(At, 0, 0); PG8_STAGE(PG8_SA(1, 1), a1 + hstep, voffA);
            PG8_WAIT_V(8); PG8_WAIT_L(0); PG8_BAR; PG8_MMA(0, 0, At, B0); PG8_MMA(0, 1, At, B1); PG8_BAR; PG8_SCHED;
            PG8_LDA(At, 0, 1); PG8_STAGE(PG8_SB(0, 0), b2, voffB); PG8_STAGE(PG8_SB(0, 1), b2 + hstep, voffB); PG8_STAGE(PG8_SA(0, 0), a2, voffA);
            PG8_WAIT_V(8); PG8_WAIT_L(0); PG8_BAR; PG8_MMA(1, 0, At, B0); PG8_MMA(1, 1, At, B1); PG8_BAR; PG8_SCHED;
            PG8_LDB(B0, 1, 0); PG8_LDB(B1, 1, 1); PG8_SCHED; PG8_LDA(At, 1, 0); PG8_STAGE(PG8_SA(0, 1), a2 + hstep, voffA);
            PG8_WAIT_V(8); PG8_WAIT_L(0); PG8_BAR; PG8_MMA(0, 0, At, B0); PG8_MMA(0, 1, At, B1); PG8_BAR; PG8_SCHED;
            PG8_LDA(At, 1, 1); PG8_STAGE(PG8_SB(1, 0), b3, voffB); PG8_STAGE(PG8_SB(1, 1), b3 + hstep, voffB); PG8_STAGE(PG8_SA(1, 0), a3, voffA);
            PG8_WAIT_V(8); PG8_WAIT_L(0); PG8_BAR; PG8_MMA(1, 0, At, B0); PG8_MMA(1, 1, At, B1); PG8_BAR; PG8_SCHED;
            } else {
            PG8_LDB(B0, 0, 0); PG8_SCHED; PG8_LDA(At, 0, 0); PG8_STAGE(PG8_SA(1, 1), a1 + hstep, voffA);
            PG8_WAIT_L(8); PG8_BAR; PG8_WAIT_L(0); PG8_MMA(0, 0, At, B0); PG8_BAR; PG8_SCHED;
            PG8_LDB(B1, 0, 1); PG8_STAGE(PG8_SB(0, 0), b2, voffB);
            PG8_BAR; PG8_WAIT_L(0); PG8_MMA(0, 1, At, B1); PG8_BAR;
            PG8_LDA(At, 0, 1); PG8_STAGE(PG8_SA(0, 0), a2, voffA);
            PG8_BAR; PG8_WAIT_L(0); PG8_MMA(1, 0, At, B0); PG8_BAR; PG8_SCHED;
            PG8_STAGE(PG8_SB(0, 1), b2 + hstep, voffB);
            PG8_WAIT_V(6); PG8_BAR; PG8_MMA(1, 1, At, B1); PG8_BAR;
            PG8_LDB(B0, 1, 0); PG8_SCHED; PG8_LDA(At, 1, 0); PG8_STAGE(PG8_SA(0, 1), a2 + hstep, voffA);
            PG8_WAIT_L(8); PG8_BAR; PG8_WAIT_L(0); PG8_MMA(0, 0, At, B0); PG8_BAR; PG8_SCHED;
            PG8_LDB(B1, 1, 1); PG8_STAGE(PG8_SB(1, 0), b3, voffB);
            PG8_BAR; PG8_WAIT_L(0); PG8_MMA(0, 1, At, B1); PG8_BAR;
            PG8_LDA(At, 1, 1); PG8_STAGE(PG8_SA(1, 0), a3, voffA);
            PG8_BAR; PG8_WAIT_L(0); PG8_MMA(1, 0, At, B0); PG8_BAR; PG8_SCHED;
            PG8_STAGE(PG8_SB(1, 1), b3 + hstep, voffB);
            PG8_WAIT_V(6); PG8_BAR; PG8_MMA(1, 1, At, B1); PG8_BAR;
            }
        }
        if constexpr (ALIGN_EPI) { if (wr == 0) PG8_BAR; }
        if constexpr (!Epi::AFTER_DRAIN) { E(acc, cur, wr, wc, fr, fq); S.done(cur); }
        if (!has_next) break;
#pragma unroll
        for (int a = 0; a < 2; ++a)
#pragma unroll
            for (int b = 0; b < 2; ++b)
#pragma unroll
                for (int m = 0; m < 4; ++m)
#pragma unroll
                    for (int n = 0; n < 2; ++n) acc[a][b][m][n] = (f32x4){0.f, 0.f, 0.f, 0.f};
        cur = nxt; cA = nA; cB = nB; ++ui;
        if constexpr (ALIGN_EPI) { if (wr == 1) PG8_BAR; }
    }
    PG8_WAIT_V(0);
    if constexpr (!ALIGN_EPI) { if (wr == 0) PG8_BAR; }
    PG8_BAR;
    if constexpr (Epi::AFTER_DRAIN) { E.fused(acc, cur, wr, wc, fr, fq, lds, wid, lane); S.done(cur); }
#undef PG8_SA
#undef PG8_SB
#undef PG8_STAGE
#undef PG8_LDA
#undef PG8_LDB
#undef PG8_MMA
#undef PG8_WAIT_V
#undef PG8_WAIT_L
#undef PG8_BAR
#undef PG8_SCHED
}
}

#ifndef PG8_SP2
#define PG8_SP2 true
#endif
#ifndef PG8_ALIGN
#define PG8_ALIGN true
#endif
#define GAS __attribute__((address_space(1)))
#define LAS __attribute__((address_space(3)))
typedef unsigned short bf16;
typedef unsigned v4u __attribute__((ext_vector_type(4)));
typedef float f32x4 __attribute__((ext_vector_type(4)));
typedef short bf16x8 __attribute__((ext_vector_type(8)));
typedef GAS unsigned gu32;
typedef GAS unsigned long long gu64;
#define RLX_AGENT __ATOMIC_RELAXED, __HIP_MEMORY_SCOPE_AGENT
#define LDS_WAIT() asm volatile("s_waitcnt lgkmcnt(0)" ::: "memory")
#define VM_WAIT() asm volatile("s_waitcnt vmcnt(0)" ::: "memory")
__device__ __forceinline__ unsigned long long rt() { return __builtin_amdgcn_s_memrealtime(); }
__device__ __forceinline__ unsigned f2bf(float f) { unsigned u = __builtin_bit_cast(unsigned, f); return (u + 0x7fffu + ((u >> 16) & 1u)) >> 16; }
__device__ __forceinline__ unsigned pk2(float lo, float hi) { return f2bf(lo) | (f2bf(hi) << 16); }

#define XB_TMO      128
#define XB_XCNT(j)  (256  + 64 * (j))
#define XB_XSUB(j)  (1280 + 64 * (j))
#define XB_XGEN(j)  (2304 + 64 * (j))
#define XB_TOP      3328
#define XB_TOPGEN   3392
#define XCD_BAR_WORDS 3456
#define XB_SPIN_CAP (1u << 18)

__device__ __forceinline__ unsigned xb_ld(unsigned* p)              { return __hip_atomic_load(p, __ATOMIC_RELAXED, __HIP_MEMORY_SCOPE_AGENT); }
__device__ __forceinline__ unsigned xb_add(unsigned* p, unsigned v) { return __hip_atomic_fetch_add(p, v, __ATOMIC_RELAXED, __HIP_MEMORY_SCOPE_AGENT); }
__device__ __forceinline__ unsigned xb_xcc_id() { return (unsigned)__builtin_amdgcn_s_getreg((3 << 11) | 20) & 0xFu; }
#define XB_SPIN(cond, bar) do { unsigned _sp = 0; while (cond) { __builtin_amdgcn_s_sleep(1); \
    if ((++_sp & 255u) == 0u) { if (xb_ld(&(bar)[XB_TMO])) break; if (_sp > XB_SPIN_CAP) { atomicAdd(&(bar)[XB_TMO], 1u); break; } } } } while (0)

struct XcdBarrier {
    unsigned* bar; unsigned x; unsigned w;
    volatile LAS unsigned* st;
};

__device__ __forceinline__ XcdBarrier xcd_barrier_post(unsigned* bar, volatile LAS unsigned* st, unsigned wave) {
    XcdBarrier b; b.bar = bar; b.x = xb_xcc_id(); b.st = st; b.w = wave;
    if (wave == 0u && lane_id() == 0) (void)xb_add(&bar[XB_XCNT(b.x)], 1u);
    return b;
}
__device__ __forceinline__ void xcd_barrier_complete(unsigned* bar, unsigned x, unsigned& nloc, unsigned& nx) {
    const unsigned G = gridDim.x * gridDim.y * gridDim.z;
    unsigned sum, cnt, mine, sp = 0u;
    for (;;) {
        sum = 0u; cnt = 0u; mine = 0u;
#pragma unroll
        for (unsigned j = 0; j < 16; ++j) { const unsigned c = xb_ld(&bar[XB_XCNT(j)]); sum += c; cnt += (c > 0u) ? 1u : 0u; mine = (j == x) ? c : mine; }
        if (sum == G) break;
        __builtin_amdgcn_s_sleep(1);
        if ((++sp & 255u) == 0u) { if (xb_ld(&bar[XB_TMO])) break; if (sp > XB_SPIN_CAP) { atomicAdd(&bar[XB_TMO], 1u); break; } }
    }
    nloc = mine > 0u ? mine : 1u; nx = cnt > 0u ? cnt : 1u;
}

__device__ __forceinline__ void xcd_barrier(const XcdBarrier& b) {
    asm volatile("s_waitcnt vmcnt(0)" ::: "memory");
    __syncthreads();
    if (b.w == 0u && lane_id() == 0) {
        unsigned* bar = b.bar;
        __builtin_amdgcn_s_waitcnt(0);
        unsigned nloc = b.st[0], nx = b.st[1];
        if (nloc == 0u) { xcd_barrier_complete(bar, b.x, nloc, nx); b.st[0] = nloc; b.st[1] = nx; }
        const unsigned old = xb_add(&bar[XB_XSUB(b.x)], 1u);
        const unsigned gen = old / nloc;
        if (old + 1u == (gen + 1u) * nloc) {
            __builtin_amdgcn_fence(__ATOMIC_RELEASE, "agent");
            asm volatile("s_waitcnt vmcnt(0)" ::: "memory");
            const unsigned og = xb_add(&bar[XB_TOP], 1u);
            const unsigned tg = og / nx;
            if (og + 1u == (tg + 1u) * nx) xb_add(&bar[XB_TOPGEN], 1u);
            else XB_SPIN(xb_ld(&bar[XB_TOPGEN]) == tg, bar);
            __builtin_amdgcn_fence(__ATOMIC_ACQUIRE, "agent");
            xb_add(&bar[XB_XGEN(b.x)], 1u);
            asm volatile("s_waitcnt vmcnt(0)" ::: "memory");
        } else {
            XB_SPIN(xb_ld(&bar[XB_XGEN(b.x)]) == gen, bar);
            __builtin_amdgcn_fence(__ATOMIC_ACQUIRE, "agent");
            asm volatile("s_waitcnt vmcnt(0)" ::: "memory");
        }
    }
    __syncthreads();
}
#include <hip/hip_bf16.h>
#include <cmath>
namespace attn_body {
using bf16=__hip_bfloat16;
using bf16x8=__attribute__((ext_vector_type(8)))short;
using s16x4=__attribute__((ext_vector_type(4)))short;
using f32x16=__attribute__((ext_vector_type(16)))float;
using u32x4=__attribute__((ext_vector_type(4)))unsigned;
constexpr int BATCH=8,NHEAD=8,SEQ=2048,D=64,DM=NHEAD*D;
constexpr int NW=8,QBLK=32,QB=QBLK*NW,KVBLK=64,NQB=SEQ/QB;
constexpr int ATTN_PITCH=DM, ATTN_UNIT_ROWS=QB;
__device__ __forceinline__ int crow(int r,int hi){return (r&3)+8*(r>>2)+4*hi;}
#define SBAR() __builtin_amdgcn_sched_barrier(0)
__device__ __forceinline__ void cmask(f32x16&p0,f32x16&p1,int jb,int qrel,int hi){
  const float NEG=-INFINITY; int kb=64*jb+4*hi;
  #pragma unroll
  for(int r=0;r<16;++r){int kv=kb+(r&3)+8*(r>>2); if(kv>qrel)p0[r]=NEG; if(kv+32>qrel)p1[r]=NEG;}
}

constexpr int NSLOT=3, SLOTB=8192;
constexpr int LDS_K=0, LDS_V=NSLOT*SLOTB, LDS_WS=2*NSLOT*SLOTB, LDS_OST=LDS_WS+NW*64*4, LDS_BYTES=LDS_OST+NW*4096;
constexpr float C2=0.125f*1.4426950408889634f;
__device__ __forceinline__ void glds16(const void*gsrc,unsigned lds_dst){unsigned keep;
  asm volatile("s_mov_b32 %0, m0\n\ts_mov_b32 m0, %2\n\ts_nop 0\n\tglobal_load_lds_dwordx4 %1, off\n\ts_mov_b32 m0, %0":"=&s"(keep):"v"(gsrc),"s"(lds_dst):"memory");}
__device__ __forceinline__ float max3f(float a,float b,float c){float r;asm("v_max3_f32 %0, %1, %2, %3":"=v"(r):"v"(a),"v"(b),"v"(c));return r;}
__device__ __forceinline__ float max2f(float a,float b){float r;asm("v_max_f32_e32 %0, %1, %2":"=v"(r):"v"(a),"v"(b));return r;}
__device__ __forceinline__ float fadd_s(float a,float b){float r;asm("v_add_f32_e32 %0, %1, %2":"=v"(r):"v"(a),"v"(b));return r;}
__device__ __forceinline__ float fsub_s(float a,float b){float r;asm("v_sub_f32_e32 %0, %1, %2":"=v"(r):"v"(a),"v"(b));return r;}
typedef float f32x2_t __attribute__((ext_vector_type(2))); typedef __bf16 bf16x2_t __attribute__((ext_vector_type(2)));
__device__ __forceinline__ unsigned cvtpk_s(float lo,float hi){f32x2_t v={lo,hi};bf16x2_t b=__builtin_convertvector(v,bf16x2_t);return __builtin_bit_cast(unsigned,b);}
#define WAIT_BAR(N) asm volatile("s_waitcnt vmcnt(" #N ") lgkmcnt(0)\n\ts_barrier":::"memory")

__device__ __forceinline__ void qkt(f32x16&p0,f32x16&p1,const char*Kslot,const bf16x8*qr,const f32x16&negm,int r32,int hi){
  const char*kb=Kslot+hi*1024+r32*16;
  #pragma unroll
  for(int d0=0;d0<4;++d0){
    const bf16x8 b0=*reinterpret_cast<const bf16x8*>(kb+d0*2048);
    const bf16x8 b1=*reinterpret_cast<const bf16x8*>(kb+d0*2048+512);
    if(d0==0){p0=__builtin_amdgcn_mfma_f32_32x32x16_bf16(b0,qr[0],negm,0,0,0);p1=__builtin_amdgcn_mfma_f32_32x32x16_bf16(b1,qr[0],negm,0,0,0);}
    else{p0=__builtin_amdgcn_mfma_f32_32x32x16_bf16(b0,qr[d0],p0,0,0,0);p1=__builtin_amdgcn_mfma_f32_32x32x16_bf16(b1,qr[d0],p1,0,0,0);}}
}
typedef __attribute__((address_space(3))) const char* lds_cptr;
typedef short v4i16_t __attribute__((ext_vector_type(4)));
__device__ __forceinline__ void kload8(bf16x8*kf,lds_cptr kp){
  kf[0]=*(const __attribute__((address_space(3))) bf16x8*)(kp);      kf[1]=*(const __attribute__((address_space(3))) bf16x8*)(kp+512);
  kf[2]=*(const __attribute__((address_space(3))) bf16x8*)(kp+2048); kf[3]=*(const __attribute__((address_space(3))) bf16x8*)(kp+2560);
  kf[4]=*(const __attribute__((address_space(3))) bf16x8*)(kp+4096); kf[5]=*(const __attribute__((address_space(3))) bf16x8*)(kp+4608);
  kf[6]=*(const __attribute__((address_space(3))) bf16x8*)(kp+6144); kf[7]=*(const __attribute__((address_space(3))) bf16x8*)(kp+6656);
}
__device__ __forceinline__ void kload2(bf16x8*kf,lds_cptr kp,int j){ kf[2*j]=*(const __attribute__((address_space(3))) bf16x8*)(kp+j*2048); kf[2*j+1]=*(const __attribute__((address_space(3))) bf16x8*)(kp+j*2048+512); }
__device__ __forceinline__ s16x4 vtr(lds_cptr p){ return __builtin_bit_cast(s16x4,__builtin_amdgcn_ds_read_tr16_b64_v4i16((__attribute__((address_space(3))) v4i16_t*)p)); }
__device__ __forceinline__ float rowmax(const f32x16&p0,const f32x16&p1){
  float a=max3f(p0[0],p0[1],p1[0]),b=max3f(p0[2],p0[3],p1[1]);a=max3f(a,p1[2],p1[3]);
  #pragma unroll
  for(int r=4;r<16;r+=4){a=max3f(a,p0[r],p0[r+1]);b=max3f(b,p0[r+2],p0[r+3]);a=max3f(a,p1[r],p1[r+1]);b=max3f(b,p1[r+2],p1[r+3]);}
  const float m=max2f(a,b);
  auto rr=__builtin_amdgcn_permlane32_swap(__float_as_uint(m),__float_as_uint(m),false,false);
  return max2f(__uint_as_float(rr[0]),__uint_as_float(rr[1]));
}
__device__ __forceinline__ void pv(f32x16*o,int vb,bf16x8 pa0,bf16x8 pa1,bf16x8 pa2,bf16x8 pa3){
  #pragma unroll
  for(int d0=0;d0<2;++d0){s16x4 lo[4],hi[4];
    #pragma unroll
    for(int ks=0;ks<4;++ks){
      asm volatile("ds_read_b64_tr_b16 %0,%1 offset:%c2":"=&v"(lo[ks]):"v"(vb),"i"(d0*4096+ks*1024):"memory");
      asm volatile("ds_read_b64_tr_b16 %0,%1 offset:%c2":"=&v"(hi[ks]):"v"(vb),"i"(d0*4096+ks*1024+512):"memory");}
    asm volatile("s_waitcnt lgkmcnt(0)":::"memory");SBAR();
    #define PK(k) (bf16x8){lo[k][0],lo[k][1],lo[k][2],lo[k][3],hi[k][0],hi[k][1],hi[k][2],hi[k][3]}
    o[d0]=__builtin_amdgcn_mfma_f32_32x32x16_bf16(pa0,PK(0),o[d0],0,0,0);
    o[d0]=__builtin_amdgcn_mfma_f32_32x32x16_bf16(pa1,PK(1),o[d0],0,0,0);
    o[d0]=__builtin_amdgcn_mfma_f32_32x32x16_bf16(pa2,PK(2),o[d0],0,0,0);
    o[d0]=__builtin_amdgcn_mfma_f32_32x32x16_bf16(pa3,PK(3),o[d0],0,0,0);
    #undef PK
  }
}

#ifndef ATTN_STORE16
#define ATTN_STORE16(p,v) (*(u32x4*)(p)=(v))
#endif
template<int THRL> __device__ __forceinline__ void attn_unit(int b,int h,int qb,const bf16*Q,const bf16*__restrict__ K,const bf16*__restrict__ V,bf16*O,char*shm,const float*__restrict__ kmean,const int wid){
  const int lane=lane_id(),r32=lane&31,hi=lane>>5;
  const long rowbase=(long)b*SEQ; const int q0=qb*QB;
  const bf16*Qw=Q+(rowbase+q0+wid*QBLK)*DM+h*D;
  const bf16*Kh=K+rowbase*DM+h*D,*Vh=V+rowbase*DM+h*D;
  const unsigned lds0=(unsigned)(uintptr_t)shm;
  float*wsf=(float*)(shm+LDS_WS)+wid*64;
  const bf16*ksrc=Kh+(long)lane*DM+wid*8;
  const bf16*vsrc=Vh+(long)(16*(wid&3)+(lane>>2))*DM+(wid>>2)*32+(lane&3)*8;
  const unsigned kdst=lds0+LDS_K+wid*1024, vdst=lds0+LDS_V+wid*1024;
  #define DMA_K(t,slot) glds16(ksrc+(long)(t)*KVBLK*DM,(unsigned)__builtin_amdgcn_readfirstlane(kdst+(slot)))
  #define DMA_V(t,slot) glds16(vsrc+(long)(t)*KVBLK*DM,(unsigned)__builtin_amdgcn_readfirstlane(vdst+(slot)))
  const int vb0=(int)(lds0+LDS_V)+((lane>>4)&1)*32+(lane&3)*8+(4*hi+((lane&15)>>2))*64;
  const char*Kbase=shm+LDS_K; bf16x8 kf[8];
  const lds_cptr shm3=(lds_cptr)shm; const lds_cptr kp0=shm3+LDS_K+hi*1024+r32*16; const lds_cptr vp0=shm3+LDS_V+((lane>>4)&1)*32+(lane&3)*8+(4*hi+((lane&15)>>2))*64;
  const int NT=(q0+QB)/KVBLK;
  DMA_K(0,0);DMA_V(0,0);DMA_K(1,SLOTB);
  bf16x8 qr[4];
  #pragma unroll
  for(int d0=0;d0<4;++d0)qr[d0]=*reinterpret_cast<const bf16x8*>(&Qw[(long)r32*DM+d0*16+hi*8]);
  unsigned sel=0xffu;
  if(qb>3){
    float g[8];
    #pragma unroll
    for(int blk=0;blk<7;++blk){ float sdot=0.f;
      if(blk<qb){ const float*km=kmean+((long)(b*NHEAD+h)*8+blk)*64+hi*8;
        #pragma unroll
        for(int d0=0;d0<4;++d0){ const float4 ka=*(const float4*)(km+d0*16), kb=*(const float4*)(km+d0*16+4); const bf16x8 qv=qr[d0];
          sdot+=__uint_as_float((unsigned)(unsigned short)qv[0]<<16)*ka.x+__uint_as_float((unsigned)(unsigned short)qv[1]<<16)*ka.y+__uint_as_float((unsigned)(unsigned short)qv[2]<<16)*ka.z+__uint_as_float((unsigned)(unsigned short)qv[3]<<16)*ka.w
               +__uint_as_float((unsigned)(unsigned short)qv[4]<<16)*kb.x+__uint_as_float((unsigned)(unsigned short)qv[5]<<16)*kb.y+__uint_as_float((unsigned)(unsigned short)qv[6]<<16)*kb.z+__uint_as_float((unsigned)(unsigned short)qv[7]<<16)*kb.w; }
        auto rr=__builtin_amdgcn_permlane32_swap(__float_as_uint(sdot),__float_as_uint(sdot),false,false); sdot=__uint_as_float(rr[0])+__uint_as_float(rr[1]); }
      g[blk]=blk<qb?sdot:-INFINITY; }
    g[7]=-INFINITY; sel=0u;
    #pragma unroll
    for(int rnd=0;rnd<3;++rnd){ float best=-INFINITY; int bi=-1;
      #pragma unroll
      for(int blk=0;blk<8;++blk){ const bool ok=!((sel>>blk)&1u)&&g[blk]>best; if(ok){best=g[blk];bi=blk;} }
      if(bi>=0)sel|=1u<<bi; }
  }
  #define BMASK(P0,P1,t) do{ const int blk_=(t)>>2; if(blk_<qb){ if(!((sel>>blk_)&1u)){ _Pragma("unroll") for(int r=0;r<16;++r){P0[r]=-1000.f;P1[r]=-1000.f;} } } }while(0)
  float mhat=0.f,l_reg=0.f;f32x16 o[2];o[0]=f32x16{};o[1]=f32x16{};const f32x16 zero16=f32x16{};
  const int qrel=wid*QBLK+r32;
  #define CMASK(P0,P1,t) do{int jb_=(t)-(NT-4); if(jb_>=0)cmask(P0,P1,jb_,qrel,hi);}while(0)
  bool resc=false;
  #define START(P0,P1) do{ const float rm=rowmax(P0,P1); resc=false; \
    { const float dl=rm; mhat=fadd_s(mhat,dl); \
      _Pragma("unroll") for(int r=0;r<16;++r){P0[r]=fsub_s(P0[r],dl);P1[r]=fsub_s(P1[r],dl);} \
      } \
    _Pragma("unroll") for(int r=0;r<16;++r)P0[r]=__builtin_amdgcn_exp2f(P0[r]); }while(0)
  #define RESC() do{ if(resc){ asm volatile("s_waitcnt lgkmcnt(0)":::"memory"); \
      _Pragma("unroll") for(int d_=0;d_<2;++d_) _Pragma("unroll") for(int r=0;r<16;++r)o[d_][r]*=wsf[crow(r,hi)]; } }while(0)
  f32x16 pA0,pA1,pB0,pB1;
  int sl_prev=0,sl_cur=0,sl_next=SLOTB;
  #define ROT() do{sl_prev=sl_cur;sl_cur=sl_next;sl_next=(sl_next==(NSLOT-1)*SLOTB)?0:sl_next+SLOTB;}while(0)
  DMA_K(2,2*SLOTB);
  WAIT_BAR(3);
  qkt(pA0,pA1,Kbase,qr,zero16,r32,hi);asm volatile("s_nop 15\n\ts_nop 7":"+v"(pA0),"+v"(pA1));CMASK(pA0,pA1,0);BMASK(pA0,pA1,0);
  START(pA0,pA1);
  _Pragma("unroll") for(int r=0;r<16;++r)pA1[r]=__builtin_amdgcn_exp2f(pA1[r]);
  WAIT_BAR(0);
  DMA_K(3,0);DMA_V(1,SLOTB);
  ROT();
  kload8(kf,kp0+sl_cur);
  WAIT_BAR(2);
  s16x4 vlo[8],vhi[8]; u32x4 pw0,pw1,pw2,pw3;
  #define PKW(P,B) cvtpk_s(P[B],P[B+1])
  #define PAF(k) __builtin_bit_cast(bf16x8,pw##k)
  #define VFR(i) (bf16x8){vlo[i][0],vlo[i][1],vlo[i][2],vlo[i][3],vhi[i][0],vhi[i][1],vhi[i][2],vhi[i][3]}
  #define PIN(x) asm volatile("":"+v"(x))
  #define MX3(a,b,c) __builtin_fmaxf(__builtin_fmaxf((a),(b)),(c))
  #define GAPA(MF,A0,A1,A2,A3,W0,W1,PW) do{ MF; sacc+=A0; sacc+=A1; sacc+=A2; sacc+=A3; PIN(sacc); W0; W1; PIN(PW); SBAR(); }while(0)
  #define EX(v) __builtin_amdgcn_exp2f(v)
  #define GAPB(MF,X,B) do{ MF; X[B]=EX(X[B]); X[B+1]=EX(X[B+1]); X[B+2]=EX(X[B+2]); X[B+3]=EX(X[B+3]); PIN(X); SBAR(); }while(0)
  #define VRD(i) do{ vlo[i]=vtr(vp_+(((i)>>2)*4096+((i)&3)*1024)); vhi[i]=vtr(vp_+(((i)>>2)*4096+((i)&3)*1024+512)); }while(0)
  #define KRD(G,j) do{ if(G){ kload2(kf,kp0+sl_next,j); SBAR(); } }while(0)
  #define STEP(C0,C1,P0,P1,t,GK,GV,GL) do{ SBAR(); \
    const lds_cptr vp_=vp0+sl_prev; \
    float sacc=(P0[0]+P0[1]); \
    GAPA(C0=__builtin_amdgcn_mfma_f32_32x32x16_bf16(kf[0],qr[0],zero16,0,0,0), P0[2],P0[3],P0[4],P0[5],     pw0[0]=PKW(P0,0), pw0[1]=PKW(P0,2), pw0); \
    GAPA(C1=__builtin_amdgcn_mfma_f32_32x32x16_bf16(kf[1],qr[0],zero16,0,0,0), P0[6],P0[7],P0[8],P0[9],     pw0[2]=PKW(P0,4), pw0[3]=PKW(P0,6), pw0); \
    GAPA(C0=__builtin_amdgcn_mfma_f32_32x32x16_bf16(kf[2],qr[1],C0,0,0,0),   P0[10],P0[11],P0[12],P0[13], pw1[0]=PKW(P0,8), pw1[1]=PKW(P0,10), pw1); \
    GAPA(C1=__builtin_amdgcn_mfma_f32_32x32x16_bf16(kf[3],qr[1],C1,0,0,0),   P0[14],P0[15],P1[0],P1[1],   pw1[2]=PKW(P0,12),pw1[3]=PKW(P0,14), pw1); \
    GAPA(C0=__builtin_amdgcn_mfma_f32_32x32x16_bf16(kf[4],qr[2],C0,0,0,0),   P1[2],P1[3],P1[4],P1[5],     pw2[0]=PKW(P1,0), pw2[1]=PKW(P1,2), pw2); \
    GAPA(C1=__builtin_amdgcn_mfma_f32_32x32x16_bf16(kf[5],qr[2],C1,0,0,0),   P1[6],P1[7],P1[8],P1[9],     pw2[2]=PKW(P1,4), pw2[3]=PKW(P1,6), pw2); \
    VRD(0); SBAR(); GAPA(C0=__builtin_amdgcn_mfma_f32_32x32x16_bf16(kf[6],qr[3],C0,0,0,0),   P1[10],P1[11],P1[12],P1[13], pw3[0]=PKW(P1,8), pw3[1]=PKW(P1,10), pw3); \
    VRD(4); SBAR(); GAPA(C1=__builtin_amdgcn_mfma_f32_32x32x16_bf16(kf[7],qr[3],C1,0,0,0),   P1[14],P1[15],0.f,0.f,       pw3[2]=PKW(P1,12),pw3[3]=PKW(P1,14), pw3); \
    l_reg+=sacc; \
    _Pragma("unroll") for(int r=0;r<16;++r){C0[r]-=mhat;C1[r]-=mhat;} \
    if(GK){DMA_K((t)+3,sl_cur);} if(GV){DMA_V((t)+1,sl_next);} \
    CMASK(C0,C1,t); BMASK(C0,C1,t); \
    { float a=MX3(C0[0],C0[1],C1[0]),b=MX3(C0[2],C0[3],C1[1]); a=MX3(a,C1[2],C1[3]); \
      _Pragma("unroll") for(int r=4;r<16;r+=4){a=MX3(a,C0[r],C0[r+1]);b=MX3(b,C0[r+2],C0[r+3]);a=MX3(a,C1[r],C1[r+1]);b=MX3(b,C1[r+2],C1[r+3]);} \
      float rm=__builtin_fmaxf(a,b); { auto rr=__builtin_amdgcn_permlane32_swap(__float_as_uint(rm),__float_as_uint(rm),false,false); rm=__builtin_fmaxf(__uint_as_float(rr[0]),__uint_as_float(rr[1])); } \
      resc=false; \
      if(__builtin_expect(__any(rm>(float)THRL),0)){ const float dl=__builtin_fmaxf(rm,0.f); mhat+=dl; \
        _Pragma("unroll") for(int r=0;r<16;++r){C0[r]-=dl;C1[r]-=dl;} \
        const float f=__builtin_amdgcn_exp2f(-dl); l_reg*=f; if(hi==0)wsf[r32]=f; resc=true; } } \
    SBAR(); \
    VRD(1); SBAR(); GAPB(o[0]=__builtin_amdgcn_mfma_f32_32x32x16_bf16(PAF(0),VFR(0),o[0],0,0,0), C0,0); \
    VRD(5); SBAR(); GAPB(o[1]=__builtin_amdgcn_mfma_f32_32x32x16_bf16(PAF(0),VFR(4),o[1],0,0,0), C0,4); \
    VRD(2); SBAR(); KRD(GL,0); GAPB(o[0]=__builtin_amdgcn_mfma_f32_32x32x16_bf16(PAF(1),VFR(1),o[0],0,0,0), C0,8); \
    VRD(6); SBAR(); KRD(GL,1); GAPB(o[1]=__builtin_amdgcn_mfma_f32_32x32x16_bf16(PAF(1),VFR(5),o[1],0,0,0), C0,12); \
    VRD(3); SBAR(); KRD(GL,2); GAPB(o[0]=__builtin_amdgcn_mfma_f32_32x32x16_bf16(PAF(2),VFR(2),o[0],0,0,0), C1,0); \
    VRD(7); SBAR(); KRD(GL,3); GAPB(o[1]=__builtin_amdgcn_mfma_f32_32x32x16_bf16(PAF(2),VFR(6),o[1],0,0,0), C1,4); \
    GAPB(o[0]=__builtin_amdgcn_mfma_f32_32x32x16_bf16(PAF(3),VFR(3),o[0],0,0,0), C1,8); \
    GAPB(o[1]=__builtin_amdgcn_mfma_f32_32x32x16_bf16(PAF(3),VFR(7),o[1],0,0,0), C1,12); \
    }while(0)
  int t=1;
  #undef CMASK
  #define CMASK(P0,P1,t) do{}while(0)
  for(;t+5<NT;t+=2){
    STEP(pB0,pB1,pA0,pA1,t,true,true,true);     WAIT_BAR(2); RESC(); ROT();
    STEP(pA0,pA1,pB0,pB1,t+1,true,true,true);   WAIT_BAR(2); RESC(); ROT();
  }
  #undef CMASK
  const int laneB=lane_id(); const int qrelB=wid*QBLK+(laneB&31), hiB=laneB>>5;
  #define CMASK(P0,P1,t) do{int jb_=(t)-(NT-4); if(jb_>=0)cmask(P0,P1,jb_,qrelB,hiB);}while(0)
  #define ENDW(tt) do{ if((tt)+3<NT){WAIT_BAR(2);} else if((tt)+2<NT){WAIT_BAR(1);} else {WAIT_BAR(0);} }while(0)
  for(;t+1<NT;t+=2){
    STEP(pB0,pB1,pA0,pA1,t,(t+3<NT),(t+1<NT),(t+1<NT));       ENDW(t);   RESC(); ROT();
    STEP(pA0,pA1,pB0,pB1,t+1,(t+4<NT),(t+2<NT),(t+2<NT));     ENDW(t+1); RESC(); ROT();
  }
  STEP(pB0,pB1,pA0,pA1,NT-1,false,false,false); RESC();
  { float sacc=pB0[0]+pB0[1]; _Pragma("unroll") for(int r=2;r<16;++r)sacc+=pB0[r]; _Pragma("unroll") for(int r=0;r<16;++r)sacc+=pB1[r]; l_reg+=sacc;
    pw0=(u32x4){PKW(pB0,0),PKW(pB0,2),PKW(pB0,4),PKW(pB0,6)};pw1=(u32x4){PKW(pB0,8),PKW(pB0,10),PKW(pB0,12),PKW(pB0,14)};pw2=(u32x4){PKW(pB1,0),PKW(pB1,2),PKW(pB1,4),PKW(pB1,6)};pw3=(u32x4){PKW(pB1,8),PKW(pB1,10),PKW(pB1,12),PKW(pB1,14)};
    SBAR(); pv(o,vb0+sl_cur,PAF(0),PAF(1),PAF(2),PAF(3)); }
  #undef PKW
  #undef PAF
  #undef VFR
  #undef PIN
  #undef MX3
  #undef GAPA
  #undef GAPB
  #undef EX
  #undef VRD
  #undef KRD
  #undef STEP
  #undef ENDW
  {auto rr=__builtin_amdgcn_permlane32_swap(__float_as_uint(l_reg),__float_as_uint(l_reg),false,false);l_reg=__uint_as_float(rr[0])+__uint_as_float(rr[1]);}
  const int laneE=lane_id(); const int r32E=laneE&31, hiE=laneE>>5; float*wsfE=(float*)(shm+LDS_WS)+wid*64;
  if(hiE==0)wsfE[32+r32E]=l_reg;asm volatile("s_waitcnt lgkmcnt(0)":::"memory");
  float rli[16];
  #pragma unroll
  for(int r=0;r<16;++r)rli[r]=__builtin_amdgcn_rcpf(wsfE[32+crow(r,hiE)]);
  bf16*Ow=O+(rowbase+q0+wid*QBLK)*DM+h*D;
  { bf16*stg=(bf16*)(shm+LDS_OST)+wid*2048;
    #pragma unroll
    for(int r=0;r<16;++r){const int orow=crow(r,hiE);
      #pragma unroll
      for(int d0=0;d0<2;++d0)stg[orow*64+d0*32+r32E]=__float2bfloat16(o[d0][r]*rli[r]);}
    asm volatile("s_waitcnt lgkmcnt(0)":::"memory");
    #pragma unroll
    for(int i=0;i<4;++i){const int row=i*8+(laneE>>3),ch=laneE&7; const u32x4 v=*(const u32x4*)(stg+row*64+ch*8); ATTN_STORE16(Ow+(long)row*DM+ch*8,v);} }
  asm volatile("s_waitcnt lgkmcnt(0)\n\ts_barrier":::"memory");
  #undef BMASK
  #undef DMA_K
  #undef DMA_V
  #undef CMASK
  #undef START
  #undef RESC
  #undef ROT
}
constexpr int ATTN_LDS_BYTES=LDS_BYTES;
struct AttnTensors { const bf16* Q; const bf16* K; const bf16* V; bf16* O; };
struct AttnUnit { int bh; int qb; };
struct StaticOrder {
  int vcu,G;
  __device__ __forceinline__ explicit StaticOrder(int grid,int block):vcu((grid%8==0)?(block%8)*(grid/8)+block/8:block),G(grid){}
  __device__ __forceinline__ bool next(int i,AttnUnit&u)const{ const int v=vcu+G*(i>>1); if(v>=256)return false; const int s=v&3; u.bh=v>>2; u.qb=(i&1)?7-s:s; return true; }
  __device__ __forceinline__ void a_ready(const AttnUnit&)const{}
  __device__ __forceinline__ void done(const AttnUnit&)const{}
};
template<class Sched,int THRL=8> __device__ __forceinline__ void attn_phase(char*lds,const AttnTensors&T,const Sched&S,const float*kmean,const int wid){
  AttnUnit u;
  for(int i=0;S.next(i,u);++i){ S.a_ready(u); attn_unit<THRL>(u.bh/NHEAD,u.bh%NHEAD,u.qb,T.Q,T.K,T.V,T.O,lds,kmean,wid); S.done(u); }
}
#undef SBAR
#undef WAIT_BAR
}
typedef unsigned v2u __attribute__((ext_vector_type(2)));
__device__ __forceinline__ float bf2f(bf16 v) { return __uint_as_float((unsigned)v << 16); }
__device__ __forceinline__ float sigmoidf_(float x) { return 1.0f / (1.0f + __expf(-x)); }
__device__ __forceinline__ float wave_sum(float v) {
#pragma unroll
    for (int o = 1; o < 64; o <<= 1) v += __shfl_xor(v, o);
    return v;
}
__device__ __forceinline__ void load64(const bf16* p, float (&x)[64]) {
#pragma unroll
    for (int i = 0; i < 8; ++i) { const uint4 v = ((const uint4*)p)[i];
        x[8 * i + 0] = __uint_as_float(v.x << 16); x[8 * i + 1] = __uint_as_float(v.x & 0xffff0000u);
        x[8 * i + 2] = __uint_as_float(v.y << 16); x[8 * i + 3] = __uint_as_float(v.y & 0xffff0000u);
        x[8 * i + 4] = __uint_as_float(v.z << 16); x[8 * i + 5] = __uint_as_float(v.z & 0xffff0000u);
        x[8 * i + 6] = __uint_as_float(v.w << 16); x[8 * i + 7] = __uint_as_float(v.w & 0xffff0000u); }
}
__device__ __forceinline__ void store64(bf16* p, const float (&x)[64]) {
#pragma unroll
    for (int i = 0; i < 8; ++i) { uint4 v;
        v.x = pk2(x[8 * i + 0], x[8 * i + 1]); v.y = pk2(x[8 * i + 2], x[8 * i + 3]); v.z = pk2(x[8 * i + 4], x[8 * i + 5]); v.w = pk2(x[8 * i + 6], x[8 * i + 7]);
        ((uint4*)p)[i] = v; }
}
constexpr int NWAVES = 8;
constexpr int RING_OFF = 0, RING_BYTES = 131072, LDSCTL_OFF = RING_BYTES, MISC_OFF = LDSCTL_OFF + 320, LDS_BYTES = 147456;
constexpr int CW_TMO = 0, CW_CODE = 1, CW_BAR = 4096;
__device__ __forceinline__ const void* karg_ptr(int i) { const void* const volatile __attribute__((address_space(4)))* k = (const void* const volatile __attribute__((address_space(4)))*)__builtin_amdgcn_kernarg_segment_ptr(); return k[i]; }
#define KARG(i) karg_ptr(i)
struct Args { const void* in[18]; float* out; unsigned char* ws; int layer, ph_lo, ph_hi, pad; };
struct Frame {
    LAS unsigned char* lds; volatile LAS unsigned* MISC; gu32* ctl;
    int wave, vcu, G;
};
__device__ __forceinline__ void tr_item(const float* src, int ld, int k0, int nsrc0, bf16* dst, int Kdim, int ndst0, LAS float* scr, int lane) {
#pragma unroll 8
    for (int i = 0; i < 32; ++i) { const int kk = 2 * i + (lane >> 5); scr[kk * 33 + (lane & 31)] = src[(size_t)(k0 + kk) * ld + nsrc0 + (lane & 31)]; }
    LDS_WAIT(); asm volatile("" ::: "memory");
    const int c = lane & 7;
#pragma unroll
    for (int j = 0; j < 4; ++j) { const int n = (lane >> 3) + 8 * j; const LAS float* s = scr + (8 * c) * 33 + n;
        v4u o; o.x = pk2(s[0 * 33], s[1 * 33]); o.y = pk2(s[2 * 33], s[3 * 33]); o.z = pk2(s[4 * 33], s[5 * 33]); o.w = pk2(s[6 * 33], s[7 * 33]);
        *(GAS v4u*)(dst + (size_t)(ndst0 + n) * Kdim + k0 + 8 * c) = o; }
    LDS_WAIT(); asm volatile("" ::: "memory");
}
__device__ __forceinline__ int win_remap(int nd) { return nd < 3072 ? nd : (nd < 3584 ? nd + 1536 : (nd < 4096 ? nd + 512 : (nd < 5120 ? nd - 1024 : nd + 8))); }

template <bool ADD_MOE> __device__ __forceinline__ void p0_prologue(Frame& F, const Args& a, const int l, const float* xin) {
    const int LANE_ = lane_id(), TID_ = F.wave * 64 + LANE_; (void)TID_;
    LAS float* scr = (LAS float*)(F.lds + RING_OFF + F.wave * 16384);
    const int gw = F.vcu * NWAVES + F.wave, NGW = F.G * NWAVES;
    const float* w_in = (const float*)KARG(3) + (size_t)l * DM * PIN; const float* w_br = (const float*)KARG(8) + (size_t)l * 3 * 512 * 1024; const float* w_out = (const float*)KARG(9) + (size_t)l * DM * DM;
    bf16* WT_IN = (bf16*)(((unsigned char*)KARG(19)) + WS_WTIN); bf16* WT_BR = (bf16*)(((unsigned char*)KARG(19)) + WS_WTBR); bf16* WT_OUT = (bf16*)(((unsigned char*)KARG(19)) + WS_WTOUT);
    constexpr int I_IN = 16 * 256, I_BR = 3 * 256, I_OUT = 16 * 32, NITEMS = I_IN + I_BR + I_OUT;
    for (int it = gw; it < NITEMS; it += NGW) {
        int r = it;
        if (r < I_IN) { const int kb = r >> 8, nb = r & 255; tr_item(w_in, PIN, 64 * kb, win_remap(32 * nb), WT_IN, DM, 32 * nb, scr, LANE_); continue; } r -= I_IN;
        if (r < I_BR) { const int n = r >> 8, rr = r & 255, kb = rr >> 5, nb = rr & 31; tr_item(w_br + (size_t)n * 512 * 1024, 1024, 64 * kb, 32 * nb, WT_BR + (size_t)n * 1024 * 512, 512, 32 * nb, scr, LANE_); continue; } r -= I_BR;
        { const int kb = r >> 5, nb = r & 31; tr_item(w_out, 1024, 64 * kb, 32 * nb, WT_OUT, DM, 32 * nb, scr, LANE_); }
    }
    const float* g1 = (const float*)KARG(2) + l * DM; const float* gate_b = (const float*)KARG(7) + l * 8;
    bf16* XN = (bf16*)(((unsigned char*)KARG(19)) + WS_XN); float* IFPRE = (float*)(((unsigned char*)KARG(19)) + WS_IFPRE);
    for (int m = gw; m < M; m += NGW) {
        const GAS f32x4* xr = (const GAS f32x4*)(xin + (size_t)m * DM) + LANE_;
        f32x4 v[4]; float s = 0.f;
#pragma unroll
        for (int j = 0; j < 4; ++j) v[j] = xr[64 * j];
        if (ADD_MOE) {
            const GAS v2u* y0 = (const GAS v2u*)(((unsigned char*)KARG(19)) + WS_YP + (size_t)(2 * m) * 2048) + LANE_; const GAS v2u* y1 = (const GAS v2u*)(((unsigned char*)KARG(19)) + WS_YP + (size_t)(2 * m + 1) * 2048) + LANE_;
#pragma unroll
            for (int j = 0; j < 4; ++j) { const v2u p0 = y0[64 * j], p1 = y1[64 * j];
                v[j].x += __uint_as_float(p0.x << 16) + __uint_as_float(p1.x << 16); v[j].y += __uint_as_float(p0.x & 0xffff0000u) + __uint_as_float(p1.x & 0xffff0000u);
                v[j].z += __uint_as_float(p0.y << 16) + __uint_as_float(p1.y << 16); v[j].w += __uint_as_float(p0.y & 0xffff0000u) + __uint_as_float(p1.y & 0xffff0000u);
                ((GAS f32x4*)(((float*)KARG(18)) + (size_t)m * DM))[LANE_ + 64 * j] = v[j]; }
        }
#pragma unroll
        for (int j = 0; j < 4; ++j) s += (v[j].x * v[j].x + v[j].y * v[j].y) + (v[j].z * v[j].z + v[j].w * v[j].w);
#pragma unroll
        for (int o = 1; o < 64; o <<= 1) s += __shfl_xor(s, o);
        const float rs = rsqrtf(s * (1.f / DM) + RMS_EPS);
        float ip[8];
#pragma unroll
        for (int o = 0; o < 8; ++o) ip[o] = 0.f;
        GAS unsigned long long* o8 = (GAS unsigned long long*)(XN + (size_t)m * DM) + LANE_;
#pragma unroll
        for (int j = 0; j < 4; ++j) { const f32x4 gg = ((const GAS f32x4*)g1)[LANE_ + 64 * j]; v[j] = v[j] * rs * gg;
            o8[64 * j] = (unsigned long long)pk2(v[j].x, v[j].y) | ((unsigned long long)pk2(v[j].z, v[j].w) << 32);
#pragma unroll
            for (int u = 0; u < 4; ++u) { const int d = (LANE_ + 64 * j) * 4 + u; const float xv = v[j][u];
                const f32x4 wa = *(const GAS f32x4*)(w_in + (size_t)d * PIN + 5120), wb = *(const GAS f32x4*)(w_in + (size_t)d * PIN + 5124);
                ip[0] += xv * wa.x; ip[1] += xv * wa.y; ip[2] += xv * wa.z; ip[3] += xv * wa.w; ip[4] += xv * wb.x; ip[5] += xv * wb.y; ip[6] += xv * wb.z; ip[7] += xv * wb.w; } }
#pragma unroll
        for (int o = 0; o < 8; ++o) {
#pragma unroll
            for (int sft = 1; sft < 64; sft <<= 1) ip[o] += __shfl_xor(ip[o], sft); }
        float val = ip[0];
#pragma unroll
        for (int o = 1; o < 8; ++o) val = LANE_ == o ? ip[o] : val;
        if (LANE_ < 8) IFPRE[(size_t)m * 8 + LANE_] = val + gate_b[LANE_];
    }
}


__device__ __forceinline__ float dot64(const float (&q)[64], const bf16* p) {
    float z = 0.f;
#pragma unroll
    for (int i = 0; i < 8; ++i) { const uint4 v = ((const uint4*)p)[i];
        z += q[8 * i + 0] * __uint_as_float(v.x << 16) + q[8 * i + 1] * __uint_as_float(v.x & 0xffff0000u) + q[8 * i + 2] * __uint_as_float(v.y << 16) + q[8 * i + 3] * __uint_as_float(v.y & 0xffff0000u)
           + q[8 * i + 4] * __uint_as_float(v.z << 16) + q[8 * i + 5] * __uint_as_float(v.z & 0xffff0000u) + q[8 * i + 6] * __uint_as_float(v.w << 16) + q[8 * i + 7] * __uint_as_float(v.w & 0xffff0000u);
        asm volatile("" ::: "memory"); }
    return z;
}
__device__ __forceinline__ void axpy64(float (&acc)[64], float sc, float p, const bf16* vp) {
#pragma unroll
    for (int i = 0; i < 8; ++i) { const uint4 v = ((const uint4*)vp)[i];
        acc[8 * i + 0] = acc[8 * i + 0] * sc + p * __uint_as_float(v.x << 16); acc[8 * i + 1] = acc[8 * i + 1] * sc + p * __uint_as_float(v.x & 0xffff0000u);
        acc[8 * i + 2] = acc[8 * i + 2] * sc + p * __uint_as_float(v.y << 16); acc[8 * i + 3] = acc[8 * i + 3] * sc + p * __uint_as_float(v.y & 0xffff0000u);
        acc[8 * i + 4] = acc[8 * i + 4] * sc + p * __uint_as_float(v.z << 16); acc[8 * i + 5] = acc[8 * i + 5] * sc + p * __uint_as_float(v.z & 0xffff0000u);
        acc[8 * i + 6] = acc[8 * i + 6] * sc + p * __uint_as_float(v.w << 16); acc[8 * i + 7] = acc[8 * i + 7] * sc + p * __uint_as_float(v.w & 0xffff0000u);
        asm volatile("" ::: "memory"); }
}

__device__ __forceinline__ void ph_prep_qk(Frame& F, const Args& a, const int l) {
    const int LANE_ = lane_id(), TID_ = F.wave * 64 + LANE_; (void)TID_;
    bf16* mbq = (bf16*)(((unsigned char*)KARG(19)) + WS_MBQ); bf16* mbk = (bf16*)(((unsigned char*)KARG(19)) + WS_MBK);
    const float* qn_g = (const float*)KARG(4) + l * 64; const float* kn_g = (const float*)KARG(5) + l * 64; const int* positions = (const int*)KARG(1);
    for (int idx = blockIdx.x * 512 + TID_; idx < M * 16; idx += F.G * 512) {
        const int row = idx >> 4, hh = idx & 15, which = hh >> 3, h = hh & 7;
        bf16* p = (which ? mbk : mbq) + (size_t)row * 512 + h * 64; const float* g = which ? kn_g : qn_g;
        float x[64]; load64(p, x);
        float ss = 0.f;
#pragma unroll
        for (int i = 0; i < 64; ++i) ss += x[i] * x[i];
        const float r = rsqrtf(ss * (1.f / 64.f) + RMS_EPS);
#pragma unroll
        for (int i = 0; i < 64; ++i) x[i] = x[i] * r * g[i];
        const double pos = (double)positions[row];
        const double invf[8] = {1.0, 0.19392274474868576, 0.03760603093086393, 0.007292664737217109, 0.001414213562373095, 0.0002742481756762073, 5.318295896944988e-05, 1.031338537721246e-05};
#pragma unroll
        for (int i = 0; i < 8; ++i) {
            double rev = pos * invf[i] * 0.15915494309189535; rev -= floor(rev);
            const float fr = (float)rev; const float sn = __builtin_amdgcn_sinf(fr), cs = __builtin_amdgcn_cosf(fr);
            const float x1 = x[i], x2 = x[i + 8]; x[i] = x1 * cs - x2 * sn; x[i + 8] = x1 * sn + x2 * cs;
        }
        if (!which) {
#pragma unroll
            for (int i = 0; i < 64; ++i) x[i] *= C2;
        }
        store64(p, x);
    }
}
__device__ __forceinline__ void ph_conv(Frame& F, const Args& a, const int l) {
    const int LANE_ = lane_id(), TID_ = F.wave * 64 + LANE_; (void)TID_;
    const bf16* mlqk = (const bf16*)(((unsigned char*)KARG(19)) + WS_MLQK); const float* cw = (const float*)KARG(6) + l * 4 * 1024;
    bf16* q2 = (bf16*)(((unsigned char*)KARG(19)) + WS_MLQ2); bf16* k2 = (bf16*)(((unsigned char*)KARG(19)) + WS_MLK2);
    for (size_t idx = (size_t)blockIdx.x * 512 + TID_; idx < (size_t)M * 1024; idx += (size_t)F.G * 512) {
        const int c = (int)(idx & 1023), row = (int)(idx >> 10), t = row & (SEQ - 1);
        float y = 0.f;
#pragma unroll
        for (int j = 0; j < 4; ++j) { const int tt = t - 3 + j; if (tt >= 0) y += cw[j * 1024 + c] * bf2f(mlqk[(size_t)(row - 3 + j) * 1024 + c]); }
        y = y * sigmoidf_(y);
        if (c < 512) q2[(size_t)row * 512 + c] = (bf16)f2bf(y); else k2[(size_t)row * 512 + c - 512] = (bf16)f2bf(y * 0.08838834764831845f);
    }
}
__device__ __forceinline__ void ph_kmean(Frame& F, const Args& a) {
    const int LANE_ = lane_id(), TID_ = F.wave * 64 + LANE_; (void)TID_;
    const bf16* mbk = (const bf16*)(((unsigned char*)KARG(19)) + WS_MBK); float* kmean = (float*)(((unsigned char*)KARG(19)) + WS_KMEAN);
    for (int idx = blockIdx.x * 512 + TID_; idx < 8 * 8 * 8 * 64; idx += F.G * 512) {
        const int d = idx & 63, blk = (idx >> 6) & 7, h = (idx >> 9) & 7, b = idx >> 12;
        float s = 0.f;
        for (int i = 0; i < 256; ++i) s += bf2f(mbk[(size_t)(b * SEQ + blk * 256 + i) * 512 + h * 64 + d]);
        kmean[idx] = s * (1.f / 256.f);
    }
}
__device__ __forceinline__ void ph_sb_naive(Frame& F, const Args& a) {
    const int LANE_ = lane_id(), TID_ = F.wave * 64 + LANE_; (void)TID_;
    bf16* sbq = (bf16*)(((unsigned char*)KARG(19)) + WS_SBQ); const bf16* sbk = (const bf16*)(((unsigned char*)KARG(19)) + WS_SBK); const bf16* sbv = (const bf16*)(((unsigned char*)KARG(19)) + WS_SBV);
    for (int idx = blockIdx.x * 512 + TID_; idx < M * 8; idx += F.G * 512) {
        const int row = idx >> 3, h = idx & 7, t = row & (SEQ - 1), base = row - t;
        float q[64], acc[64]; load64(sbq + (size_t)row * 512 + h * 64, q);
#pragma unroll
        for (int i = 0; i < 64; ++i) acc[i] = 0.f;
        float C = 0.f;
        for (int s = t - 1; s >= 0; --s) {
            const float z = dot64(q, sbk + (size_t)(base + s) * 512 + h * 64);
            const float sp = z > 0.f ? z + __log2f(1.f + exp2f(-z)) : __log2f(1.f + exp2f(z));
            C += sp; const float w = exp2f(z - C);
            axpy64(acc, 1.f, w, sbv + (size_t)(base + s) * 512 + h * 64);
            if (C > 150.f) break;
        }
        store64(sbq + (size_t)row * 512 + h * 64, acc);
    }
}
__device__ __forceinline__ void ph_moba_naive(Frame& F, const Args& a) {
    const int LANE_ = lane_id(), TID_ = F.wave * 64 + LANE_; (void)TID_;
    bf16* mbq = (bf16*)(((unsigned char*)KARG(19)) + WS_MBQ); const bf16* mbk = (const bf16*)(((unsigned char*)KARG(19)) + WS_MBK); const bf16* mbv = (const bf16*)(((unsigned char*)KARG(19)) + WS_MBV); const float* kmean = (const float*)(((unsigned char*)KARG(19)) + WS_KMEAN);
    for (int idx = blockIdx.x * 512 + TID_; idx < M * 8; idx += F.G * 512) {
        const int row = idx >> 3, h = idx & 7, t = row & (SEQ - 1), base = row - t, b = row >> 11, own = t >> 8;
        float q[64], acc[64]; load64(mbq + (size_t)row * 512 + h * 64, q);
#pragma unroll
        for (int i = 0; i < 64; ++i) acc[i] = 0.f;
        unsigned sel = 0u;
        {
            float g[8];
#pragma unroll
            for (int blk = 0; blk < 8; ++blk) { float s = 0.f; const float* km = kmean + ((size_t)(b * 8 + h) * 8 + blk) * 64;
#pragma unroll
                for (int i = 0; i < 64; ++i) s += q[i] * km[i];
                g[blk] = blk < own ? s : -INFINITY; }
#pragma unroll
            for (int r = 0; r < 3; ++r) { float best = -INFINITY; int bi = -1;
#pragma unroll
                for (int blk = 0; blk < 8; ++blk) { const bool ok = !((sel >> blk) & 1u) && g[blk] > best; if (ok) { best = g[blk]; bi = blk; } }
                if (bi >= 0) sel |= 1u << bi; }
        }
        sel |= 1u << own;
        float m = -INFINITY, lsum = 0.f;
        for (int blk = 0; blk <= own; ++blk) {
            if (!((sel >> blk) & 1u)) continue;
            const int s1 = blk == own ? t : blk * 256 + 255;
            for (int s = blk * 256; s <= s1; ++s) {
                const float z = dot64(q, mbk + (size_t)(base + s) * 512 + h * 64);
                const float mn = fmaxf(m, z), sc = exp2f(m - mn), p = exp2f(z - mn);
                lsum = lsum * sc + p;
                axpy64(acc, sc, p, mbv + (size_t)(base + s) * 512 + h * 64);
                m = mn;
            }
        }
        const float il = 1.f / lsum;
#pragma unroll
        for (int i = 0; i < 64; ++i) acc[i] *= il;
        store64(mbq + (size_t)row * 512 + h * 64, acc);
    }
}
__device__ __forceinline__ void ph_mlstm_naive(Frame& F, const Args& a) {
    const int LANE_ = lane_id(), TID_ = F.wave * 64 + LANE_; (void)TID_;
    const bf16* q2 = (const bf16*)(((unsigned char*)KARG(19)) + WS_MLQ2); const bf16* k2 = (const bf16*)(((unsigned char*)KARG(19)) + WS_MLK2); const bf16* mlv = (const bf16*)(((unsigned char*)KARG(19)) + WS_MLV); bf16* mlo = (bf16*)(((unsigned char*)KARG(19)) + WS_MLO);
    const float* ifpre = (const float*)(((unsigned char*)KARG(19)) + WS_IFPRE);
    for (int unit = blockIdx.x; unit < 32; unit += F.G) {
        const int b = unit >> 2, h = unit & 3, tid = TID_, e = tid >> 2, dq = tid & 3;
        float Cst[32], nst[32];
#pragma unroll
        for (int j = 0; j < 32; ++j) { Cst[j] = 0.f; nst[j] = 0.f; }
        float m = 0.f;
        for (int t = 0; t < SEQ; ++t) {
            const size_t row = (size_t)b * SEQ + t;
            const float li = ifpre[row * 8 + h], fp = ifpre[row * 8 + 4 + h];
            const float lf = fp >= 0.f ? -log1pf(__expf(-fp)) : fp - log1pf(__expf(fp));
            const float mn = fmaxf(lf + m, li), fd = __expf(lf + m - mn), ii = __expf(li - mn); m = mn;
            const bf16* kp = k2 + row * 512 + h * 128 + dq * 32; const bf16* qp = q2 + row * 512 + h * 128 + dq * 32;
            const float ve = bf2f(mlv[row * 512 + h * 128 + e]) * ii;
            float num = 0.f, den = 0.f;
#pragma unroll
            for (int c4 = 0; c4 < 4; ++c4) {
                const uint4 kv = ((const uint4*)kp)[c4], qv = ((const uint4*)qp)[c4];
                const unsigned ku[4] = {kv.x, kv.y, kv.z, kv.w}, qu[4] = {qv.x, qv.y, qv.z, qv.w};
#pragma unroll
                for (int u = 0; u < 4; ++u) {
                    const float k0 = __uint_as_float(ku[u] << 16), k1 = __uint_as_float(ku[u] & 0xffff0000u), q0 = __uint_as_float(qu[u] << 16), q1 = __uint_as_float(qu[u] & 0xffff0000u);
                    const int j = c4 * 8 + u * 2;
                    Cst[j] = fd * Cst[j] + ve * k0; Cst[j + 1] = fd * Cst[j + 1] + ve * k1;
                    nst[j] = fd * nst[j] + ii * k0; nst[j + 1] = fd * nst[j + 1] + ii * k1;
                    num += Cst[j] * q0 + Cst[j + 1] * q1; den += nst[j] * q0 + nst[j + 1] * q1;
                }
            }
            num += __shfl_xor(num, 1); num += __shfl_xor(num, 2); den += __shfl_xor(den, 1); den += __shfl_xor(den, 2);
            const float o = num / fmaxf(fabsf(den), __expf(-m));
            if (dq == 0) { bf16* op = mlo + row * 512 + h * 128 + e; *op = (bf16)f2bf(o * sigmoidf_(bf2f(*op))); }
        }
    }
}
__device__ __forceinline__ void ph_router(Frame& F, const Args& a, const int l) {
    const int LANE_ = lane_id(), TID_ = F.wave * 64 + LANE_; (void)TID_;
    const float* hin = ((float*)KARG(18)); const float* g2 = (const float*)KARG(10) + l * DM; const float* w_rg = (const float*)KARG(11) + (size_t)l * DM * 4; const float* b_rg = (const float*)KARG(12) + l * 4;
    const float* w_re = (const float*)KARG(13) + (size_t)l * DM * 32; const float* b_re = (const float*)KARG(14) + l * 32;
    bf16* xn2 = (bf16*)(((unsigned char*)KARG(19)) + WS_XN2); int* re = (int*)(((unsigned char*)KARG(19)) + WS_RE); float* rw = (float*)(((unsigned char*)KARG(19)) + WS_RW); int* rank = (int*)(((unsigned char*)KARG(19)) + WS_RANK); unsigned* cnt = (unsigned*)(F.ctl + CW_CNT + 64 * l);
    const int lane = LANE_, r8 = lane >> 3, part = lane & 7, gw = F.vcu * NWAVES + F.wave, NGW = F.G * NWAVES;
    for (int grp = gw; grp < M / 8; grp += NGW) {
        const int row = grp * 8 + r8;
        const float* xp = hin + (size_t)row * DM + 4 * part; const float* gp = g2 + 4 * part; const float* wgp = w_rg + (size_t)(4 * part) * 4; const float* wep = w_re + (size_t)(4 * part) * 32;
        float lg[36]; float ss = 0.f;
#pragma unroll
        for (int o = 0; o < 36; ++o) lg[o] = 0.f;
#pragma unroll 1
        for (int c = 0; c < 32; ++c) {
            const f32x4 x4 = *(const GAS f32x4*)(xp + 32 * c), g4 = *(const GAS f32x4*)(gp + 32 * c);
            ss += (x4.x * x4.x + x4.y * x4.y) + (x4.z * x4.z + x4.w * x4.w);
            const f32x4 xg = x4 * g4;
#pragma unroll
            for (int u = 0; u < 4; ++u) { const float xv = xg[u];
                const f32x4 wg = *(const GAS f32x4*)(wgp + (size_t)(32 * c + u) * 4); lg[0] += xv * wg.x; lg[1] += xv * wg.y; lg[2] += xv * wg.z; lg[3] += xv * wg.w;
#pragma unroll
                for (int o4 = 0; o4 < 8; ++o4) { const f32x4 we = *(const GAS f32x4*)(wep + (size_t)(32 * c + u) * 32 + o4 * 4);
                    lg[4 + o4 * 4] += xv * we.x; lg[5 + o4 * 4] += xv * we.y; lg[6 + o4 * 4] += xv * we.z; lg[7 + o4 * 4] += xv * we.w; } }
        }
        ss += __shfl_xor(ss, 1); ss += __shfl_xor(ss, 2); ss += __shfl_xor(ss, 4);
        const float r = rsqrtf(ss * (1.f / DM) + RMS_EPS);
#pragma unroll
        for (int o = 0; o < 36; ++o) { float v = lg[o]; v += __shfl_xor(v, 1); v += __shfl_xor(v, 2); v += __shfl_xor(v, 4); lg[o] = v * r; }
        bf16* op = xn2 + (size_t)row * DM + 4 * part;
#pragma unroll 1
        for (int c = 0; c < 32; ++c) {
            const f32x4 x4 = *(const GAS f32x4*)(xp + 32 * c), g4 = *(const GAS f32x4*)(gp + 32 * c); const f32x4 y = x4 * g4 * r;
            *(GAS unsigned long long*)(op + 32 * c) = (unsigned long long)pk2(y.x, y.y) | ((unsigned long long)pk2(y.z, y.w) << 32);
        }
        float gm = -INFINITY; int gi = 0; float gl[4];
#pragma unroll
        for (int i = 0; i < 4; ++i) { gl[i] = lg[i] + b_rg[i]; if (gl[i] > gm) { gm = gl[i]; gi = i; } }
        float gs = 0.f;
#pragma unroll
        for (int i = 0; i < 4; ++i) gs += __expf(gl[i] - gm);
        const float gwt = 1.f / gs;
        float el[8];
#pragma unroll
        for (int j = 0; j < 8; ++j) { const float a0 = lg[4 + j] + b_re[j], a1 = lg[12 + j] + b_re[8 + j], a2 = lg[20 + j] + b_re[16 + j], a3 = lg[28 + j] + b_re[24 + j];
            el[j] = gi == 0 ? a0 : (gi == 1 ? a1 : (gi == 2 ? a2 : a3)); }
        float m1 = -INFINITY; int i1 = 0;
#pragma unroll
        for (int j = 0; j < 8; ++j) if (el[j] > m1) { m1 = el[j]; i1 = j; }
        float m2 = -INFINITY; int i2 = 0;
#pragma unroll
        for (int j = 0; j < 8; ++j) if (j != i1 && el[j] > m2) { m2 = el[j]; i2 = j; }
        const float p2 = __expf(m2 - m1);
        const float w1 = gwt / (1.f + p2), w2 = gwt * p2 / (1.f + p2);
        if (part == 0) { const int ea = gi * 8 + i1, eb = gi * 8 + i2; re[row * 2] = ea; re[row * 2 + 1] = eb; rw[row * 2] = w1; rw[row * 2 + 1] = w2;
            rank[row * 2] = (int)__hip_atomic_fetch_add(cnt + ea, 1u, __ATOMIC_RELAXED, __HIP_MEMORY_SCOPE_AGENT); rank[row * 2 + 1] = (int)__hip_atomic_fetch_add(cnt + eb, 1u, __ATOMIC_RELAXED, __HIP_MEMORY_SCOPE_AGENT); }
    }
}
__device__ __forceinline__ void ph_moe_weights(Frame& F, const Args& a, const int l) {
    const int LANE_ = lane_id(), TID_ = F.wave * 64 + LANE_; (void)TID_;
    LAS float* scr = (LAS float*)(F.lds + RING_OFF + F.wave * 16384);
    const int gw = F.vcu * NWAVES + F.wave, NGW = F.G * NWAVES;
    const float* w1 = (const float*)KARG(15) + (size_t)l * 32 * 1024 * 256; const float* w3 = (const float*)KARG(16) + (size_t)l * 32 * 1024 * 256; const float* w2 = (const float*)KARG(17) + (size_t)l * 32 * 256 * 1024;
    bf16* WT13 = (bf16*)(((unsigned char*)KARG(19)) + WS_WT13); bf16* WT2 = (bf16*)(((unsigned char*)KARG(19)) + WS_WT2);
    constexpr int I_13 = 32 * 2 * 128, I_2 = 32 * 128;
    for (int it = gw; it < I_13 + I_2; it += NGW) {
        if (it < I_13) { const int e = it >> 8, which = (it >> 7) & 1, rr = it & 127, kb = rr >> 3, nb = rr & 7, f0 = 32 * nb;
            tr_item((which ? w3 : w1) + (size_t)e * 1024 * 256, 256, 64 * kb, f0, WT13 + (size_t)e * 512 * 1024, 1024, (f0 >> 7) * 256 + which * 128 + (f0 & 127), scr, LANE_); }
        else { const int r = it - I_13, e = r >> 7, rr = r & 127, kb = rr >> 5, nb = rr & 31;
            tr_item(w2 + (size_t)e * 256 * 1024, 1024, 64 * kb, 32 * nb, WT2 + (size_t)e * 1024 * 256, 256, 32 * nb, scr, LANE_); }
    }
}
constexpr int MOE_TAB_OFF = LDSCTL_OFF + 1024;
__device__ __forceinline__ void moe_tables(Frame& F, const int l) {
    const int LANE_ = lane_id(), TID_ = F.wave * 64 + LANE_; (void)TID_;
    LAS int* tab = (LAS int*)(F.lds + MOE_TAB_OFF);
    if (F.wave == 0) {
        const int e = LANE_ & 31; const int c = (int)__hip_atomic_load(F.ctl + CW_CNT + 64 * l + e, RLX_AGENT); const int np = (c + 255) >> 8;
        int inc = np;
#pragma unroll
        for (int o = 1; o < 32; o <<= 1) { const int t = __shfl_up(inc, o); if ((LANE_ & 31) >= o) inc += t; }
        const int seg = inc - np;
        if (LANE_ < 32) { tab[32 + e] = seg; for (int j = 0; j < np; ++j) { tab[64 + seg + j] = e; const int rem = c - 256 * j; tab[256 + seg + j] = rem < 256 ? rem : 256; } }
        if (LANE_ == 31) tab[0] = inc;
    }
    LDS_WAIT(); __syncthreads();
}
__device__ __forceinline__ void ph_moe_gather(Frame& F, const Args& a, const int l) {
    const int LANE_ = lane_id(), TID_ = F.wave * 64 + LANE_; (void)TID_;
    moe_tables(F, l);
    const LAS int* tab = (const LAS int*)(F.lds + MOE_TAB_OFF);
    const int* re = (const int*)(((unsigned char*)KARG(19)) + WS_RE); const float* rw = (const float*)(((unsigned char*)KARG(19)) + WS_RW); const int* rank = (const int*)(((unsigned char*)KARG(19)) + WS_RANK);
    int* spair = (int*)(((unsigned char*)KARG(19)) + WS_SPAIR); float* sw = (float*)(((unsigned char*)KARG(19)) + WS_SW);
    const int gw = F.vcu * NWAVES + F.wave, NGW = F.G * NWAVES;
    for (int p = gw; p < 2 * M; p += NGW) {
        const int e = re[p]; const int slot = tab[32 + e] * 256 + rank[p];
        const GAS v4u* src = (const GAS v4u*)(((unsigned char*)KARG(19)) + WS_XN2 + (size_t)(p >> 1) * 2048); GAS v4u* dst = (GAS v4u*)(((unsigned char*)KARG(19)) + WS_XS + (size_t)slot * 2048);
        const v4u v0 = src[LANE_], v1 = src[LANE_ + 64]; dst[LANE_] = v0; dst[LANE_ + 64] = v1;
        if (LANE_ == 0) { spair[slot] = p; sw[slot] = rw[p]; }
    }
}
__device__ __forceinline__ void ph_final(Frame& F, const Args& a) {
    const int LANE_ = lane_id(), TID_ = F.wave * 64 + LANE_; (void)TID_;
    const int gw = F.vcu * NWAVES + F.wave, NGW = F.G * NWAVES;
    for (int m = gw; m < M; m += NGW) {
        GAS f32x4* xr = (GAS f32x4*)(((float*)KARG(18)) + (size_t)m * DM) + LANE_;
        const GAS v2u* y0 = (const GAS v2u*)(((unsigned char*)KARG(19)) + WS_YP + (size_t)(2 * m) * 2048) + LANE_; const GAS v2u* y1 = (const GAS v2u*)(((unsigned char*)KARG(19)) + WS_YP + (size_t)(2 * m + 1) * 2048) + LANE_;
#pragma unroll
        for (int j = 0; j < 4; ++j) { f32x4 v = xr[64 * j]; const v2u p0 = y0[64 * j], p1 = y1[64 * j];
            v.x += __uint_as_float(p0.x << 16) + __uint_as_float(p1.x << 16); v.y += __uint_as_float(p0.x & 0xffff0000u) + __uint_as_float(p1.x & 0xffff0000u);
            v.z += __uint_as_float(p0.y << 16) + __uint_as_float(p1.y << 16); v.w += __uint_as_float(p0.y & 0xffff0000u) + __uint_as_float(p1.y & 0xffff0000u);
            xr[64 * j] = v; }
    }
}
namespace ml {
typedef short bf16x8 __attribute__((ext_vector_type(8)));
typedef short s16x4 __attribute__((ext_vector_type(4)));
typedef float f32x16 __attribute__((ext_vector_type(16)));
typedef float f32x4v __attribute__((ext_vector_type(4)));
constexpr int TS = 272;
constexpr int OFF_Q = 0, OFF_K = 64 * TS, OFF_V = 2 * 64 * TS, OFF_SC = 3 * 64 * TS, OFF_N = OFF_SC + 1280;
__device__ __forceinline__ int crow(int r, int hi) { return (r & 3) + 8 * (r >> 2) + 4 * hi; }
__device__ __forceinline__ s16x4 trd(const LAS unsigned char* p) { return __builtin_bit_cast(s16x4, __builtin_amdgcn_ds_read_tr16_b64_v4i16((LAS s16x4*)p)); }
__device__ __forceinline__ bf16x8 cat8(s16x4 a, s16x4 b) { return (bf16x8){a[0], a[1], a[2], a[3], b[0], b[1], b[2], b[3]}; }
__device__ __forceinline__ float bfv(short v) { return __uint_as_float((unsigned)(unsigned short)v << 16); }
__device__ __forceinline__ bf16x8 scale8(bf16x8 v, const float (&w)[8]) {
    const unsigned a = pk2(bfv(v[0]) * w[0], bfv(v[1]) * w[1]), b = pk2(bfv(v[2]) * w[2], bfv(v[3]) * w[3]), c = pk2(bfv(v[4]) * w[4], bfv(v[5]) * w[5]), d = pk2(bfv(v[6]) * w[6], bfv(v[7]) * w[7]);
    return __builtin_bit_cast(bf16x8, (v4u){a, b, c, d});
}
__device__ __forceinline__ void stage_tile(LAS unsigned char* dst, const bf16* src, int tid) {
    const int row = tid >> 3, piece = tid & 7; const GAS v4u* s = (const GAS v4u*)(src + (size_t)row * 512 + piece * 16); const v4u a = s[0], b = s[1];
    *(LAS v4u*)(dst + row * TS + piece * 32) = a; *(LAS v4u*)(dst + row * TS + piece * 32 + 16) = b;
}
__device__ __forceinline__ float swap_add(float v) { auto rr = __builtin_amdgcn_permlane32_swap(__float_as_uint(v), __float_as_uint(v), false, false); return __uint_as_float(rr[0]) + __uint_as_float(rr[1]); }
}

__device__ __forceinline__ void ph_ml_scalars(Frame& F, unsigned char* ws) {
    const int lane = lane_id(), gw = F.vcu * NWAVES + F.wave;
    if (gw >= 32) return;
    const int bh = gw, b = bh >> 2, h = bh & 3;
    const float* ifpre = (const float*)(ws + WS_IFPRE); ml::f32x4v* scal = (ml::f32x4v*)(ws + WS_MLSCAL); float* wk = (float*)(ws + WS_MLWK); float* dec = (float*)(ws + WS_MLDEC);
    float m = 0.f;
    for (int c = 0; c < 32; ++c) {
        const size_t row = (size_t)b * SEQ + c * 64 + lane;
        const float li = ifpre[row * 8 + h], fp = ifpre[row * 8 + 4 + h];
        const float lf = fp >= 0.f ? -log1pf(__expf(-fp)) : fp - log1pf(__expf(fp));
        float bc = lf;
#pragma unroll
        for (int o = 1; o < 64; o <<= 1) { const float t = __shfl_up(bc, o); if (lane >= o) bc += t; }
        const float a = li - bc; float A = a;
#pragma unroll
        for (int o = 1; o < 64; o <<= 1) { const float t = __shfl_up(A, o); if (lane >= o) A = fmaxf(A, t); }
        const float Mx = fmaxf(m, A), MxL = __shfl(Mx, 63), bL = __shfl(bc, 63);
        scal[(size_t)bh * SEQ + c * 64 + lane] = (ml::f32x4v){a, Mx, __expf(m - Mx), __expf(-(bc + Mx))};
        wk[(size_t)bh * SEQ + c * 64 + lane] = __expf(a - MxL);
        if (lane == 0) dec[bh * 32 + c] = __expf(m - MxL);
        m = bL + MxL;
    }
}
__device__ __forceinline__ void ph_ml_state(Frame& F, unsigned char* ws) {
    const int lane = lane_id(), tid = F.wave * 64 + lane, wave = F.wave;
    LAS unsigned char* lds = F.lds; LAS float* sWk = (LAS float*)(lds + ml::OFF_SC + 1024);
    const bf16* K2 = (const bf16*)(ws + WS_MLK2); const bf16* V = (const bf16*)(ws + WS_MLV); const float* wkg = (const float*)(ws + WS_MLWK);
    bf16* cst = (bf16*)(ws + WS_MLCST); float* dn = (float*)(ws + WS_MLDN);
    const int r32 = lane & 31, hi = lane >> 5, q4 = (lane & 15) >> 2, p4 = lane & 3, blk = (lane >> 4) & 1, db = wave & 3, eh = wave >> 2;
    for (int u = F.vcu; u < 32 * 31; u += F.G) {
        const int bh = u / 31, c = u - bh * 31, b = bh >> 2, h = bh & 3; const size_t row0 = (size_t)b * SEQ + c * 64;
        ml::stage_tile(lds + ml::OFF_K, K2 + row0 * 512 + h * 128, tid); ml::stage_tile(lds + ml::OFF_V, V + row0 * 512 + h * 128, tid);
        if (tid < 64) sWk[tid] = wkg[(size_t)bh * SEQ + c * 64 + tid];
        LDS_WAIT(); __syncthreads();
        if (tid < 128) { float s = 0.f;
            for (int ss = 0; ss < 64; ++ss) s += sWk[ss] * bf2f(*(const LAS bf16*)(lds + ml::OFF_K + ss * ml::TS + tid * 2));
            dn[(size_t)(bh * 32 + c) * 128 + tid] = s; }
        ml::f32x16 acc0 = {}, acc1 = {};
#pragma unroll
        for (int ks = 0; ks < 4; ++ks) {
            const int rowb = 16 * ks + 8 * hi + q4, colb = (16 * blk + 4 * p4) * 2;
            const ml::bf16x8 Af = ml::cat8(ml::trd(lds + ml::OFF_K + rowb * ml::TS + 64 * db + colb), ml::trd(lds + ml::OFF_K + (rowb + 4) * ml::TS + 64 * db + colb));
            float w[8]; { const ml::f32x4v w0 = *(const LAS ml::f32x4v*)(sWk + 16 * ks + 8 * hi), w1 = *(const LAS ml::f32x4v*)(sWk + 16 * ks + 8 * hi + 4);
                w[0] = w0[0]; w[1] = w0[1]; w[2] = w0[2]; w[3] = w0[3]; w[4] = w1[0]; w[5] = w1[1]; w[6] = w1[2]; w[7] = w1[3]; }
            const ml::bf16x8 B0 = ml::scale8(ml::cat8(ml::trd(lds + ml::OFF_V + rowb * ml::TS + 64 * (2 * eh) + colb), ml::trd(lds + ml::OFF_V + (rowb + 4) * ml::TS + 64 * (2 * eh) + colb)), w);
            const ml::bf16x8 B1 = ml::scale8(ml::cat8(ml::trd(lds + ml::OFF_V + rowb * ml::TS + 64 * (2 * eh + 1) + colb), ml::trd(lds + ml::OFF_V + (rowb + 4) * ml::TS + 64 * (2 * eh + 1) + colb)), w);
            acc0 = __builtin_amdgcn_mfma_f32_32x32x16_bf16(Af, B0, acc0, 0, 0, 0); acc1 = __builtin_amdgcn_mfma_f32_32x32x16_bf16(Af, B1, acc1, 0, 0, 0);
        }
        bf16* cb = cst + (size_t)(bh * 32 + c) * 128 * 128;
#pragma unroll
        for (int g = 0; g < 4; ++g) { const int d0 = 32 * db + 8 * g + 4 * hi;
            *(GAS unsigned long long*)(cb + (size_t)(32 * (2 * eh) + r32) * 128 + d0) = (unsigned long long)pk2(acc0[4 * g], acc0[4 * g + 1]) | ((unsigned long long)pk2(acc0[4 * g + 2], acc0[4 * g + 3]) << 32);
            *(GAS unsigned long long*)(cb + (size_t)(32 * (2 * eh + 1) + r32) * 128 + d0) = (unsigned long long)pk2(acc1[4 * g], acc1[4 * g + 1]) | ((unsigned long long)pk2(acc1[4 * g + 2], acc1[4 * g + 3]) << 32); }
        LDS_WAIT(); __syncthreads();
    }
}
__device__ __forceinline__ void ph_ml_scan(Frame& F, unsigned char* ws) {
    const int lane = lane_id(), tid = F.wave * 64 + lane;
    bf16* cst = (bf16*)(ws + WS_MLCST); float* dn = (float*)(ws + WS_MLDN); const float* dec = (const float*)(ws + WS_MLDEC);
    for (int idx = blockIdx.x * 512 + tid; idx < 32 * 2048 + 32 * 128; idx += F.G * 512) {
        if (idx < 32 * 2048) { const int bh = idx >> 11, off = (idx & 2047) * 8; float acc[8];
#pragma unroll
            for (int j = 0; j < 8; ++j) acc[j] = 0.f;
#pragma unroll 4
            for (int c = 0; c < 31; ++c) { const float dc = dec[bh * 32 + c]; GAS v4u* p = (GAS v4u*)(cst + (size_t)(bh * 32 + c) * 16384 + off); const v4u v = *p;
                acc[0] = dc * acc[0] + __uint_as_float(v.x << 16); acc[1] = dc * acc[1] + __uint_as_float(v.x & 0xffff0000u); acc[2] = dc * acc[2] + __uint_as_float(v.y << 16); acc[3] = dc * acc[3] + __uint_as_float(v.y & 0xffff0000u);
                acc[4] = dc * acc[4] + __uint_as_float(v.z << 16); acc[5] = dc * acc[5] + __uint_as_float(v.z & 0xffff0000u); acc[6] = dc * acc[6] + __uint_as_float(v.w << 16); acc[7] = dc * acc[7] + __uint_as_float(v.w & 0xffff0000u);
                v4u o; o.x = pk2(acc[0], acc[1]); o.y = pk2(acc[2], acc[3]); o.z = pk2(acc[4], acc[5]); o.w = pk2(acc[6], acc[7]); *p = o; } }
        else { const int r = idx - 32 * 2048, bh = r >> 7, d = r & 127; float n = 0.f;
            for (int c = 0; c < 31; ++c) { float* p = dn + (size_t)(bh * 32 + c) * 128 + d; n = dec[bh * 32 + c] * n + *p; *p = n; } }
    }
}
__device__ __forceinline__ void ph_ml_out(Frame& F, unsigned char* ws) {
    const int lane = lane_id(), tid = F.wave * 64 + lane, wave = F.wave;
    LAS unsigned char* lds = F.lds; LAS float* sA = (LAS float*)(lds + ml::OFF_SC); LAS float* sMx = sA + 64; LAS float* sWi = sA + 128; LAS float* sEm = sA + 192; LAS float* sN = (LAS float*)(lds + ml::OFF_N);
    const bf16* Q2 = (const bf16*)(ws + WS_MLQ2); const bf16* K2 = (const bf16*)(ws + WS_MLK2); const bf16* V = (const bf16*)(ws + WS_MLV); bf16* mlo = (bf16*)(ws + WS_MLO);
    const bf16* cst = (const bf16*)(ws + WS_MLCST); const float* nst = (const float*)(ws + WS_MLDN); const ml::f32x4v* scal = (const ml::f32x4v*)(ws + WS_MLSCAL);
    const int r32 = lane & 31, hi = lane >> 5, q4 = (lane & 15) >> 2, p4 = lane & 3, blk = (lane >> 4) & 1, eb = wave >> 1, tb = wave & 1, t = 32 * tb + r32;
    for (int u = F.vcu; u < 1024; u += F.G) {
        const int bh = u >> 5, c = u & 31, b = bh >> 2, h = bh & 3; const size_t row0 = (size_t)b * SEQ + c * 64;
        ml::stage_tile(lds + ml::OFF_Q, Q2 + row0 * 512 + h * 128, tid); ml::stage_tile(lds + ml::OFF_K, K2 + row0 * 512 + h * 128, tid); ml::stage_tile(lds + ml::OFF_V, V + row0 * 512 + h * 128, tid);
        if (tid < 64) { const ml::f32x4v s4 = scal[(size_t)bh * SEQ + c * 64 + tid]; sA[tid] = s4[0]; sMx[tid] = s4[1]; sWi[tid] = s4[2]; sEm[tid] = s4[3]; }
        if (tid >= 64 && tid < 192) sN[tid - 64] = c > 0 ? nst[(size_t)(bh * 32 + c - 1) * 128 + tid - 64] : 0.f;
        LDS_WAIT(); __syncthreads();
        ml::f32x16 S0 = {}, S1 = {}; ml::bf16x8 qf[8]; float dni = 0.f;
#pragma unroll
        for (int ks = 0; ks < 8; ++ks) {
            qf[ks] = *(const LAS ml::bf16x8*)(lds + ml::OFF_Q + t * ml::TS + (16 * ks + 8 * hi) * 2);
            const ml::bf16x8 a0 = *(const LAS ml::bf16x8*)(lds + ml::OFF_K + r32 * ml::TS + (16 * ks + 8 * hi) * 2), a1 = *(const LAS ml::bf16x8*)(lds + ml::OFF_K + (32 + r32) * ml::TS + (16 * ks + 8 * hi) * 2);
            S0 = __builtin_amdgcn_mfma_f32_32x32x16_bf16(a0, qf[ks], S0, 0, 0, 0); S1 = __builtin_amdgcn_mfma_f32_32x32x16_bf16(a1, qf[ks], S1, 0, 0, 0);
            const ml::f32x4v n0 = *(const LAS ml::f32x4v*)(sN + 16 * ks + 8 * hi), n1 = *(const LAS ml::f32x4v*)(sN + 16 * ks + 8 * hi + 4);
            dni += ml::bfv(qf[ks][0]) * n0[0] + ml::bfv(qf[ks][1]) * n0[1] + ml::bfv(qf[ks][2]) * n0[2] + ml::bfv(qf[ks][3]) * n0[3] + ml::bfv(qf[ks][4]) * n1[0] + ml::bfv(qf[ks][5]) * n1[1] + ml::bfv(qf[ks][6]) * n1[2] + ml::bfv(qf[ks][7]) * n1[3];
        }
        const float Mxt = sMx[t], wit = sWi[t], emt = sEm[t]; float den = 0.f;
#pragma unroll
        for (int r = 0; r < 16; ++r) { const int s0 = ml::crow(r, hi), s1 = 32 + s0;
            const float w0 = s0 <= t ? __expf(sA[s0] - Mxt) : 0.f, w1 = s1 <= t ? __expf(sA[s1] - Mxt) : 0.f;
            S0[r] *= w0; S1[r] *= w1; den += S0[r] + S1[r]; }
        den = ml::swap_add(den) + wit * ml::swap_add(dni);
        ml::bf16x8 pf[4];
        pf[0] = __builtin_bit_cast(ml::bf16x8, (v4u){pk2(S0[0], S0[1]), pk2(S0[2], S0[3]), pk2(S0[4], S0[5]), pk2(S0[6], S0[7])});
        pf[1] = __builtin_bit_cast(ml::bf16x8, (v4u){pk2(S0[8], S0[9]), pk2(S0[10], S0[11]), pk2(S0[12], S0[13]), pk2(S0[14], S0[15])});
        pf[2] = __builtin_bit_cast(ml::bf16x8, (v4u){pk2(S1[0], S1[1]), pk2(S1[2], S1[3]), pk2(S1[4], S1[5]), pk2(S1[6], S1[7])});
        pf[3] = __builtin_bit_cast(ml::bf16x8, (v4u){pk2(S1[8], S1[9]), pk2(S1[10], S1[11]), pk2(S1[12], S1[13]), pk2(S1[14], S1[15])});
        ml::f32x16 O = {};
#pragma unroll
        for (int kk = 0; kk < 4; ++kk) {
            const int rowb = 16 * kk + 4 * hi + q4, colb = (32 * eb + 16 * blk + 4 * p4) * 2;
            const ml::bf16x8 Av = ml::cat8(ml::trd(lds + ml::OFF_V + rowb * ml::TS + colb), ml::trd(lds + ml::OFF_V + (rowb + 8) * ml::TS + colb));
            O = __builtin_amdgcn_mfma_f32_32x32x16_bf16(Av, pf[kk], O, 0, 0, 0);
        }
        if (c > 0) {
            const bf16* cp = cst + (size_t)(bh * 32 + c - 1) * 16384 + (size_t)(32 * eb + r32) * 128 + 8 * hi;
            float wv[8];
#pragma unroll
            for (int j = 0; j < 8; ++j) wv[j] = wit;
#pragma unroll
            for (int ks = 0; ks < 8; ++ks) { const ml::bf16x8 Ac = *(const GAS ml::bf16x8*)(cp + 16 * ks);
                O = __builtin_amdgcn_mfma_f32_32x32x16_bf16(Ac, ml::scale8(qf[ks], wv), O, 0, 0, 0); }
        }
        const float inv = 1.0f / fmaxf(fabsf(den), emt);
        bf16* op = mlo + (row0 + t) * 512 + h * 128 + 32 * eb + 4 * hi;
#pragma unroll
        for (int g = 0; g < 4; ++g) { GAS v2u* pp = (GAS v2u*)(op + 8 * g); const v2u ov = *pp;
            const float y0 = O[4 * g] * inv * sigmoidf_(__uint_as_float(ov.x << 16)), y1 = O[4 * g + 1] * inv * sigmoidf_(__uint_as_float(ov.x & 0xffff0000u));
            const float y2 = O[4 * g + 2] * inv * sigmoidf_(__uint_as_float(ov.y << 16)), y3 = O[4 * g + 3] * inv * sigmoidf_(__uint_as_float(ov.y & 0xffff0000u));
            v2u o2; o2.x = pk2(y0, y1); o2.y = pk2(y2, y3); *pp = o2; }
        LDS_WAIT(); __syncthreads();
    }
}

constexpr int NPH = 12;
template <int l> __device__ __forceinline__ void layer_body(Frame& F, const Args& args, const XcdBarrier& bar, const int plo, const int phi) {
    const int LANE_ = lane_id(), TID_ = F.wave * 64 + LANE_; (void)TID_;
    unsigned char* ws = ((unsigned char*)KARG(19));
        const int lo = plo - l * NPH, hi = phi - l * NPH;
#define IN(k) (lo <= (k) && (k) < hi)
#define SEAM(k) do { if ((k) + 1 + l * NPH < phi) xcd_barrier(bar); } while (0)
        const float* xin = l == 0 ? (const float*)KARG(0) : (const float*)((float*)KARG(18));
        if (IN(0)) { p0_prologue<(l > 0)>(F, args, l, xin); SEAM(0); }
        if (IN(1)) {
            pg8::Gemm g{(const pg8::bf16_t*)(ws + WS_XN), (const pg8::bf16_t*)(ws + WS_WTIN), M, 8192, DM}; pg8::StaticOrder S; S.init(M, 8192, F.G, (int)blockIdx.x);
            pg8::EpiInProj E{ws};
            pg8::gemm_phase<pg8::EpiInProj, pg8::StaticOrder, PG8_ALIGN, PG8_SP2>(F.lds + RING_OFF, g, S, E, F.wave);
            SEAM(1);
        }
        if (IN(2)) { ph_ml_scalars(F, ws); ph_prep_qk(F, args, l); ph_conv(F, args, l); SEAM(2); }
        if (IN(3)) { ph_kmean(F, args); ph_ml_state(F, ws); SEAM(3); }
        if (IN(4)) { ph_ml_scan(F, ws); ph_sb_naive(F, args); SEAM(4); }
        if (IN(5)) {
            ph_ml_out(F, ws);
            const attn_body::AttnTensors AT{(const attn_body::bf16*)(ws + WS_MBQ), (const attn_body::bf16*)(ws + WS_MBK), (const attn_body::bf16*)(ws + WS_MBV), (attn_body::bf16*)(ws + WS_MBQ)};
            const attn_body::StaticOrder S((int)F.G, (int)blockIdx.x);
            attn_body::attn_phase<attn_body::StaticOrder>((char*)F.lds + RING_OFF, AT, S, (const float*)(ws + WS_KMEAN), F.wave);
            SEAM(5);
        }
        if (IN(6)) {
            pg8::Gemm g{(const pg8::bf16_t*)(ws + WS_SBQ), (const pg8::bf16_t*)(ws + WS_WTBR), M, 1024, 512}; pg8::YOrder S{F.vcu, F.G};
            pg8::EpiYMerge E{(const pg8::bf16_t*)(ws + WS_GATES), (pg8::bf16_t*)(ws + WS_MERGED)};
            pg8::gemm_phase<pg8::EpiYMerge, pg8::YOrder, PG8_ALIGN, PG8_SP2>(F.lds + RING_OFF, g, S, E, F.wave);
            SEAM(6);
        }
        if (IN(7)) {
            pg8::Gemm g{(const pg8::bf16_t*)(ws + WS_MERGED), (const pg8::bf16_t*)(ws + WS_WTOUT), M, DM, DM}; pg8::StaticOrder S; S.init(M, DM, F.G, (int)blockIdx.x);
            pg8::EpiResid32 E{xin, ((float*)KARG(18))};
            pg8::gemm_phase<pg8::EpiResid32, pg8::StaticOrder, PG8_ALIGN, PG8_SP2>(F.lds + RING_OFF, g, S, E, F.wave);
            SEAM(7);
        }
        if (IN(8)) { ph_moe_weights(F, args, l); ph_router(F, args, l); SEAM(8); }
        if (IN(9)) { ph_moe_gather(F, args, l); SEAM(9); }
        if (IN(10)) {
            moe_tables(F, l); const LAS int* tab = (const LAS int*)(F.lds + MOE_TAB_OFF);
            pg8::Gemm g{(const pg8::bf16_t*)(ws + WS_XS), (const pg8::bf16_t*)(ws + WS_WT13), M, 512, DM}; pg8::MoeOrder S{F.vcu, F.G, tab[0], 2, tab + 64};
            pg8::EpiSwiGLU E{(pg8::bf16_t*)(ws + WS_HS)};
            pg8::gemm_phase<pg8::EpiSwiGLU, pg8::MoeOrder, PG8_ALIGN, PG8_SP2>(F.lds + RING_OFF, g, S, E, F.wave);
            SEAM(10);
        }
        if (IN(11)) {
            moe_tables(F, l); const LAS int* tab = (const LAS int*)(F.lds + MOE_TAB_OFF);
            pg8::Gemm g{(const pg8::bf16_t*)(ws + WS_HS), (const pg8::bf16_t*)(ws + WS_WT2), M, DM, 256}; pg8::MoeOrder S{F.vcu, F.G, tab[0], 4, tab + 64};
            pg8::EpiMoeOut E{(pg8::bf16_t*)(ws + WS_YP), (const int*)(ws + WS_SPAIR), (const float*)(ws + WS_SW), tab + 256};
            pg8::gemm_phase<pg8::EpiMoeOut, pg8::MoeOrder, PG8_ALIGN, PG8_SP2>(F.lds + RING_OFF, g, S, E, F.wave);
            SEAM(11);
        }
#undef IN
#undef SEAM
}
__global__ void __launch_bounds__(NWAVES * 64, 2) mk(Args args) {
    extern __shared__ __attribute__((aligned(16))) unsigned char lds[];
    Frame F;
    F.lds = (LAS unsigned char*)lds; F.MISC = (volatile LAS unsigned*)(F.lds + MISC_OFF);
    F.wave = __builtin_amdgcn_readfirstlane((int)threadIdx.x >> 6);
    const int LANE_ = lane_id(), TID_ = F.wave * 64 + LANE_;
    F.G = gridDim.x; { const int bx = blockIdx.x; F.vcu = (F.G % 8 == 0) ? (bx % 8) * (F.G / 8) + bx / 8 : bx; }
    unsigned char* ws = ((unsigned char*)KARG(19)); F.ctl = (gu32*)(ws + WS_CTL);
    for (int u = TID_; u < (LDS_BYTES - LDSCTL_OFF) / 4; u += NWAVES * 64) ((LAS unsigned*)(F.lds + LDSCTL_OFF))[u] = 0u;
    __syncthreads();
    const int plo = args.ph_lo, phi = args.ph_hi;
    XcdBarrier bar; bar.bar = (unsigned*)(F.ctl + CW_BAR); bar.x = 0; bar.st = nullptr; bar.w = (unsigned)F.wave;
    if (phi - plo > 1) bar = xcd_barrier_post((unsigned*)(F.ctl + CW_BAR), F.MISC + 8, (unsigned)F.wave);
    layer_body<0>(F, args, bar, plo, phi);
    layer_body<1>(F, args, bar, plo, phi);
    if (plo <= DEPTH * NPH && DEPTH * NPH < phi) ph_final(F, args);
}

#ifndef MK_ONE_LAUNCH
#define MK_ONE_LAUNCH 1
#endif
extern "C" void kernel_launch(void* const* d_in, const int* in_sizes, int n_in, void* d_out, int out_size, void* d_ws, size_t ws_size, hipStream_t stream) {
    static int grid = 0;
    if (grid == 0) {
        if (n_in != 18 || out_size != M * DM || ws_size < WS_END) { fprintf(stderr, "kernel_launch: unexpected shapes (n_in %d out %d ws %zu)\n", n_in, out_size, ws_size); grid = -1; return; }
        int dev = 0, cus = 0;
        if (hipGetDevice(&dev) != hipSuccess || hipDeviceGetAttribute(&cus, hipDeviceAttributeMultiprocessorCount, dev) != hipSuccess) { grid = -1; return; }
        if (hipFuncSetAttribute((const void*)mk, hipFuncAttributeMaxDynamicSharedMemorySize, LDS_BYTES) != hipSuccess) { grid = -1; return; }
        int per_cu = 0;
        if (hipOccupancyMaxActiveBlocksPerMultiprocessor(&per_cu, (const void*)mk, NWAVES * 64, LDS_BYTES) != hipSuccess || per_cu < 1) fprintf(stderr, "kernel_launch: occupancy query says %d blocks per CU\n", per_cu);
        (void)hipGetLastError();
        grid = cus;
    }
    if (grid < 0) return;
    (void)hipMemsetAsync((char*)d_ws + WS_CTL, 0, CTL_ZERO_BYTES, stream);
    Args a{};
    for (int i = 0; i < 18; ++i) a.in[i] = d_in[i];
    a.out = (float*)d_out; a.ws = (unsigned char*)d_ws; a.layer = 0;
#if MK_ONE_LAUNCH
    a.ph_lo = 0; a.ph_hi = DEPTH * NPH + 1; hipLaunchKernelGGL(mk, dim3(grid), dim3(NWAVES * 64), LDS_BYTES, stream, a);
#else
    for (int p = 0; p < DEPTH * NPH + 1; ++p) { a.ph_lo = p; a.ph_hi = p + 1; hipLaunchKernelGGL(mk, dim3(grid), dim3(NWAVES * 64), LDS_BYTES, stream, a); }
#endif
}
```

```cpp
#include <hip/hip_runtime.h>
#include <stdint.h>
#include <cstdio>
#include <cmath>

constexpr int BATCH = 8, SEQ = 2048, DM = 1024, M = BATCH * SEQ, W = 512, PIN = 8200, DEPTH = 2;
constexpr float RMS_EPS = 1e-6f;
constexpr float C2 = 0.18033688011112042f;
constexpr size_t MiB = 1u << 20;
constexpr size_t WS_CTL = 0, CTL_ZERO_BYTES = 1 * MiB;
constexpr size_t WS_IFPRE = 1 * MiB, WS_KMEAN = WS_IFPRE + 512 * 1024, WS_RE = WS_KMEAN + 128 * 1024, WS_RW = WS_RE + 128 * 1024;
constexpr size_t WS_XN = 4 * MiB, WS_WTIN = 36 * MiB;
constexpr size_t WS_SBQ = 52 * MiB, WS_SBK = 68 * MiB, WS_SBV = 84 * MiB, WS_MBQ = 100 * MiB, WS_MBK = 116 * MiB, WS_MBV = 132 * MiB;
constexpr size_t WS_MLO = 148 * MiB, WS_MLV = 164 * MiB, WS_MLQK = 180 * MiB, WS_GATES = 212 * MiB;
constexpr size_t WS_WTBR = 308 * MiB, WS_WTOUT = 311 * MiB, WS_END = 313 * MiB;
constexpr size_t WS_MLQ2 = WS_XN, WS_MLK2 = WS_XN + 16 * MiB, WS_MERGED = WS_MLQK, WS_XN2 = WS_XN;
constexpr size_t WS_WT13 = 52 * MiB, WS_WT2 = 84 * MiB, WS_XS = 100 * MiB, WS_HS = 181 * MiB, WS_YP = 202 * MiB;
constexpr size_t WS_SPAIR = 2 * MiB, WS_SW = 2 * MiB + 256 * 1024, WS_RANK = 2 * MiB + 512 * 1024;
constexpr size_t WS_MLDN = 2 * MiB, WS_MLDEC = 2 * MiB + 640 * 1024, WS_MLWK = 2 * MiB + 768 * 1024, WS_MLSCAL = 3 * MiB, WS_MLCST = WS_MLQK;
constexpr int CW_CNT = 8192;
__device__ __forceinline__ int lane_id() { int x; asm volatile("v_mbcnt_lo_u32_b32 %0, -1, 0\n\tv_mbcnt_hi_u32_b32 %0, -1, %0" : "=v"(x)); return x; }
namespace pg8 {
#define PG8_LAS __attribute__((address_space(3)))
typedef unsigned short bf16_t;
typedef short bf16x8 __attribute__((ext_vector_type(8)));
typedef float f32x4 __attribute__((ext_vector_type(4)));
typedef unsigned u32x4 __attribute__((ext_vector_type(4)));
constexpr int BM = 256, BK = 64, HALF = 128, HTB = HALF * BK * 2  , STAGE_BYTES = 8 * HTB, NXCD = 8, WGM = 8;

__host__ __device__ __forceinline__ int lds_byte(int r, int c) { const int st = (r >> 4) * 2 + (c >> 5), rr = r & 15, cc = c & 31, ob = rr * 64 + cc * 2; return st * 1024 + (ob ^ (((ob >> 9) & 1) << 5)); }
__host__ __device__ __forceinline__ void stage_rc(int b, int& R, int& C) { const int st = b / 1024, sb = b % 1024, swz = sb ^ (((sb >> 9) & 1) << 5); R = (st >> 1) * 16 + swz / 64; C = (st & 1) * 32 + (swz % 64) / 2; }
__host__ __device__ __forceinline__ int perm32(int rho) { const int n = rho >> 4, i = rho & 15; return 8 * (i >> 2) + 4 * n + (i & 3); }

struct Unit { int pm, pn; };
struct Gemm { const bf16_t* A; const bf16_t* Bt; int M, N, K; };

struct StaticOrder {
    int nM, nN, nwg, G, c;
    __host__ __device__ void init(int M, int N, int G_, int c_) { nM = M / BM; nN = N / BM; nwg = nM * nN; G = G_; c = c_; }
    __host__ __device__ bool next(int i, Unit& u) const {
        const long L = (long)i * G + c; if (L >= nwg) return false;
        int wgid = (int)L; { const int q = nwg / NXCD, r = nwg % NXCD, xcd = wgid % NXCD, off = wgid / NXCD; wgid = (xcd < r ? xcd * (q + 1) : r * (q + 1) + (xcd - r) * q) + off; }
        const int nig = WGM * nN, gid = wgid / nig, fm = gid * WGM, gsz = (nM - fm) < WGM ? (nM - fm) : WGM;
        u.pm = fm + ((wgid % nig) % gsz); u.pn = (wgid % nig) / gsz; return true;
    }
    __device__ __forceinline__ void a_ready(const Unit&) const {}
    __device__ __forceinline__ void done(const Unit&) const {}
};

__device__ __forceinline__ unsigned cvt_pk_bf16(float lo, float hi) { unsigned r; asm volatile("v_cvt_pk_bf16_f32 %0, %1, %2" : "=v"(r) : "v"(lo), "v"(hi)); return r; }
typedef float f32x2 __attribute__((ext_vector_type(2)));
__device__ __forceinline__ float fast_sigmoid(float x) { return __builtin_amdgcn_rcpf(1.0f + __expf(-x)); }
struct EpiInProj {
    static constexpr bool PERM = true, AFTER_DRAIN = false;
    unsigned char* ws;
    __device__ __forceinline__ void operator()(const f32x4 (&acc)[2][2][4][2], const Unit& u, int wr, int wc, int fr, int fq) const {
        const int pn = u.pn; bf16_t* base; int ldc, colt; float sc = 1.f; bool sig = false;
        if (pn < 12) { base = (bf16_t*)(ws + WS_SBQ) + (size_t)(pn >> 1) * (8u << 20); ldc = 512; colt = (pn & 1) * 256; if (pn < 2) sc = C2; }
        else if (pn < 14) { base = (bf16_t*)(ws + WS_MLO); ldc = 512; colt = (pn & 1) * 256; }
        else if (pn < 16) { base = (bf16_t*)(ws + WS_MLV); ldc = 512; colt = (pn & 1) * 256; }
        else if (pn < 20) { base = (bf16_t*)(ws + WS_MLQK); ldc = 1024; colt = (pn - 16) * 256; }
        else { base = (bf16_t*)(ws + WS_GATES); ldc = 3072; colt = (pn - 20) * 256; sig = true; }
        const int row0 = u.pm * BM + wr * 64 + fr, col0 = colt + wc * 32 + 8 * fq;
#pragma unroll
        for (int ai = 0; ai < 2; ++ai)
#pragma unroll
            for (int m = 0; m < 4; ++m) { bf16_t* rowp = base + (size_t)(row0 + ai * HALF + m * 16) * ldc + col0;
#pragma unroll
                for (int bj = 0; bj < 2; ++bj) { f32x4 v0 = acc[ai][bj][m][0], v1 = acc[ai][bj][m][1];
                    if (sig) { v0 = (f32x4){fast_sigmoid(v0[0]), fast_sigmoid(v0[1]), fast_sigmoid(v0[2]), fast_sigmoid(v0[3])}; v1 = (f32x4){fast_sigmoid(v1[0]), fast_sigmoid(v1[1]), fast_sigmoid(v1[2]), fast_sigmoid(v1[3])}; }
                    else { v0 = v0 * sc; v1 = v1 * sc; }
                    u32x4 w; w.x = cvt_pk_bf16(v0[0], v0[1]); w.y = cvt_pk_bf16(v0[2], v0[3]); w.z = cvt_pk_bf16(v1[0], v1[1]); w.w = cvt_pk_bf16(v1[2], v1[3]);
                    *(u32x4*)(rowp + bj * HALF) = w; } }
    }
};
struct EpiYMerge {
    static constexpr bool PERM = true, AFTER_DRAIN = false;
    const bf16_t* gates; bf16_t* merged;
    __device__ __forceinline__ void operator()(const f32x4 (&acc)[2][2][4][2], const Unit& u, int wr, int wc, int fr, int fq) const {
        const int n = u.pn >> 2, pn = u.pn & 3, pm = u.pm - 192 * n;
        const int row0 = pm * BM + wr * 64 + fr, col0 = pn * BM + wc * 32 + 8 * fq;
#pragma unroll
        for (int ai = 0; ai < 2; ++ai)
#pragma unroll
            for (int m = 0; m < 4; ++m) { const size_t r = (size_t)(row0 + ai * HALF + m * 16);
#pragma unroll
                for (int bj = 0; bj < 2; ++bj) { const int c = col0 + bj * HALF;
                    const u32x4 gv = *(const u32x4*)(gates + r * 3072 + n * 1024 + c);
                    f32x4 v0 = acc[ai][bj][m][0], v1 = acc[ai][bj][m][1];
                    v0[0] *= __uint_as_float(gv.x << 16); v0[1] *= __uint_as_float(gv.x & 0xffff0000u); v0[2] *= __uint_as_float(gv.y << 16); v0[3] *= __uint_as_float(gv.y & 0xffff0000u);
                    v1[0] *= __uint_as_float(gv.z << 16); v1[1] *= __uint_as_float(gv.z & 0xffff0000u); v1[2] *= __uint_as_float(gv.w << 16); v1[3] *= __uint_as_float(gv.w & 0xffff0000u);
                    bf16_t* mp = merged + r * 1024 + c;
                    if (n > 0) { const u32x4 pv = *(const u32x4*)mp;
                        v0[0] += __uint_as_float(pv.x << 16); v0[1] += __uint_as_float(pv.x & 0xffff0000u); v0[2] += __uint_as_float(pv.y << 16); v0[3] += __uint_as_float(pv.y & 0xffff0000u);
                        v1[0] += __uint_as_float(pv.z << 16); v1[1] += __uint_as_float(pv.z & 0xffff0000u); v1[2] += __uint_as_float(pv.w << 16); v1[3] += __uint_as_float(pv.w & 0xffff0000u); }
                    u32x4 w; w.x = cvt_pk_bf16(v0[0], v0[1]); w.y = cvt_pk_bf16(v0[2], v0[3]); w.z = cvt_pk_bf16(v1[0], v1[1]); w.w = cvt_pk_bf16(v1[2], v1[3]);
                    *(u32x4*)mp = w; } }
    }
};
struct YOrder {
    int vcu, G;
    __device__ __forceinline__ bool next(int i, Unit& u) const { const int j = i / 3, n = i - 3 * j, tile = vcu + G * j; if (tile >= 256) return false; u.pm = (tile >> 2) + 192 * n; u.pn = (tile & 3) + 4 * n; return true; }
    __device__ __forceinline__ void a_ready(const Unit&) const {}
    __device__ __forceinline__ void done(const Unit&) const {}
};
struct EpiResid32 {
    static constexpr bool PERM = false, AFTER_DRAIN = false;
    const float* xin; float* out;
    __device__ __forceinline__ void operator()(const f32x4 (&acc)[2][2][4][2], const Unit& u, int wr, int wc, int fr, int fq) const {
        const int row0 = u.pm * BM + wr * 64 + fr, col0 = u.pn * BM + wc * 32 + 4 * fq;
#pragma unroll
        for (int ai = 0; ai < 2; ++ai)
#pragma unroll
            for (int m = 0; m < 4; ++m) { const size_t off = (size_t)(row0 + ai * HALF + m * 16) * 1024 + col0;
#pragma unroll
                for (int bj = 0; bj < 2; ++bj)
#pragma unroll
                    for (int n = 0; n < 2; ++n) { const f32x4 xv = *(const f32x4*)(xin + off + bj * HALF + n * 16); *(f32x4*)(out + off + bj * HALF + n * 16) = xv + acc[ai][bj][m][n]; } }
    }
};

struct EpiSwiGLU {
    static constexpr bool PERM = true, AFTER_DRAIN = false;
    bf16_t* Hs;
    __device__ __forceinline__ void operator()(const f32x4 (&acc)[2][2][4][2], const Unit& u, int wr, int wc, int fr, int fq) const {
        const int j = u.pn & 1; const int row0 = u.pm * BM + wr * 64 + fr, col0 = j * 128 + wc * 32 + 8 * fq;
#pragma unroll
        for (int ai = 0; ai < 2; ++ai)
#pragma unroll
            for (int m = 0; m < 4; ++m) { bf16_t* rowp = Hs + (size_t)(row0 + ai * HALF + m * 16) * 256 + col0;
                f32x4 h0, h1;
#pragma unroll
                for (int t = 0; t < 4; ++t) { const float a0 = acc[ai][0][m][0][t], a1 = acc[ai][0][m][1][t]; h0[t] = a0 * fast_sigmoid(a0) * acc[ai][1][m][0][t]; h1[t] = a1 * fast_sigmoid(a1) * acc[ai][1][m][1][t]; }
                u32x4 w; w.x = cvt_pk_bf16(h0[0], h0[1]); w.y = cvt_pk_bf16(h0[2], h0[3]); w.z = cvt_pk_bf16(h1[0], h1[1]); w.w = cvt_pk_bf16(h1[2], h1[3]);
                *(u32x4*)rowp = w; }
    }
};
struct EpiMoeOut {
    static constexpr bool PERM = true, AFTER_DRAIN = false;
    bf16_t* Yp; const int* spair; const float* sw; const PG8_LAS int* panelValid;
    __device__ __forceinline__ void operator()(const f32x4 (&acc)[2][2][4][2], const Unit& u, int wr, int wc, int fr, int fq) const {
        const int jn = u.pn & 3, valid = panelValid[u.pm]; const int rl0 = wr * 64 + fr, col0 = jn * 256 + wc * 32 + 8 * fq;
#pragma unroll
        for (int ai = 0; ai < 2; ++ai)
#pragma unroll
            for (int m = 0; m < 4; ++m) { const int rl = rl0 + ai * HALF + m * 16;
                if (rl < valid) { const int slot = u.pm * BM + rl; const int pair = spair[slot]; const float w = sw[slot]; bf16_t* rowp = Yp + (size_t)pair * 1024 + col0;
#pragma unroll
                    for (int bj = 0; bj < 2; ++bj) { const f32x4 v0 = acc[ai][bj][m][0] * w, v1 = acc[ai][bj][m][1] * w;
                        u32x4 o; o.x = cvt_pk_bf16(v0[0], v0[1]); o.y = cvt_pk_bf16(v0[2], v0[3]); o.z = cvt_pk_bf16(v1[0], v1[1]); o.w = cvt_pk_bf16(v1[2], v1[3]);
                        *(u32x4*)(rowp + bj * HALF) = o; } } }
    }
};
struct MoeOrder {
    int vcu, G, P, nper; const PG8_LAS int* panelE;
    __device__ __forceinline__ bool next(int i, Unit& u) const { const int idx = vcu + G * i; if (idx >= nper * P) return false; const int p = idx / nper, j = idx - p * nper; u.pm = p; u.pn = panelE[p] * nper + j; return true; }
    __device__ __forceinline__ void a_ready(const Unit&) const {}
    __device__ __forceinline__ void done(const Unit&) const {}
};
template <class Epi, class Sched, bool ALIGN_EPI = false, bool SP2 = false>
__device__ __forceinline__ void gemm_phase(PG8_LAS unsigned char* lds, const Gemm g, const Sched& S, const Epi& E, const int wid) {
    const int lane = lane_id(), tid = wid * 64 + lane, wr = wid >> 2, wc = wid & 3, fr = lane & 15, fq = lane >> 4;
    const int K = g.K, nt = K / BK;
    unsigned voffA[2], voffB[2];
#pragma unroll
    for (int i = 0; i < 2; ++i) { int R, C; stage_rc(tid * 16 + i * 8192, R, C); const int Rb = Epi::PERM ? ((R & ~31) + perm32(R & 31)) : R;
        voffA[i] = (unsigned)(R * K + C) * 2u; voffB[i] = (unsigned)(Rb * K + C) * 2u; }
    const size_t kstep = (size_t)(BK * 2);
    const size_t hstep = (size_t)HALF * K * 2;
    const size_t tstep = 2 * hstep;
    const unsigned ldsw = (unsigned)wid * 1024u;
    const int aoff = lds_byte(wr * 64 + fr, fq * 8), boff = lds_byte(wc * 32 + fr, fq * 8);
#define PG8_SA(b, h) (((b) * 2 + (h)) * HTB)
#define PG8_SB(b, h) ((4 + (b) * 2 + (h)) * HTB)
#define PG8_STAGE(bufoff, gbase, voff) do { _Pragma("unroll") for (int _i = 0; _i < 2; ++_i) \
        __builtin_amdgcn_global_load_lds((const unsigned*)((const char*)(gbase) + (voff)[_i]), (PG8_LAS unsigned*)(lds + (bufoff) + ldsw + _i * 8192), 16, 0, 0); } while (0)
#define PG8_LDA(dst, b, h) do { _Pragma("unroll") for (int m = 0; m < 4; ++m) _Pragma("unroll") for (int k = 0; k < 2; ++k) dst[m][k] = *(const PG8_LAS bf16x8*)(lds + PG8_SA(b, h) + aoff + m * 2048 + k * 1024); } while (0)
#define PG8_LDB(dst, b, h) do { _Pragma("unroll") for (int n = 0; n < 2; ++n) _Pragma("unroll") for (int k = 0; k < 2; ++k) dst[n][k] = *(const PG8_LAS bf16x8*)(lds + PG8_SB(b, h) + boff + n * 2048 + k * 1024); } while (0)
#define PG8_MMA(ai, bj, At, Bt) do { __builtin_amdgcn_s_setprio(1); _Pragma("unroll") for (int m = 0; m < 4; ++m) _Pragma("unroll") for (int n = 0; n < 2; ++n) _Pragma("unroll") for (int k = 0; k < 2; ++k) \
        acc[ai][bj][m][n] = __builtin_amdgcn_mfma_f32_16x16x32_bf16(Bt[n][k], At[m][k], acc[ai][bj][m][n], 0, 0, 0); __builtin_amdgcn_s_setprio(0); } while (0)
#define PG8_WAIT_V(n) asm volatile("s_waitcnt vmcnt(" #n ")" ::: "memory")
#define PG8_WAIT_L(n) asm volatile("s_waitcnt lgkmcnt(" #n ")" ::: "memory")
#define PG8_BAR __builtin_amdgcn_s_barrier()
#define PG8_SCHED __builtin_amdgcn_sched_barrier(0)
    Unit cur, nxt; int ui = 0;
    if (!S.next(0, cur)) return;
    f32x4 acc[2][2][4][2];
#pragma unroll
    for (int a = 0; a < 2; ++a)
#pragma unroll
        for (int b = 0; b < 2; ++b)
#pragma unroll
            for (int m = 0; m < 4; ++m)
#pragma unroll
                for (int n = 0; n < 2; ++n) acc[a][b][m][n] = (f32x4){0.f, 0.f, 0.f, 0.f};
    bf16x8 At[4][2], B0[2][2], B1[2][2];
    const char* cA = (const char*)g.A + (size_t)cur.pm * tstep; const char* cB = (const char*)g.Bt + (size_t)cur.pn * tstep;
    S.a_ready(cur);
    if constexpr (SP2) {
        PG8_STAGE(PG8_SB(0, 0), cB, voffB); PG8_STAGE(PG8_SB(0, 1), cB + hstep, voffB); PG8_STAGE(PG8_SA(0, 0), cA, voffA); PG8_STAGE(PG8_SA(0, 1), cA + hstep, voffA);
        if (wr == 1) PG8_BAR;
        PG8_WAIT_V(2); PG8_BAR;
        PG8_STAGE(PG8_SB(1, 0), cB + kstep, voffB); PG8_STAGE(PG8_SA(1, 0), cA + kstep, voffA); PG8_STAGE(PG8_SB(1, 1), cB + hstep + kstep, voffB);
        PG8_WAIT_V(6); PG8_BAR;
    } else {
        PG8_STAGE(PG8_SB(0, 0), cB, voffB); PG8_STAGE(PG8_SA(0, 0), cA, voffA); PG8_STAGE(PG8_SB(0, 1), cB + hstep, voffB); PG8_STAGE(PG8_SA(0, 1), cA + hstep, voffA);
        if (wr == 1) PG8_BAR;
        PG8_WAIT_V(4); PG8_BAR;
        PG8_STAGE(PG8_SB(1, 0), cB + kstep, voffB); PG8_STAGE(PG8_SA(1, 0), cA + kstep, voffA); PG8_STAGE(PG8_SB(1, 1), cB + hstep + kstep, voffB);
        PG8_WAIT_V(6); PG8_BAR;
    }
    for (;;) {
        const bool has_next = S.next(ui + 1, nxt);
        const char* nA = has_next ? (const char*)g.A + (size_t)nxt.pm * tstep : cA; const char* nB = has_next ? (const char*)g.Bt + (size_t)nxt.pn * tstep : cB;
        for (int t = 0; t < nt; t += 2) {
            const bool last = (t == nt - 2);
            const char* a1 = cA + (size_t)(t + 1) * kstep;
            const char* a2 = last ? nA : cA + (size_t)(t + 2) * kstep; const char* b2 = last ? nB : cB + (size_t)(t + 2) * kstep;
            const char* a3 = a2 + kstep; const char* b3 = b2 + kstep;
            if (last && has_next) S.a_ready(nxt);
            if constexpr (SP2) {
            PG8_LDB(B0, 0, 0); PG8_LDB(B1, 0, 1); PG8_SCHED; PG8_LDA(At, 0, 0); PG8_STAGE(PG8_SA(1, 1), a1 + hstep, voffA);
            PG8_WAIT_V(8); PG8_WAIT_L(0); PG8_BAR; PG8_MMA(0, 0, At, B0); PG8_MMA(0, 1, At, B1); PG8_BAR; PG8_SCHED;
            PG8_LDA(At, 0, 1); PG8_STAGE(PG8_SB(0, 0), b2, voffB); PG8_STAGE(PG8_SB(0, 1), b2 + hstep, voffB); PG8_STAGE(PG8_SA(0, 0), a2, voffA);
            PG8_WAIT_V(8); PG8_WAIT_L(0); PG8_BAR; PG8_MMA(1, 0, At, B0); PG8_MMA(1, 1, At, B1); PG8_BAR; PG8_SCHED;
            PG8_LDB(B0, 1, 0); PG8_LDB(B1, 1, 1); PG8_SCHED; PG8_LDA(At, 1, 0); PG8_STAGE(PG8_SA(0, 1), a2 + hstep, voffA);
            PG8_WAIT_V(8); PG8_WAIT_L(0); PG8_BAR; PG8_MMA(0, 0, At, B0); PG8_MMA(0, 1, At, B1); PG8_BAR; PG8_SCHED;
            PG8_LDA(At, 1, 1); PG8_STAGE(PG8_SB(1, 0), b3, voffB); PG8_STAGE(PG8_SB(1, 1), b3 + hstep, voffB); PG8_STAGE(PG8_SA(1, 0), a3, voffA);
            PG8_WAIT_V(8); PG8_WAIT_L(0); PG8_BAR; PG8_MMA(1, 0, At, B0); PG8_MMA(1, 1, At, B1); PG8_BAR; PG8_SCHED;
            } else {
            PG8_LDB(B0, 0, 0); PG8_SCHED; PG8_LDA(At, 0, 0); PG8_STAGE(PG8_SA(1, 1), a1 + hstep, voffA);
            PG8_WAIT_L(8); PG8_BAR; PG8_WAIT_L(0); PG8_MMA(0, 0, At, B0); PG8_BAR; PG8_SCHED;
            PG8_LDB(B1, 0, 1); PG8_STAGE(PG8_SB(0, 0), b2, voffB);
            PG8_BAR; PG8_WAIT_L(0); PG8_MMA(0, 1, At, B1); PG8_BAR;
            PG8_LDA(At, 0, 1); PG8_STAGE(PG8_SA(0, 0), a2, voffA);
            PG8_BAR; PG8_WAIT_L(0); PG8_MMA(1, 0, At, B0); PG8_BAR; PG8_SCHED;
            PG8_STAGE(PG8_SB(0, 1), b2 + hstep, voffB);
            PG8_WAIT_V(6); PG8_BAR; PG8_MMA(1, 1, At, B1); PG8_BAR;
            PG8_LDB(B0, 1, 0); PG8_SCHED; PG8_LDA(At, 1, 0); PG8_STAGE(PG8_SA(0, 1), a2 + hstep, voffA);
            PG8_WAIT_L(8); PG8_BAR; PG8_WAIT_L(0); PG8_MMA(0, 0, At, B0); PG8_BAR; PG8_SCHED;
            PG8_LDB(B1, 1, 1); PG8_STAGE(PG8_SB(1, 0), b3, voffB);
            PG8_BAR; PG8_WAIT_L(0); PG8_MMA(0, 1, At, B1); PG8_BAR;
            PG8_LDA(At, 1, 1); PG8_STAGE(PG8_SA(1, 0), a3, voffA);
            PG8_BAR; PG8_WAIT_L(0); PG8_MMA(1, 0, At, B0); PG8_BAR; PG8_SCHED;
            PG8_STAGE(PG8_SB(1, 1), b3 + hstep, voffB);
            PG8_WAIT_V(6); PG8_BAR; PG8_MMA(1, 1, At, B1); PG8_BAR;
            }
        }
        if constexpr (ALIGN_EPI) { if (wr == 0) PG8_BAR; }
        if constexpr (!Epi::AFTER_DRAIN) { E(acc, cur, wr, wc, fr, fq); S.done(cur); }
        if (!has_next) break;
#pragma unroll
        for (int a = 0; a < 2; ++a)
#pragma unroll
            for (int b = 0; b < 2; ++b)
#pragma unroll
                for (int m = 0; m < 4; ++m)
#pragma unroll
                    for (int n = 0; n < 2; ++n) acc[a][b][m][n] = (f32x4){0.f, 0.f, 0.f, 0.f};
        cur = nxt; cA = nA; cB = nB; ++ui;
        if constexpr (ALIGN_EPI) { if (wr == 1) PG8_BAR; }
    }
    PG8_WAIT_V(0);
    if constexpr (!ALIGN_EPI) { if (wr == 0) PG8_BAR; }
    PG8_BAR;
    if constexpr (Epi::AFTER_DRAIN) { E.fused(acc, cur, wr, wc, fr, fq, lds, wid, lane); S.done(cur); }
#undef PG8_SA
#undef PG8_SB
#undef PG8_STAGE
#undef PG8_LDA
#undef PG8_LDB
#undef PG8_MMA
#undef PG8_WAIT_V
#undef PG8_WAIT_L
#undef PG8_BAR
#undef PG8_SCHED
}
}

#ifndef PG8_SP2
#define PG8_SP2 true
#endif
#ifndef PG8_ALIGN
#define PG8_ALIGN true
#endif
#define GAS __attribute__((address_space(1)))
#define LAS __attribute__((address_space(3)))
typedef unsigned short bf16;
typedef unsigned v4u __attribute__((ext_vector_type(4)));
typedef float f32x4 __attribute__((ext_vector_type(4)));
typedef short bf16x8 __attribute__((ext_vector_type(8)));
typedef GAS unsigned gu32;
typedef GAS unsigned long long gu64;
#define RLX_AGENT __ATOMIC_RELAXED, __HIP_MEMORY_SCOPE_AGENT
#define LDS_WAIT() asm volatile("s_waitcnt lgkmcnt(0)" ::: "memory")
#define VM_WAIT() asm volatile("s_waitcnt vmcnt(0)" ::: "memory")
__device__ __forceinline__ unsigned long long rt() { return __builtin_amdgcn_s_memrealtime(); }
__device__ __forceinline__ unsigned f2bf(float f) { unsigned u = __builtin_bit_cast(unsigned, f); return (u + 0x7fffu + ((u >> 16) & 1u)) >> 16; }
__device__ __forceinline__ unsigned pk2(float lo, float hi) { return f2bf(lo) | (f2bf(hi) << 16); }

#define XB_TMO      128
#define XB_XCNT(j)  (256  + 64 * (j))
#define XB_XSUB(j)  (1280 + 64 * (j))
#define XB_XGEN(j)  (2304 + 64 * (j))
#define XB_TOP      3328
#define XB_TOPGEN   3392
#define XCD_BAR_WORDS 3456
#define XB_SPIN_CAP (1u << 18)

__device__ __forceinline__ unsigned xb_ld(unsigned* p)              { return __hip_atomic_load(p, __ATOMIC_RELAXED, __HIP_MEMORY_SCOPE_AGENT); }
__device__ __forceinline__ unsigned xb_add(unsigned* p, unsigned v) { return __hip_atomic_fetch_add(p, v, __ATOMIC_RELAXED, __HIP_MEMORY_SCOPE_AGENT); }
__device__ __forceinline__ unsigned xb_xcc_id() { return (unsigned)__builtin_amdgcn_s_getreg((3 << 11) | 20) & 0xFu; }
#define XB_SPIN(cond, bar) do { unsigned _sp = 0; while (cond) { __builtin_amdgcn_s_sleep(1); \
    if ((++_sp & 255u) == 0u) { if (xb_ld(&(bar)[XB_TMO])) break; if (_sp > XB_SPIN_CAP) { atomicAdd(&(bar)[XB_TMO], 1u); break; } } } } while (0)

struct XcdBarrier {
    unsigned* bar; unsigned x; unsigned w;
    volatile LAS unsigned* st;
};

__device__ __forceinline__ XcdBarrier xcd_barrier_post(unsigned* bar, volatile LAS unsigned* st, unsigned wave) {
    XcdBarrier b; b.bar = bar; b.x = xb_xcc_id(); b.st = st; b.w = wave;
    if (wave == 0u && lane_id() == 0) (void)xb_add(&bar[XB_XCNT(b.x)], 1u);
    return b;
}
__device__ __forceinline__ void xcd_barrier_complete(unsigned* bar, unsigned x, unsigned& nloc, unsigned& nx) {
    const unsigned G = gridDim.x * gridDim.y * gridDim.z;
    unsigned sum, cnt, mine, sp = 0u;
    for (;;) {
        sum = 0u; cnt = 0u; mine = 0u;
#pragma unroll
        for (unsigned j = 0; j < 16; ++j) { const unsigned c = xb_ld(&bar[XB_XCNT(j)]); sum += c; cnt += (c > 0u) ? 1u : 0u; mine = (j == x) ? c : mine; }
        if (sum == G) break;
        __builtin_amdgcn_s_sleep(1);
        if ((++sp & 255u) == 0u) { if (xb_ld(&bar[XB_TMO])) break; if (sp > XB_SPIN_CAP) { atomicAdd(&bar[XB_TMO], 1u); break; } }
    }
    nloc = mine > 0u ? mine : 1u; nx = cnt > 0u ? cnt : 1u;
}

__device__ __forceinline__ void xcd_barrier(const XcdBarrier& b) {
    asm volatile("s_waitcnt vmcnt(0)" ::: "memory");
    __syncthreads();
    if (b.w == 0u && lane_id() == 0) {
        unsigned* bar = b.bar;
        __builtin_amdgcn_s_waitcnt(0);
        unsigned nloc = b.st[0], nx = b.st[1];
        if (nloc == 0u) { xcd_barrier_complete(bar, b.x, nloc, nx); b.st[0] = nloc; b.st[1] = nx; }
        const unsigned old = xb_add(&bar[XB_XSUB(b.x)], 1u);
        const unsigned gen = old / nloc;
        if (old + 1u == (gen + 1u) * nloc) {
            __builtin_amdgcn_fence(__ATOMIC_RELEASE, "agent");
            asm volatile("s_waitcnt vmcnt(0)" ::: "memory");
            const unsigned og = xb_add(&bar[XB_TOP], 1u);
            const unsigned tg = og / nx;
            if (og + 1u == (tg + 1u) * nx) xb_add(&bar[XB_TOPGEN], 1u);
            else XB_SPIN(xb_ld(&bar[XB_TOPGEN]) == tg, bar);
            __builtin_amdgcn_fence(__ATOMIC_ACQUIRE, "agent");
            xb_add(&bar[XB_XGEN(b.x)], 1u);
            asm volatile("s_waitcnt vmcnt(0)" ::: "memory");
        } else {
            XB_SPIN(xb_ld(&bar[XB_XGEN(b.x)]) == gen, bar);
            __builtin_amdgcn_fence(__ATOMIC_ACQUIRE, "agent");
            asm volatile("s_waitcnt vmcnt(0)" ::: "memory");
        }
    }
    __syncthreads();
}
#include <hip/hip_bf16.h>
#include <cmath>
namespace attn_body {
using bf16=__hip_bfloat16;
using bf16x8=__attribute__((ext_vector_type(8)))short;
using s16x4=__attribute__((ext_vector_type(4)))short;
using f32x16=__attribute__((ext_vector_type(16)))float;
using u32x4=__attribute__((ext_vector_type(4)))unsigned;
constexpr int BATCH=8,NHEAD=8,SEQ=2048,D=64,DM=NHEAD*D;
constexpr int NW=8,QBLK=32,QB=QBLK*NW,KVBLK=64,NQB=SEQ/QB;
constexpr int ATTN_PITCH=DM, ATTN_UNIT_ROWS=QB;
__device__ __forceinline__ int crow(int r,int hi){return (r&3)+8*(r>>2)+4*hi;}
#define SBAR() __builtin_amdgcn_sched_barrier(0)
__device__ __forceinline__ void cmask(f32x16&p0,f32x16&p1,int jb,int qrel,int hi){
  const float NEG=-INFINITY; int kb=64*jb+4*hi;
  #pragma unroll
  for(int r=0;r<16;++r){int kv=kb+(r&3)+8*(r>>2); if(kv>qrel)p0[r]=NEG; if(kv+32>qrel)p1[r]=NEG;}
}

constexpr int NSLOT=3, SLOTB=8192;
constexpr int LDS_K=0, LDS_V=NSLOT*SLOTB, LDS_WS=2*NSLOT*SLOTB, LDS_OST=LDS_WS+NW*64*4, LDS_BYTES=LDS_OST+NW*4096;
constexpr float C2=0.125f*1.4426950408889634f;
__device__ __forceinline__ void glds16(const void*gsrc,unsigned lds_dst){unsigned keep;
  asm volatile("s_mov_b32 %0, m0\n\ts_mov_b32 m0, %2\n\ts_nop 0\n\tglobal_load_lds_dwordx4 %1, off\n\ts_mov_b32 m0, %0":"=&s"(keep):"v"(gsrc),"s"(lds_dst):"memory");}
__device__ __forceinline__ float max3f(float a,float b,float c){float r;asm("v_max3_f32 %0, %1, %2, %3":"=v"(r):"v"(a),"v"(b),"v"(c));return r;}
__device__ __forceinline__ float max2f(float a,float b){float r;asm("v_max_f32_e32 %0, %1, %2":"=v"(r):"v"(a),"v"(b));return r;}
__device__ __forceinline__ float fadd_s(float a,float b){float r;asm("v_add_f32_e32 %0, %1, %2":"=v"(r):"v"(a),"v"(b));return r;}
__device__ __forceinline__ float fsub_s(float a,float b){float r;asm("v_sub_f32_e32 %0, %1, %2":"=v"(r):"v"(a),"v"(b));return r;}
typedef float f32x2_t __attribute__((ext_vector_type(2))); typedef __bf16 bf16x2_t __attribute__((ext_vector_type(2)));
__device__ __forceinline__ unsigned cvtpk_s(float lo,float hi){f32x2_t v={lo,hi};bf16x2_t b=__builtin_convertvector(v,bf16x2_t);return __builtin_bit_cast(unsigned,b);}
#define WAIT_BAR(N) asm volatile("s_waitcnt vmcnt(" #N ") lgkmcnt(0)\n\ts_barrier":::"memory")

__device__ __forceinline__ void qkt(f32x16&p0,f32x16&p1,const char*Kslot,const bf16x8*qr,const f32x16&negm,int r32,int hi){
  const char*kb=Kslot+hi*1024+r32*16;
  #pragma unroll
  for(int d0=0;d0<4;++d0){
    const bf16x8 b0=*reinterpret_cast<const bf16x8*>(kb+d0*2048);
    const bf16x8 b1=*reinterpret_cast<const bf16x8*>(kb+d0*2048+512);
    if(d0==0){p0=__builtin_amdgcn_mfma_f32_32x32x16_bf16(b0,qr[0],negm,0,0,0);p1=__builtin_amdgcn_mfma_f32_32x32x16_bf16(b1,qr[0],negm,0,0,0);}
    else{p0=__builtin_amdgcn_mfma_f32_32x32x16_bf16(b0,qr[d0],p0,0,0,0);p1=__builtin_amdgcn_mfma_f32_32x32x16_bf16(b1,qr[d0],p1,0,0,0);}}
}
typedef __attribute__((address_space(3))) const char* lds_cptr;
typedef short v4i16_t __attribute__((ext_vector_type(4)));
__device__ __forceinline__ void kload8(bf16x8*kf,lds_cptr kp){
  kf[0]=*(const __attribute__((address_space(3))) bf16x8*)(kp);      kf[1]=*(const __attribute__((address_space(3))) bf16x8*)(kp+512);
  kf[2]=*(const __attribute__((address_space(3))) bf16x8*)(kp+2048); kf[3]=*(const __attribute__((address_space(3))) bf16x8*)(kp+2560);
  kf[4]=*(const __attribute__((address_space(3))) bf16x8*)(kp+4096); kf[5]=*(const __attribute__((address_space(3))) bf16x8*)(kp+4608);
  kf[6]=*(const __attribute__((address_space(3))) bf16x8*)(kp+6144); kf[7]=*(const __attribute__((address_space(3))) bf16x8*)(kp+6656);
}
__device__ __forceinline__ void kload2(bf16x8*kf,lds_cptr kp,int j){ kf[2*j]=*(const __attribute__((address_space(3))) bf16x8*)(kp+j*2048); kf[2*j+1]=*(const __attribute__((address_space(3))) bf16x8*)(kp+j*2048+512); }
__device__ __forceinline__ s16x4 vtr(lds_cptr p){ return __builtin_bit_cast(s16x4,__builtin_amdgcn_ds_read_tr16_b64_v4i16((__attribute__((address_space(3))) v4i16_t*)p)); }
__device__ __forceinline__ float rowmax(const f32x16&p0,const f32x16&p1){
  float a=max3f(p0[0],p0[1],p1[0]),b=max3f(p0[2],p0[3],p1[1]);a=max3f(a,p1[2],p1[3]);
  #pragma unroll
  for(int r=4;r<16;r+=4){a=max3f(a,p0[r],p0[r+1]);b=max3f(b,p0[r+2],p0[r+3]);a=max3f(a,p1[r],p1[r+1]);b=max3f(b,p1[r+2],p1[r+3]);}
  const float m=max2f(a,b);
  auto rr=__builtin_amdgcn_permlane32_swap(__float_as_uint(m),__float_as_uint(m),false,false);
  return max2f(__uint_as_float(rr[0]),__uint_as_float(rr[1]));
}
__device__ __forceinline__ void pv(f32x16*o,int vb,bf16x8 pa0,bf16x8 pa1,bf16x8 pa2,bf16x8 pa3){
  #pragma unroll
  for(int d0=0;d0<2;++d0){s16x4 lo[4],hi[4];
    #pragma unroll
    for(int ks=0;ks<4;++ks){
      asm volatile("ds_read_b64_tr_b16 %0,%1 offset:%c2":"=&v"(lo[ks]):"v"(vb),"i"(d0*4096+ks*1024):"memory");
      asm volatile("ds_read_b64_tr_b16 %0,%1 offset:%c2":"=&v"(hi[ks]):"v"(vb),"i"(d0*4096+ks*1024+512):"memory");}
    asm volatile("s_waitcnt lgkmcnt(0)":::"memory");SBAR();
    #define PK(k) (bf16x8){lo[k][0],lo[k][1],lo[k][2],lo[k][3],hi[k][0],hi[k][1],hi[k][2],hi[k][3]}
    o[d0]=__builtin_amdgcn_mfma_f32_32x32x16_bf16(pa0,PK(0),o[d0],0,0,0);
    o[d0]=__builtin_amdgcn_mfma_f32_32x32x16_bf16(pa1,PK(1),o[d0],0,0,0);
    o[d0]=__builtin_amdgcn_mfma_f32_32x32x16_bf16(pa2,PK(2),o[d0],0,0,0);
    o[d0]=__builtin_amdgcn_mfma_f32_32x32x16_bf16(pa3,PK(3),o[d0],0,0,0);
    #undef PK
  }
}

#ifndef ATTN_STORE16
#define ATTN_STORE16(p,v) (*(u32x4*)(p)=(v))
#endif
template<int THRL> __device__ __forceinline__ void attn_unit(int b,int h,int qb,const bf16*Q,const bf16*__restrict__ K,const bf16*__restrict__ V,bf16*O,char*shm,const float*__restrict__ kmean,const int wid){
  const int lane=lane_id(),r32=lane&31,hi=lane>>5;
  const long rowbase=(long)b*SEQ; const int q0=qb*QB;
  const bf16*Qw=Q+(rowbase+q0+wid*QBLK)*DM+h*D;
  const bf16*Kh=K+rowbase*DM+h*D,*Vh=V+rowbase*DM+h*D;
  const unsigned lds0=(unsigned)(uintptr_t)shm;
  float*wsf=(float*)(shm+LDS_WS)+wid*64;
  const bf16*ksrc=Kh+(long)lane*DM+wid*8;
  const bf16*vsrc=Vh+(long)(16*(wid&3)+(lane>>2))*DM+(wid>>2)*32+(lane&3)*8;
  const unsigned kdst=lds0+LDS_K+wid*1024, vdst=lds0+LDS_V+wid*1024;
  #define DMA_K(t,slot) glds16(ksrc+(long)(t)*KVBLK*DM,(unsigned)__builtin_amdgcn_readfirstlane(kdst+(slot)))
  #define DMA_V(t,slot) glds16(vsrc+(long)(t)*KVBLK*DM,(unsigned)__builtin_amdgcn_readfirstlane(vdst+(slot)))
  const int vb0=(int)(lds0+LDS_V)+((lane>>4)&1)*32+(lane&3)*8+(4*hi+((lane&15)>>2))*64;
  const char*Kbase=shm+LDS_K; bf16x8 kf[8];
  const lds_cptr shm3=(lds_cptr)shm; const lds_cptr kp0=shm3+LDS_K+hi*1024+r32*16; const lds_cptr vp0=shm3+LDS_V+((lane>>4)&1)*32+(lane&3)*8+(4*hi+((lane&15)>>2))*64;
  const int NT=(q0+QB)/KVBLK;
  DMA_K(0,0);DMA_V(0,0);DMA_K(1,SLOTB);
  bf16x8 qr[4];
  #pragma unroll
  for(int d0=0;d0<4;++d0)qr[d0]=*reinterpret_cast<const bf16x8*>(&Qw[(long)r32*DM+d0*16+hi*8]);
  unsigned sel=0xffu;
  if(qb>3){
    float g[8];
    #pragma unroll
    for(int blk=0;blk<7;++blk){ float sdot=0.f;
      if(blk<qb){ const float*km=kmean+((long)(b*NHEAD+h)*8+blk)*64+hi*8;
        #pragma unroll
        for(int d0=0;d0<4;++d0){ const float4 ka=*(const float4*)(km+d0*16), kb=*(const float4*)(km+d0*16+4); const bf16x8 qv=qr[d0];
          sdot+=__uint_as_float((unsigned)(unsigned short)qv[0]<<16)*ka.x+__uint_as_float((unsigned)(unsigned short)qv[1]<<16)*ka.y+__uint_as_float((unsigned)(unsigned short)qv[2]<<16)*ka.z+__uint_as_float((unsigned)(unsigned short)qv[3]<<16)*ka.w
               +__uint_as_float((unsigned)(unsigned short)qv[4]<<16)*kb.x+__uint_as_float((unsigned)(unsigned short)qv[5]<<16)*kb.y+__uint_as_float((unsigned)(unsigned short)qv[6]<<16)*kb.z+__uint_as_float((unsigned)(unsigned short)qv[7]<<16)*kb.w; }
        auto rr=__builtin_amdgcn_permlane32_swap(__float_as_uint(sdot),__float_as_uint(sdot),false,false); sdot=__uint_as_float(rr[0])+__uint_as_float(rr[1]); }
      g[blk]=blk<qb?sdot:-INFINITY; }
    g[7]=-INFINITY; sel=0u;
    #pragma unroll
    for(int rnd=0;rnd<3;++rnd){ float best=-INFINITY; int bi=-1;
      #pragma unroll
      for(int blk=0;blk<8;++blk){ const bool ok=!((sel>>blk)&1u)&&g[blk]>best; if(ok){best=g[blk];bi=blk;} }
      if(bi>=0)sel|=1u<<bi; }
  }
  #define BMASK(P0,P1,t) do{ const int blk_=(t)>>2; if(blk_<qb){ if(!((sel>>blk_)&1u)){ _Pragma("unroll") for(int r=0;r<16;++r){P0[r]=-1000.f;P1[r]=-1000.f;} } } }while(0)
  float mhat=0.f,l_reg=0.f;f32x16 o[2];o[0]=f32x16{};o[1]=f32x16{};const f32x16 zero16=f32x16{};
  const int qrel=wid*QBLK+r32;
  #define CMASK(P0,P1,t) do{int jb_=(t)-(NT-4); if(jb_>=0)cmask(P0,P1,jb_,qrel,hi);}while(0)
  bool resc=false;
  #define START(P0,P1) do{ const float rm=rowmax(P0,P1); resc=false; \
    { const float dl=rm; mhat=fadd_s(mhat,dl); \
      _Pragma("unroll") for(int r=0;r<16;++r){P0[r]=fsub_s(P0[r],dl);P1[r]=fsub_s(P1[r],dl);} \
      } \
    _Pragma("unroll") for(int r=0;r<16;++r)P0[r]=__builtin_amdgcn_exp2f(P0[r]); }while(0)
  #define RESC() do{ if(resc){ asm volatile("s_waitcnt lgkmcnt(0)":::"memory"); \
      _Pragma("unroll") for(int d_=0;d_<2;++d_) _Pragma("unroll") for(int r=0;r<16;++r)o[d_][r]*=wsf[crow(r,hi)]; } }while(0)
  f32x16 pA0,pA1,pB0,pB1;
  int sl_prev=0,sl_cur=0,sl_next=SLOTB;
  #define ROT() do{sl_prev=sl_cur;sl_cur=sl_next;sl_next=(sl_next==(NSLOT-1)*SLOTB)?0:sl_next+SLOTB;}while(0)
  DMA_K(2,2*SLOTB);
  WAIT_BAR(3);
  qkt(pA0,pA1,Kbase,qr,zero16,r32,hi);asm volatile("s_nop 15\n\ts_nop 7":"+v"(pA0),"+v"(pA1));CMASK(pA0,pA1,0);BMASK(pA0,pA1,0);
  START(pA0,pA1);
  _Pragma("unroll") for(int r=0;r<16;++r)pA1[r]=__builtin_amdgcn_exp2f(pA1[r]);
  WAIT_BAR(0);
  DMA_K(3,0);DMA_V(1,SLOTB);
  ROT();
  kload8(kf,kp0+sl_cur);
  WAIT_BAR(2);
  s16x4 vlo[8],vhi[8]; u32x4 pw0,pw1,pw2,pw3;
  #define PKW(P,B) cvtpk_s(P[B],P[B+1])
  #define PAF(k) __builtin_bit_cast(bf16x8,pw##k)
  #define VFR(i) (bf16x8){vlo[i][0],vlo[i][1],vlo[i][2],vlo[i][3],vhi[i][0],vhi[i][1],vhi[i][2],vhi[i][3]}
  #define PIN(x) asm volatile("":"+v"(x))
  #define MX3(a,b,c) __builtin_fmaxf(__builtin_fmaxf((a),(b)),(c))
  #define GAPA(MF,A0,A1,A2,A3,W0,W1,PW) do{ MF; sacc+=A0; sacc+=A1; sacc+=A2; sacc+=A3; PIN(sacc); W0; W1; PIN(PW); SBAR(); }while(0)
  #define EX(v) __builtin_amdgcn_exp2f(v)
  #define GAPB(MF,X,B) do{ MF; X[B]=EX(X[B]); X[B+1]=EX(X[B+1]); X[B+2]=EX(X[B+2]); X[B+3]=EX(X[B+3]); PIN(X); SBAR(); }while(0)
  #define VRD(i) do{ vlo[i]=vtr(vp_+(((i)>>2)*4096+((i)&3)*1024)); vhi[i]=vtr(vp_+(((i)>>2)*4096+((i)&3)*1024+512)); }while(0)
  #define KRD(G,j) do{ if(G){ kload2(kf,kp0+sl_next,j); SBAR(); } }while(0)
  #define STEP(C0,C1,P0,P1,t,GK,GV,GL) do{ SBAR(); \
    const lds_cptr vp_=vp0+sl_prev; \
    float sacc=(P0[0]+P0[1]); \
    GAPA(C0=__builtin_amdgcn_mfma_f32_32x32x16_bf16(kf[0],qr[0],zero16,0,0,0), P0[2],P0[3],P0[4],P0[5],     pw0[0]=PKW(P0,0), pw0[1]=PKW(P0,2), pw0); \
    GAPA(C1=__builtin_amdgcn_mfma_f32_32x32x16_bf16(kf[1],qr[0],zero16,0,0,0), P0[6],P0[7],P0[8],P0[9],     pw0[2]=PKW(P0,4), pw0[3]=PKW(P0,6), pw0); \
    GAPA(C0=__builtin_amdgcn_mfma_f32_32x32x16_bf16(kf[2],qr[1],C0,0,0,0),   P0[10],P0[11],P0[12],P0[13], pw1[0]=PKW(P0,8), pw1[1]=PKW(P0,10), pw1); \
    GAPA(C1=__builtin_amdgcn_mfma_f32_32x32x16_bf16(kf[3],qr[1],C1,0,0,0),   P0[14],P0[15],P1[0],P1[1],   pw1[2]=PKW(P0,12),pw1[3]=PKW(P0,14), pw1); \
    GAPA(C0=__builtin_amdgcn_mfma_f32_32x32x16_bf16(kf[4],qr[2],C0,0,0,0),   P1[2],P1[3],P1[4],P1[5],     pw2[0]=PKW(P1,0), pw2[1]=PKW(P1,2), pw2); \
    GAPA(C1=__builtin_amdgcn_mfma_f32_32x32x16_bf16(kf[5],qr[2],C1,0,0,0),   P1[6],P1[7],P1[8],P1[9],     pw2[2]=PKW(P1,4), pw2[3]=PKW(P1,6), pw2); \
    VRD(0); SBAR(); GAPA(C0=__builtin_amdgcn_mfma_f32_32x32x16_bf16(kf[6],qr[3],C0,0,0,0),   P1[10],P1[11],P1[12],P1[13], pw3[0]=PKW(P1,8), pw3[1]=PKW(P1,10), pw3); \
    VRD(4); SBAR(); GAPA(C1=__builtin_amdgcn_mfma_f32_32x32x16_bf16(kf[7],qr[3],C1,0,0,0),   P1[14],P1[15],0.f,0.f,       pw3[2]=PKW(P1,12),pw3[3]=PKW(P1,14), pw3); \
    l_reg+=sacc; \
    _Pragma("unroll") for(int r=0;r<16;++r){C0[r]-=mhat;C1[r]-=mhat;} \
    if(GK){DMA_K((t)+3,sl_cur);} if(GV){DMA_V((t)+1,sl_next);} \
    CMASK(C0,C1,t); BMASK(C0,C1,t); \
    { float a=MX3(C0[0],C0[1],C1[0]),b=MX3(C0[2],C0[3],C1[1]); a=MX3(a,C1[2],C1[3]); \
      _Pragma("unroll") for(int r=4;r<16;r+=4){a=MX3(a,C0[r],C0[r+1]);b=MX3(b,C0[r+2],C0[r+3]);a=MX3(a,C1[r],C1[r+1]);b=MX3(b,C1[r+2],C1[r+3]);} \
      float rm=__builtin_fmaxf(a,b); { auto rr=__builtin_amdgcn_permlane32_swap(__float_as_uint(rm),__float_as_uint(rm),false,false); rm=__builtin_fmaxf(__uint_as_float(rr[0]),__uint_as_float(rr[1])); } \
      resc=false; \
      if(__builtin_expect(__any(rm>(float)THRL),0)){ const float dl=__builtin_fmaxf(rm,0.f); mhat+=dl; \
        _Pragma("unroll") for(int r=0;r<16;++r){C0[r]-=dl;C1[r]-=dl;} \
        const float f=__builtin_amdgcn_exp2f(-dl); l_reg*=f; if(hi==0)wsf[r32]=f; resc=true; } } \
    SBAR(); \
    VRD(1); SBAR(); GAPB(o[0]=__builtin_amdgcn_mfma_f32_32x32x16_bf16(PAF(0),VFR(0),o[0],0,0,0), C0,0); \
    VRD(5); SBAR(); GAPB(o[1]=__builtin_amdgcn_mfma_f32_32x32x16_bf16(PAF(0),VFR(4),o[1],0,0,0), C0,4); \
    VRD(2); SBAR(); KRD(GL,0); GAPB(o[0]=__builtin_amdgcn_mfma_f32_32x32x16_bf16(PAF(1),VFR(1),o[0],0,0,0), C0,8); \
    VRD(6); SBAR(); KRD(GL,1); GAPB(o[1]=__builtin_amdgcn_mfma_f32_32x32x16_bf16(PAF(1),VFR(5),o[1],0,0,0), C0,12); \
    VRD(3); SBAR(); KRD(GL,2); GAPB(o[0]=__builtin_amdgcn_mfma_f32_32x32x16_bf16(PAF(2),VFR(2),o[0],0,0,0), C1,0); \
    VRD(7); SBAR(); KRD(GL,3); GAPB(o[1]=__builtin_amdgcn_mfma_f32_32x32x16_bf16(PAF(2),VFR(6),o[1],0,0,0), C1,4); \
    GAPB(o[0]=__builtin_amdgcn_mfma_f32_32x32x16_bf16(PAF(3),VFR(3),o[0],0,0,0), C1,8); \
    GAPB(o[1]=__builtin_amdgcn_mfma_f32_32x32x16_bf16(PAF(3),VFR(7),o[1],0,0,0), C1,12); \
    }while(0)
  int t=1;
  #undef CMASK
  #define CMASK(P0,P1,t) do{}while(0)
  for(;t+5<NT;t+=2){
    STEP(pB0,pB1,pA0,pA1,t,true,true,true);     WAIT_BAR(2); RESC(); ROT();
    STEP(pA0,pA1,pB0,pB1,t+1,true,true,true);   WAIT_BAR(2); RESC(); ROT();
  }
  #undef CMASK
  const int laneB=lane_id(); const int qrelB=wid*QBLK+(laneB&31), hiB=laneB>>5;
  #define CMASK(P0,P1,t) do{int jb_=(t)-(NT-4); if(jb_>=0)cmask(P0,P1,jb_,qrelB,hiB);}while(0)
  #define ENDW(tt) do{ if((tt)+3<NT){WAIT_BAR(2);} else if((tt)+2<NT){WAIT_BAR(1);} else {WAIT_BAR(0);} }while(0)
  for(;t+1<NT;t+=2){
    STEP(pB0,pB1,pA0,pA1,t,(t+3<NT),(t+1<NT),(t+1<NT));       ENDW(t);   RESC(); ROT();
    STEP(pA0,pA1,pB0,pB1,t+1,(t+4<NT),(t+2<NT),(t+2<NT));     ENDW(t+1); RESC(); ROT();
  }
  STEP(pB0,pB1,pA0,pA1,NT-1,false,false,false); RESC();
  { float sacc=pB0[0]+pB0[1]; _Pragma("unroll") for(int r=2;r<16;++r)sacc+=pB0[r]; _Pragma("unroll") for(int r=0;r<16;++r)sacc+=pB1[r]; l_reg+=sacc;
    pw0=(u32x4){PKW(pB0,0),PKW(pB0,2),PKW(pB0,4),PKW(pB0,6)};pw1=(u32x4){PKW(pB0,8),PKW(pB0,10),PKW(pB0,12),PKW(pB0,14)};pw2=(u32x4){PKW(pB1,0),PKW(pB1,2),PKW(pB1,4),PKW(pB1,6)};pw3=(u32x4){PKW(pB1,8),PKW(pB1,10),PKW(pB1,12),PKW(pB1,14)};
    SBAR(); pv(o,vb0+sl_cur,PAF(0),PAF(1),PAF(2),PAF(3)); }
  #undef PKW
  #undef PAF
  #undef VFR
  #undef PIN
  #undef MX3
  #undef GAPA
  #undef GAPB
  #undef EX
  #undef VRD
  #undef KRD
  #undef STEP
  #undef ENDW
  {auto rr=__builtin_amdgcn_permlane32_swap(__float_as_uint(l_reg),__float_as_uint(l_reg),false,false);l_reg=__uint_as_float(rr[0])+__uint_as_float(rr[1]);}
  const int laneE=lane_id(); const int r32E=laneE&31, hiE=laneE>>5; float*wsfE=(float*)(shm+LDS_WS)+wid*64;
  if(hiE==0)wsfE[32+r32E]=l_reg;asm volatile("s_waitcnt lgkmcnt(0)":::"memory");
  float rli[16];
  #pragma unroll
  for(int r=0;r<16;++r)rli[r]=__builtin_amdgcn_rcpf(wsfE[32+crow(r,hiE)]);
  bf16*Ow=O+(rowbase+q0+wid*QBLK)*DM+h*D;
  { bf16*stg=(bf16*)(shm+LDS_OST)+wid*2048;
    #pragma unroll
    for(int r=0;r<16;++r){const int orow=crow(r,hiE);
      #pragma unroll
      for(int d0=0;d0<2;++d0)stg[orow*64+d0*32+r32E]=__float2bfloat16(o[d0][r]*rli[r]);}
    asm volatile("s_waitcnt lgkmcnt(0)":::"memory");
    #pragma unroll
    for(int i=0;i<4;++i){const int row=i*8+(laneE>>3),ch=laneE&7; const u32x4 v=*(const u32x4*)(stg+row*64+ch*8); ATTN_STORE16(Ow+(long)row*DM+ch*8,v);} }
  asm volatile("s_waitcnt lgkmcnt(0)\n\ts_barrier":::"memory");
  #undef BMASK
  #undef DMA_K
  #undef DMA_V
  #undef CMASK
  #undef START
  #undef RESC
  #undef ROT
}
constexpr int ATTN_LDS_BYTES=LDS_BYTES;
struct AttnTensors { const bf16* Q; const bf16* K; const bf16* V; bf16* O; };
struct AttnUnit { int bh; int qb; };
struct StaticOrder {
  int vcu,G;
  __device__ __forceinline__ explicit StaticOrder(int grid,int block):vcu((grid%8==0)?(block%8)*(grid/8)+block/8:block),G(grid){}
  __device__ __forceinline__ bool next(int i,AttnUnit&u)const{ const int v=vcu+G*(i>>1); if(v>=256)return false; const int s=v&3; u.bh=v>>2; u.qb=(i&1)?7-s:s; return true; }
  __device__ __forceinline__ void a_ready(const AttnUnit&)const{}
  __device__ __forceinline__ void done(const AttnUnit&)const{}
};
template<class Sched,int THRL=8> __device__ __forceinline__ void attn_phase(char*lds,const AttnTensors&T,const Sched&S,const float*kmean,const int wid){
  AttnUnit u;
  for(int i=0;S.next(i,u);++i){ S.a_ready(u); attn_unit<THRL>(u.bh/NHEAD,u.bh%NHEAD,u.qb,T.Q,T.K,T.V,T.O,lds,kmean,wid); S.done(u); }
}
#undef SBAR
#undef WAIT_BAR
}
typedef unsigned v2u __attribute__((ext_vector_type(2)));
__device__ __forceinline__ float bf2f(bf16 v) { return __uint_as_float((unsigned)v << 16); }
__device__ __forceinline__ float sigmoidf_(float x) { return 1.0f / (1.0f + __expf(-x)); }
__device__ __forceinline__ float wave_sum(float v) {
#pragma unroll
    for (int o = 1; o < 64; o <<= 1) v += __shfl_xor(v, o);
    return v;
}
__device__ __forceinline__ void load64(const bf16* p, float (&x)[64]) {
#pragma unroll
    for (int i = 0; i < 8; ++i) { const uint4 v = ((const uint4*)p)[i];
        x[8 * i + 0] = __uint_as_float(v.x << 16); x[8 * i + 1] = __uint_as_float(v.x & 0xffff0000u);
        x[8 * i + 2] = __uint_as_float(v.y << 16); x[8 * i + 3] = __uint_as_float(v.y & 0xffff0000u);
        x[8 * i + 4] = __uint_as_float(v.z << 16); x[8 * i + 5] = __uint_as_float(v.z & 0xffff0000u);
        x[8 * i + 6] = __uint_as_float(v.w << 16); x[8 * i + 7] = __uint_as_float(v.w & 0xffff0000u); }
}
__device__ __forceinline__ void store64(bf16* p, const float (&x)[64]) {
#pragma unroll
    for (int i = 0; i < 8; ++i) { uint4 v;
        v.x = pk2(x[8 * i + 0], x[8 * i + 1]); v.y = pk2(x[8 * i + 2], x[8 * i + 3]); v.z = pk2(x[8 * i + 4], x[8 * i + 5]); v.w = pk2(x[8 * i + 6], x[8 * i + 7]);
        ((uint4*)p)[i] = v; }
}
constexpr int NWAVES = 8;
constexpr int RING_OFF = 0, RING_BYTES = 131072, LDSCTL_OFF = RING_BYTES, MISC_OFF = LDSCTL_OFF + 320, LDS_BYTES = 147456;
constexpr int CW_TMO = 0, CW_CODE = 1, CW_BAR = 4096;
__device__ __forceinline__ const void* karg_ptr(int i) { const void* const volatile __attribute__((address_space(4)))* k = (const void* const volatile __attribute__((address_space(4)))*)__builtin_amdgcn_kernarg_segment_ptr(); return k[i]; }
#define KARG(i) karg_ptr(i)
struct Args { const void* in[18]; float* out; unsigned char* ws; int layer, ph_lo, ph_hi, pad; };
struct Frame {
    LAS unsigned char* lds; volatile LAS unsigned* MISC; gu32* ctl;
    int wave, vcu, G;
};
__device__ __forceinline__ void tr_item(const float* src, int ld, int k0, int nsrc0, bf16* dst, int Kdim, int ndst0, LAS float* scr, int lane) {
#pragma unroll 8
    for (int i = 0; i < 32; ++i) { const int kk = 2 * i + (lane >> 5); scr[kk * 33 + (lane & 31)] = src[(size_t)(k0 + kk) * ld + nsrc0 + (lane & 31)]; }
    LDS_WAIT(); asm volatile("" ::: "memory");
    const int c = lane & 7;
#pragma unroll
    for (int j = 0; j < 4; ++j) { const int n = (lane >> 3) + 8 * j; const LAS float* s = scr + (8 * c) * 33 + n;
        v4u o; o.x = pk2(s[0 * 33], s[1 * 33]); o.y = pk2(s[2 * 33], s[3 * 33]); o.z = pk2(s[4 * 33], s[5 * 33]); o.w = pk2(s[6 * 33], s[7 * 33]);
        *(GAS v4u*)(dst + (size_t)(ndst0 + n) * Kdim + k0 + 8 * c) = o; }
    LDS_WAIT(); asm volatile("" ::: "memory");
}
__device__ __forceinline__ int win_remap(int nd) { return nd < 3072 ? nd : (nd < 3584 ? nd + 1536 : (nd < 4096 ? nd + 512 : (nd < 5120 ? nd - 1024 : nd + 8))); }

template <bool ADD_MOE> __device__ __forceinline__ void p0_prologue(Frame& F, const Args& a, const int l, const float* xin) {
    const int LANE_ = lane_id(), TID_ = F.wave * 64 + LANE_; (void)TID_;
    LAS float* scr = (LAS float*)(F.lds + RING_OFF + F.wave * 16384);
    const int gw = F.vcu * NWAVES + F.wave, NGW = F.G * NWAVES;
    const float* w_in = (const float*)KARG(3) + (size_t)l * DM * PIN; const float* w_br = (const float*)KARG(8) + (size_t)l * 3 * 512 * 1024; const float* w_out = (const float*)KARG(9) + (size_t)l * DM * DM;
    bf16* WT_IN = (bf16*)(((unsigned char*)KARG(19)) + WS_WTIN); bf16* WT_BR = (bf16*)(((unsigned char*)KARG(19)) + WS_WTBR); bf16* WT_OUT = (bf16*)(((unsigned char*)KARG(19)) + WS_WTOUT);
    constexpr int I_IN = 16 * 256, I_BR = 3 * 256, I_OUT = 16 * 32, NITEMS = I_IN + I_BR + I_OUT;
    for (int it = gw; it < NITEMS; it += NGW) {
        int r = it;
        if (r < I_IN) { const int kb = r >> 8, nb = r & 255; tr_item(w_in, PIN, 64 * kb, win_remap(32 * nb), WT_IN, DM, 32 * nb, scr, LANE_); continue; } r -= I_IN;
        if (r < I_BR) { const int n = r >> 8, rr = r & 255, kb = rr >> 5, nb = rr & 31; tr_item(w_br + (size_t)n * 512 * 1024, 1024, 64 * kb, 32 * nb, WT_BR + (size_t)n * 1024 * 512, 512, 32 * nb, scr, LANE_); continue; } r -= I_BR;
        { const int kb = r >> 5, nb = r & 31; tr_item(w_out, 1024, 64 * kb, 32 * nb, WT_OUT, DM, 32 * nb, scr, LANE_); }
    }
    const float* g1 = (const float*)KARG(2) + l * DM; const float* gate_b = (const float*)KARG(7) + l * 8;
    bf16* XN = (bf16*)(((unsigned char*)KARG(19)) + WS_XN); float* IFPRE = (float*)(((unsigned char*)KARG(19)) + WS_IFPRE);
    for (int m = gw; m < M; m += NGW) {
        const GAS f32x4* xr = (const GAS f32x4*)(xin + (size_t)m * DM) + LANE_;
        f32x4 v[4]; float s = 0.f;
#pragma unroll
        for (int j = 0; j < 4; ++j) v[j] = xr[64 * j];
        if (ADD_MOE) {
            const GAS v2u* y0 = (const GAS v2u*)(((unsigned char*)KARG(19)) + WS_YP + (size_t)(2 * m) * 2048) + LANE_; const GAS v2u* y1 = (const GAS v2u*)(((unsigned char*)KARG(19)) + WS_YP + (size_t)(2 * m + 1) * 2048) + LANE_;
#pragma unroll
            for (int j = 0; j < 4; ++j) { const v2u p0 = y0[64 * j], p1 = y1[64 * j];
                v[j].x += __uint_as_float(p0.x << 16) + __uint_as_float(p1.x << 16); v[j].y += __uint_as_float(p0.x & 0xffff0000u) + __uint_as_float(p1.x & 0xffff0000u);
                v[j].z += __uint_as_float(p0.y << 16) + __uint_as_float(p1.y << 16); v[j].w += __uint_as_float(p0.y & 0xffff0000u) + __uint_as_float(p1.y & 0xffff0000u);
                ((GAS f32x4*)(((float*)KARG(18)) + (size_t)m * DM))[LANE_ + 64 * j] = v[j]; }
        }
#pragma unroll
        for (int j = 0; j < 4; ++j) s += (v[j].x * v[j].x + v[j].y * v[j].y) + (v[j].z * v[j].z + v[j].w * v[j].w);
#pragma unroll
        for (int o = 1; o < 64; o <<= 1) s += __shfl_xor(s, o);
        const float rs = rsqrtf(s * (1.f / DM) + RMS_EPS);
        float ip[8];
#pragma unroll
        for (int o = 0; o < 8; ++o) ip[o] = 0.f;
        GAS unsigned long long* o8 = (GAS unsigned long long*)(XN + (size_t)m * DM) + LANE_;
#pragma unroll
        for (int j = 0; j < 4; ++j) { const f32x4 gg = ((const GAS f32x4*)g1)[LANE_ + 64 * j]; v[j] = v[j] * rs * gg;
            o8[64 * j] = (unsigned long long)pk2(v[j].x, v[j].y) | ((unsigned long long)pk2(v[j].z, v[j].w) << 32);
#pragma unroll
            for (int u = 0; u < 4; ++u) { const int d = (LANE_ + 64 * j) * 4 + u; const float xv = v[j][u];
                const f32x4 wa = *(const GAS f32x4*)(w_in + (size_t)d * PIN + 5120), wb = *(const GAS f32x4*)(w_in + (size_t)d * PIN + 5124);
                ip[0] += xv * wa.x; ip[1] += xv * wa.y; ip[2] += xv * wa.z; ip[3] += xv * wa.w; ip[4] += xv * wb.x; ip[5] += xv * wb.y; ip[6] += xv * wb.z; ip[7] += xv * wb.w; } }
#pragma unroll
        for (int o = 0; o < 8; ++o) {
#pragma unroll
            for (int sft = 1; sft < 64; sft <<= 1) ip[o] += __shfl_xor(ip[o], sft); }
        float val = ip[0];
#pragma unroll
        for (int o = 1; o < 8; ++o) val = LANE_ == o ? ip[o] : val;
        if (LANE_ < 8) IFPRE[(size_t)m * 8 + LANE_] = val + gate_b[LANE_];
    }
}


__device__ __forceinline__ float dot64(const float (&q)[64], const bf16* p) {
    float z = 0.f;
#pragma unroll
    for (int i = 0; i < 8; ++i) { const uint4 v = ((const uint4*)p)[i];
        z += q[8 * i + 0] * __uint_as_float(v.x << 16) + q[8 * i + 1] * __uint_as_float(v.x & 0xffff0000u) + q[8 * i + 2] * __uint_as_float(v.y << 16) + q[8 * i + 3] * __uint_as_float(v.y & 0xffff0000u)
           + q[8 * i + 4] * __uint_as_float(v.z << 16) + q[8 * i + 5] * __uint_as_float(v.z & 0xffff0000u) + q[8 * i + 6] * __uint_as_float(v.w << 16) + q[8 * i + 7] * __uint_as_float(v.w & 0xffff0000u);
        asm volatile("" ::: "memory"); }
    return z;
}
__device__ __forceinline__ void axpy64(float (&acc)[64], float sc, float p, const bf16* vp) {
#pragma unroll
    for (int i = 0; i < 8; ++i) { const uint4 v = ((const uint4*)vp)[i];
        acc[8 * i + 0] = acc[8 * i + 0] * sc + p * __uint_as_float(v.x << 16); acc[8 * i + 1] = acc[8 * i + 1] * sc + p * __uint_as_float(v.x & 0xffff0000u);
        acc[8 * i + 2] = acc[8 * i + 2] * sc + p * __uint_as_float(v.y << 16); acc[8 * i + 3] = acc[8 * i + 3] * sc + p * __uint_as_float(v.y & 0xffff0000u);
        acc[8 * i + 4] = acc[8 * i + 4] * sc + p * __uint_as_float(v.z << 16); acc[8 * i + 5] = acc[8 * i + 5] * sc + p * __uint_as_float(v.z & 0xffff0000u);
        acc[8 * i + 6] = acc[8 * i + 6] * sc + p * __uint_as_float(v.w << 16); acc[8 * i + 7] = acc[8 * i + 7] * sc + p * __uint_as_float(v.w & 0xffff0000u);
        asm volatile("" ::: "memory"); }
}

__device__ __forceinline__ void ph_prep_qk(Frame& F, const Args& a, const int l) {
    const int LANE_ = lane_id(), TID_ = F.wave * 64 + LANE_; (void)TID_;
    bf16* mbq = (bf16*)(((unsigned char*)KARG(19)) + WS_MBQ); bf16* mbk = (bf16*)(((unsigned char*)KARG(19)) + WS_MBK);
    const float* qn_g = (const float*)KARG(4) + l * 64; const float* kn_g = (const float*)KARG(5) + l * 64; const int* positions = (const int*)KARG(1);
    for (int idx = blockIdx.x * 512 + TID_; idx < M * 16; idx += F.G * 512) {
        const int row = idx >> 4, hh = idx & 15, which = hh >> 3, h = hh & 7;
        bf16* p = (which ? mbk : mbq) + (size_t)row * 512 + h * 64; const float* g = which ? kn_g : qn_g;
        float x[64]; load64(p, x);
        float ss = 0.f;
#pragma unroll
        for (int i = 0; i < 64; ++i) ss += x[i] * x[i];
        const float r = rsqrtf(ss * (1.f / 64.f) + RMS_EPS);
#pragma unroll
        for (int i = 0; i < 64; ++i) x[i] = x[i] * r * g[i];
        const double pos = (double)positions[row];
        const double invf[8] = {1.0, 0.19392274474868576, 0.03760603093086393, 0.007292664737217109, 0.001414213562373095, 0.0002742481756762073, 5.318295896944988e-05, 1.031338537721246e-05};
#pragma unroll
        for (int i = 0; i < 8; ++i) {
            double rev = pos * invf[i] * 0.15915494309189535; rev -= floor(rev);
            const float fr = (float)rev; const float sn = __builtin_amdgcn_sinf(fr), cs = __builtin_amdgcn_cosf(fr);
            const float x1 = x[i], x2 = x[i + 8]; x[i] = x1 * cs - x2 * sn; x[i + 8] = x1 * sn + x2 * cs;
        }
        if (!which) {
#pragma unroll
            for (int i = 0; i < 64; ++i) x[i] *= C2;
        }
        store64(p, x);
    }
}
__device__ __forceinline__ void ph_conv(Frame& F, const Args& a, const int l) {
    const int LANE_ = lane_id(), TID_ = F.wave * 64 + LANE_; (void)TID_;
    const bf16* mlqk = (const bf16*)(((unsigned char*)KARG(19)) + WS_MLQK); const float* cw = (const float*)KARG(6) + l * 4 * 1024;
    bf16* q2 = (bf16*)(((unsigned char*)KARG(19)) + WS_MLQ2); bf16* k2 = (bf16*)(((unsigned char*)KARG(19)) + WS_MLK2);
    for (size_t idx = (size_t)blockIdx.x * 512 + TID_; idx < (size_t)M * 1024; idx += (size_t)F.G * 512) {
        const int c = (int)(idx & 1023), row = (int)(idx >> 10), t = row & (SEQ - 1);
        float y = 0.f;
#pragma unroll
        for (int j = 0; j < 4; ++j) { const int tt = t - 3 + j; if (tt >= 0) y += cw[j * 1024 + c] * bf2f(mlqk[(size_t)(row - 3 + j) * 1024 + c]); }
        y = y * sigmoidf_(y);
        if (c < 512) q2[(size_t)row * 512 + c] = (bf16)f2bf(y); else k2[(size_t)row * 512 + c - 512] = (bf16)f2bf(y * 0.08838834764831845f);
    }
}
__device__ __forceinline__ void ph_kmean(Frame& F, const Args& a) {
    const int LANE_ = lane_id(), TID_ = F.wave * 64 + LANE_; (void)TID_;
    const bf16* mbk = (const bf16*)(((unsigned char*)KARG(19)) + WS_MBK); float* kmean = (float*)(((unsigned char*)KARG(19)) + WS_KMEAN);
    for (int idx = blockIdx.x * 512 + TID_; idx < 8 * 8 * 8 * 64; idx += F.G * 512) {
        const int d = idx & 63, blk = (idx >> 6) & 7, h = (idx >> 9) & 7, b = idx >> 12;
        float s = 0.f;
        for (int i = 0; i < 256; ++i) s += bf2f(mbk[(size_t)(b * SEQ + blk * 256 + i) * 512 + h * 64 + d]);
        kmean[idx] = s * (1.f / 256.f);
    }
}
__device__ __forceinline__ void ph_sb_naive(Frame& F, const Args& a) {
    const int LANE_ = lane_id(), TID_ = F.wave * 64 + LANE_; (void)TID_;
    bf16* sbq = (bf16*)(((unsigned char*)KARG(19)) + WS_SBQ); const bf16* sbk = (const bf16*)(((unsigned char*)KARG(19)) + WS_SBK); const bf16* sbv = (const bf16*)(((unsigned char*)KARG(19)) + WS_SBV);
    for (int idx = blockIdx.x * 512 + TID_; idx < M * 8; idx += F.G * 512) {
        const int row = idx >> 3, h = idx & 7, t = row & (SEQ - 1), base = row - t;
        float q[64], acc[64]; load64(sbq + (size_t)row * 512 + h * 64, q);
#pragma unroll
        for (int i = 0; i < 64; ++i) acc[i] = 0.f;
        float C = 0.f;
        for (int s = t - 1; s >= 0; --s) {
            const float z = dot64(q, sbk + (size_t)(base + s) * 512 + h * 64);
            const float sp = z > 0.f ? z + __log2f(1.f + exp2f(-z)) : __log2f(1.f + exp2f(z));
            C += sp; const float w = exp2f(z - C);
            axpy64(acc, 1.f, w, sbv + (size_t)(base + s) * 512 + h * 64);
            if (C > 150.f) break;
        }
        store64(sbq + (size_t)row * 512 + h * 64, acc);
    }
}
__device__ __forceinline__ void ph_moba_naive(Frame& F, const Args& a) {
    const int LANE_ = lane_id(), TID_ = F.wave * 64 + LANE_; (void)TID_;
    bf16* mbq = (bf16*)(((unsigned char*)KARG(19)) + WS_MBQ); const bf16* mbk = (const bf16*)(((unsigned char*)KARG(19)) + WS_MBK); const bf16* mbv = (const bf16*)(((unsigned char*)KARG(19)) + WS_MBV); const float* kmean = (const float*)(((unsigned char*)KARG(19)) + WS_KMEAN);
    for (int idx = blockIdx.x * 512 + TID_; idx < M * 8; idx += F.G * 512) {
        const int row = idx >> 3, h = idx & 7, t = row & (SEQ - 1), base = row - t, b = row >> 11, own = t >> 8;
        float q[64], acc[64]; load64(mbq + (size_t)row * 512 + h * 64, q);
#pragma unroll
        for (int i = 0; i < 64; ++i) acc[i] = 0.f;
        unsigned sel = 0u;
        {
            float g[8];
#pragma unroll
            for (int blk = 0; blk < 8; ++blk) { float s = 0.f; const float* km = kmean + ((size_t)(b * 8 + h) * 8 + blk) * 64;
#pragma unroll
                for (int i = 0; i < 64; ++i) s += q[i] * km[i];
                g[blk] = blk < own ? s : -INFINITY; }
#pragma unroll
            for (int r = 0; r < 3; ++r) { float best = -INFINITY; int bi = -1;
#pragma unroll
                for (int blk = 0; blk < 8; ++blk) { const bool ok = !((sel >> blk) & 1u) && g[blk] > best; if (ok) { best = g[blk]; bi = blk; } }
                if (bi >= 0) sel |= 1u << bi; }
        }
        sel |= 1u << own;
        float m = -INFINITY, lsum = 0.f;
        for (int blk = 0; blk <= own; ++blk) {
            if (!((sel >> blk) & 1u)) continue;
            const int s1 = blk == own ? t : blk * 256 + 255;
            for (int s = blk * 256; s <= s1; ++s) {
                const float z = dot64(q, mbk + (size_t)(base + s) * 512 + h * 64);
                const float mn = fmaxf(m, z), sc = exp2f(m - mn), p = exp2f(z - mn);
                lsum = lsum * sc + p;
                axpy64(acc, sc, p, mbv + (size_t)(base + s) * 512 + h * 64);
                m = mn;
            }
        }
        const float il = 1.f / lsum;
#pragma unroll
        for (int i = 0; i < 64; ++i) acc[i] *= il;
        store64(mbq + (size_t)row * 512 + h * 64, acc);
    }
}
__device__ __forceinline__ void ph_mlstm_naive(Frame& F, const Args& a) {
    const int LANE_ = lane_id(), TID_ = F.wave * 64 + LANE_; (void)TID_;
    const bf16* q2 = (const bf16*)(((unsigned char*)KARG(19)) + WS_MLQ2); const bf16* k2 = (const bf16*)(((unsigned char*)KARG(19)) + WS_MLK2); const bf16* mlv = (const bf16*)(((unsigned char*)KARG(19)) + WS_MLV); bf16* mlo = (bf16*)(((unsigned char*)KARG(19)) + WS_MLO);
    const float* ifpre = (const float*)(((unsigned char*)KARG(19)) + WS_IFPRE);
    for (int unit = blockIdx.x; unit < 32; unit += F.G) {
        const int b = unit >> 2, h = unit & 3, tid = TID_, e = tid >> 2, dq = tid & 3;
        float Cst[32], nst[32];
#pragma unroll
        for (int j = 0; j < 32; ++j) { Cst[j] = 0.f; nst[j] = 0.f; }
        float m = 0.f;
        for (int t = 0; t < SEQ; ++t) {
            const size_t row = (size_t)b * SEQ + t;
            const float li = ifpre[row * 8 + h], fp = ifpre[row * 8 + 4 + h];
            const float lf = fp >= 0.f ? -log1pf(__expf(-fp)) : fp - log1pf(__expf(fp));
            const float mn = fmaxf(lf + m, li), fd = __expf(lf + m - mn), ii = __expf(li - mn); m = mn;
            const bf16* kp = k2 + row * 512 + h * 128 + dq * 32; const bf16* qp = q2 + row * 512 + h * 128 + dq * 32;
            const float ve = bf2f(mlv[row * 512 + h * 128 + e]) * ii;
            float num = 0.f, den = 0.f;
#pragma unroll
            for (int c4 = 0; c4 < 4; ++c4) {
                const uint4 kv = ((const uint4*)kp)[c4], qv = ((const uint4*)qp)[c4];
                const unsigned ku[4] = {kv.x, kv.y, kv.z, kv.w}, qu[4] = {qv.x, qv.y, qv.z, qv.w};
#pragma unroll
                for (int u = 0; u < 4; ++u) {
                    const float k0 = __uint_as_float(ku[u] << 16), k1 = __uint_as_float(ku[u] & 0xffff0000u), q0 = __uint_as_float(qu[u] << 16), q1 = __uint_as_float(qu[u] & 0xffff0000u);
                    const int j = c4 * 8 + u * 2;
                    Cst[j] = fd * Cst[j] + ve * k0; Cst[j + 1] = fd * Cst[j + 1] + ve * k1;
                    nst[j] = fd * nst[j] + ii * k0; nst[j + 1] = fd * nst[j + 1] + ii * k1;
                    num += Cst[j] * q0 + Cst[j + 1] * q1; den += nst[j] * q0 + nst[j + 1] * q1;
                }
            }
            num += __shfl_xor(num, 1); num += __shfl_xor(num, 2); den += __shfl_xor(den, 1); den += __shfl_xor(den, 2);
            const float o = num / fmaxf(fabsf(den), __expf(-m));
            if (dq == 0) { bf16* op = mlo + row * 512 + h * 128 + e; *op = (bf16)f2bf(o * sigmoidf_(bf2f(*op))); }
        }
    }
}
__device__ __forceinline__ void ph_router(Frame& F, const Args& a, const int l) {
    const int LANE_ = lane_id(), TID_ = F.wave * 64 + LANE_; (void)TID_;
    const float* hin = ((float*)KARG(18)); const float* g2 = (const float*)KARG(10) + l * DM; const float* w_rg = (const float*)KARG(11) + (size_t)l * DM * 4; const float* b_rg = (const float*)KARG(12) + l * 4;
    const float* w_re = (const float*)KARG(13) + (size_t)l * DM * 32; const float* b_re = (const float*)KARG(14) + l * 32;
    bf16* xn2 = (bf16*)(((unsigned char*)KARG(19)) + WS_XN2); int* re = (int*)(((unsigned char*)KARG(19)) + WS_RE); float* rw = (float*)(((unsigned char*)KARG(19)) + WS_RW); int* rank = (int*)(((unsigned char*)KARG(19)) + WS_RANK); unsigned* cnt = (unsigned*)(F.ctl + CW_CNT + 64 * l);
    const int lane = LANE_, r8 = lane >> 3, part = lane & 7, gw = F.vcu * NWAVES + F.wave, NGW = F.G * NWAVES;
    for (int grp = gw; grp < M / 8; grp += NGW) {
        const int row = grp * 8 + r8;
        const float* xp = hin + (size_t)row * DM + 4 * part; const float* gp = g2 + 4 * part; const float* wgp = w_rg + (size_t)(4 * part) * 4; const float* wep = w_re + (size_t)(4 * part) * 32;
        float lg[36]; float ss = 0.f;
#pragma unroll
        for (int o = 0; o < 36; ++o) lg[o] = 0.f;
#pragma unroll 1
        for (int c = 0; c < 32; ++c) {
            const f32x4 x4 = *(const GAS f32x4*)(xp + 32 * c), g4 = *(const GAS f32x4*)(gp + 32 * c);
            ss += (x4.x * x4.x + x4.y * x4.y) + (x4.z * x4.z + x4.w * x4.w);
            const f32x4 xg = x4 * g4;
#pragma unroll
            for (int u = 0; u < 4; ++u) { const float xv = xg[u];
                const f32x4 wg = *(const GAS f32x4*)(wgp + (size_t)(32 * c + u) * 4); lg[0] += xv * wg.x; lg[1] += xv * wg.y; lg[2] += xv * wg.z; lg[3] += xv * wg.w;
#pragma unroll
                for (int o4 = 0; o4 < 8; ++o4) { const f32x4 we = *(const GAS f32x4*)(wep + (size_t)(32 * c + u) * 32 + o4 * 4);
                    lg[4 + o4 * 4] += xv * we.x; lg[5 + o4 * 4] += xv * we.y; lg[6 + o4 * 4] += xv * we.z; lg[7 + o4 * 4] += xv * we.w; } }
        }
        ss += __shfl_xor(ss, 1); ss += __shfl_xor(ss, 2); ss += __shfl_xor(ss, 4);
        const float r = rsqrtf(ss * (1.f / DM) + RMS_EPS);
#pragma unroll
        for (int o = 0; o < 36; ++o) { float v = lg[o]; v += __shfl_xor(v, 1); v += __shfl_xor(v, 2); v += __shfl_xor(v, 4); lg[o] = v * r; }
        bf16* op = xn2 + (size_t)row * DM + 4 * part;
#pragma unroll 1
        for (int c = 0; c < 32; ++c) {
            const f32x4 x4 = *(const GAS f32x4*)(xp + 32 * c), g4 = *(const GAS f32x4*)(gp + 32 * c); const f32x4 y = x4 * g4 * r;
            *(GAS unsigned long long*)(op + 32 * c) = (unsigned long long)pk2(y.x, y.y) | ((unsigned long long)pk2(y.z, y.w) << 32);
        }
        float gm = -INFINITY; int gi = 0; float gl[4];
#pragma unroll
        for (int i = 0; i < 4; ++i) { gl[i] = lg[i] + b_rg[i]; if (gl[i] > gm) { gm = gl[i]; gi = i; } }
        float gs = 0.f;
#pragma unroll
        for (int i = 0; i < 4; ++i) gs += __expf(gl[i] - gm);
        const float gwt = 1.f / gs;
        float el[8];
#pragma unroll
        for (int j = 0; j < 8; ++j) { const float a0 = lg[4 + j] + b_re[j], a1 = lg[12 + j] + b_re[8 + j], a2 = lg[20 + j] + b_re[16 + j], a3 = lg[28 + j] + b_re[24 + j];
            el[j] = gi == 0 ? a0 : (gi == 1 ? a1 : (gi == 2 ? a2 : a3)); }
        float m1 = -INFINITY; int i1 = 0;
#pragma unroll
        for (int j = 0; j < 8; ++j) if (el[j] > m1) { m1 = el[j]; i1 = j; }
        float m2 = -INFINITY; int i2 = 0;
#pragma unroll
        for (int j = 0; j < 8; ++j) if (j != i1 && el[j] > m2) { m2 = el[j]; i2 = j; }
        const float p2 = __expf(m2 - m1);
        const float w1 = gwt / (1.f + p2), w2 = gwt * p2 / (1.f + p2);
        if (part == 0) { const int ea = gi * 8 + i1, eb = gi * 8 + i2; re[row * 2] = ea; re[row * 2 + 1] = eb; rw[row * 2] = w1; rw[row * 2 + 1] = w2;
            rank[row * 2] = (int)__hip_atomic_fetch_add(cnt + ea, 1u, __ATOMIC_RELAXED, __HIP_MEMORY_SCOPE_AGENT); rank[row * 2 + 1] = (int)__hip_atomic_fetch_add(cnt + eb, 1u, __ATOMIC_RELAXED, __HIP_MEMORY_SCOPE_AGENT); }
    }
}
__device__ __forceinline__ void ph_moe_weights(Frame& F, const Args& a, const int l) {
    const int LANE_ = lane_id(), TID_ = F.wave * 64 + LANE_; (void)TID_;
    LAS float* scr = (LAS float*)(F.lds + RING_OFF + F.wave * 16384);
    const int gw = F.vcu * NWAVES + F.wave, NGW = F.G * NWAVES;
    const float* w1 = (const float*)KARG(15) + (size_t)l * 32 * 1024 * 256; const float* w3 = (const float*)KARG(16) + (size_t)l * 32 * 1024 * 256; const float* w2 = (const float*)KARG(17) + (size_t)l * 32 * 256 * 1024;
    bf16* WT13 = (bf16*)(((unsigned char*)KARG(19)) + WS_WT13); bf16* WT2 = (bf16*)(((unsigned char*)KARG(19)) + WS_WT2);
    constexpr int I_13 = 32 * 2 * 128, I_2 = 32 * 128;
    for (int it = gw; it < I_13 + I_2; it += NGW) {
        if (it < I_13) { const int e = it >> 8, which = (it >> 7) & 1, rr = it & 127, kb = rr >> 3, nb = rr & 7, f0 = 32 * nb;
            tr_item((which ? w3 : w1) + (size_t)e * 1024 * 256, 256, 64 * kb, f0, WT13 + (size_t)e * 512 * 1024, 1024, (f0 >> 7) * 256 + which * 128 + (f0 & 127), scr, LANE_); }
        else { const int r = it - I_13, e = r >> 7, rr = r & 127, kb = rr >> 5, nb = rr & 31;
            tr_item(w2 + (size_t)e * 256 * 1024, 1024, 64 * kb, 32 * nb, WT2 + (size_t)e * 1024 * 256, 256, 32 * nb, scr, LANE_); }
    }
}
constexpr int MOE_TAB_OFF = LDSCTL_OFF + 1024;
__device__ __forceinline__ void moe_tables(Frame& F, const int l) {
    const int LANE_ = lane_id(), TID_ = F.wave * 64 + LANE_; (void)TID_;
    LAS int* tab = (LAS int*)(F.lds + MOE_TAB_OFF);
    if (F.wave == 0) {
        const int e = LANE_ & 31; const int c = (int)__hip_atomic_load(F.ctl + CW_CNT + 64 * l + e, RLX_AGENT); const int np = (c + 255) >> 8;
        int inc = np;
#pragma unroll
        for (int o = 1; o < 32; o <<= 1) { const int t = __shfl_up(inc, o); if ((LANE_ & 31) >= o) inc += t; }
        const int seg = inc - np;
        if (LANE_ < 32) { tab[32 + e] = seg; for (int j = 0; j < np; ++j) { tab[64 + seg + j] = e; const int rem = c - 256 * j; tab[256 + seg + j] = rem < 256 ? rem : 256; } }
        if (LANE_ == 31) tab[0] = inc;
    }
    LDS_WAIT(); __syncthreads();
}
__device__ __forceinline__ void ph_moe_gather(Frame& F, const Args& a, const int l) {
    const int LANE_ = lane_id(), TID_ = F.wave * 64 + LANE_; (void)TID_;
    moe_tables(F, l);
    const LAS int* tab = (const LAS int*)(F.lds + MOE_TAB_OFF);
    const int* re = (const int*)(((unsigned char*)KARG(19)) + WS_RE); const float* rw = (const float*)(((unsigned char*)KARG(19)) + WS_RW); const int* rank = (const int*)(((unsigned char*)KARG(19)) + WS_RANK);
    int* spair = (int*)(((unsigned char*)KARG(19)) + WS_SPAIR); float* sw = (float*)(((unsigned char*)KARG(19)) + WS_SW);
    const int gw = F.vcu * NWAVES + F.wave, NGW = F.G * NWAVES;
    for (int p = gw; p < 2 * M; p += NGW) {
        const int e = re[p]; const int slot = tab[32 + e] * 256 + rank[p];
        const GAS v4u* src = (const GAS v4u*)(((unsigned char*)KARG(19)) + WS_XN2 + (size_t)(p >> 1) * 2048); GAS v4u* dst = (GAS v4u*)(((unsigned char*)KARG(19)) + WS_XS + (size_t)slot * 2048);
        const v4u v0 = src[LANE_], v1 = src[LANE_ + 64]; dst[LANE_] = v0; dst[LANE_ + 64] = v1;
        if (LANE_ == 0) { spair[slot] = p; sw[slot] = rw[p]; }
    }
}
__device__ __forceinline__ void ph_final(Frame& F, const Args& a) {
    const int LANE_ = lane_id(), TID_ = F.wave * 64 + LANE_; (void)TID_;
    const int gw = F.vcu * NWAVES + F.wave, NGW = F.G * NWAVES;
    for (int m = gw; m < M; m += NGW) {
        GAS f32x4* xr = (GAS f32x4*)(((float*)KARG(18)) + (size_t)m * DM) + LANE_;
        const GAS v2u* y0 = (const GAS v2u*)(((unsigned char*)KARG(19)) + WS_YP + (size_t)(2 * m) * 2048) + LANE_; const GAS v2u* y1 = (const GAS v2u*)(((unsigned char*)KARG(19)) + WS_YP + (size_t)(2 * m + 1) * 2048) + LANE_;
#pragma unroll
        for (int j = 0; j < 4; ++j) { f32x4 v = xr[64 * j]; const v2u p0 = y0[64 * j], p1 = y1[64 * j];
            v.x += __uint_as_float(p0.x << 16) + __uint_as_float(p1.x << 16); v.y += __uint_as_float(p0.x & 0xffff0000u) + __uint_as_float(p1.x & 0xffff0000u);
            v.z += __uint_as_float(p0.y << 16) + __uint_as_float(p1.y << 16); v.w += __uint_as_float(p0.y & 0xffff0000u) + __uint_as_float(p1.y & 0xffff0000u);
            xr[64 * j] = v; }
    }
}
namespace ml {
typedef short bf16x8 __attribute__((ext_vector_type(8)));
typedef short s16x4 __attribute__((ext_vector_type(4)));
typedef float f32x16 __attribute__((ext_vector_type(16)));
typedef float f32x4v __attribute__((ext_vector_type(4)));
constexpr int TS = 272;
constexpr int OFF_Q = 0, OFF_K = 64 * TS, OFF_V = 2 * 64 * TS, OFF_SC = 3 * 64 * TS, OFF_N = OFF_SC + 1280;
__device__ __forceinline__ int crow(int r, int hi) { return (r & 3) + 8 * (r >> 2) + 4 * hi; }
__device__ __forceinline__ s16x4 trd(const LAS unsigned char* p) { return __builtin_bit_cast(s16x4, __builtin_amdgcn_ds_read_tr16_b64_v4i16((LAS s16x4*)p)); }
__device__ __forceinline__ bf16x8 cat8(s16x4 a, s16x4 b) { return (bf16x8){a[0], a[1], a[2], a[3], b[0], b[1], b[2], b[3]}; }
__device__ __forceinline__ float bfv(short v) { return __uint_as_float((unsigned)(unsigned short)v << 16); }
__device__ __forceinline__ bf16x8 scale8(bf16x8 v, const float (&w)[8]) {
    const unsigned a = pk2(bfv(v[0]) * w[0], bfv(v[1]) * w[1]), b = pk2(bfv(v[2]) * w[2], bfv(v[3]) * w[3]), c = pk2(bfv(v[4]) * w[4], bfv(v[5]) * w[5]), d = pk2(bfv(v[6]) * w[6], bfv(v[7]) * w[7]);
    return __builtin_bit_cast(bf16x8, (v4u){a, b, c, d});
}
__device__ __forceinline__ void stage_tile(LAS unsigned char* dst, const bf16* src, int tid) {
    const int row = tid >> 3, piece = tid & 7; const GAS v4u* s = (const GAS v4u*)(src + (size_t)row * 512 + piece * 16); const v4u a = s[0], b = s[1];
    *(LAS v4u*)(dst + row * TS + piece * 32) = a; *(LAS v4u*)(dst + row * TS + piece * 32 + 16) = b;
}
__device__ __forceinline__ float swap_add(float v) { auto rr = __builtin_amdgcn_permlane32_swap(__float_as_uint(v), __float_as_uint(v), false, false); return __uint_as_float(rr[0]) + __uint_as_float(rr[1]); }
}

__device__ __forceinline__ void ph_ml_scalars(Frame& F, unsigned char* ws) {
    const int lane = lane_id(), gw = F.vcu * NWAVES + F.wave;
    if (gw >= 32) return;
    const int bh = gw, b = bh >> 2, h = bh & 3;
    const float* ifpre = (const float*)(ws + WS_IFPRE); ml::f32x4v* scal = (ml::f32x4v*)(ws + WS_MLSCAL); float* wk = (float*)(ws + WS_MLWK); float* dec = (float*)(ws + WS_MLDEC);
    float m = 0.f;
    for (int c = 0; c < 32; ++c) {
        const size_t row = (size_t)b * SEQ + c * 64 + lane;
        const float li = ifpre[row * 8 + h], fp = ifpre[row * 8 + 4 + h];
        const float lf = fp >= 0.f ? -log1pf(__expf(-fp)) : fp - log1pf(__expf(fp));
        float bc = lf;
#pragma unroll
        for (int o = 1; o < 64; o <<= 1) { const float t = __shfl_up(bc, o); if (lane >= o) bc += t; }
        const float a = li - bc; float A = a;
#pragma unroll
        for (int o = 1; o < 64; o <<= 1) { const float t = __shfl_up(A, o); if (lane >= o) A = fmaxf(A, t); }
        const float Mx = fmaxf(m, A), MxL = __shfl(Mx, 63), bL = __shfl(bc, 63);
        scal[(size_t)bh * SEQ + c * 64 + lane] = (ml::f32x4v){a, Mx, __expf(m - Mx), __expf(-(bc + Mx))};
        wk[(size_t)bh * SEQ + c * 64 + lane] = __expf(a - MxL);
        if (lane == 0) dec[bh * 32 + c] = __expf(m - MxL);
        m = bL + MxL;
    }
}
__device__ __forceinline__ void ph_ml_state(Frame& F, unsigned char* ws) {
    const int lane = lane_id(), tid = F.wave * 64 + lane, wave = F.wave;
    LAS unsigned char* lds = F.lds; LAS float* sWk = (LAS float*)(lds + ml::OFF_SC + 1024);
    const bf16* K2 = (const bf16*)(ws + WS_MLK2); const bf16* V = (const bf16*)(ws + WS_MLV); const float* wkg = (const float*)(ws + WS_MLWK);
    bf16* cst = (bf16*)(ws + WS_MLCST); float* dn = (float*)(ws + WS_MLDN);
    const int r32 = lane & 31, hi = lane >> 5, q4 = (lane & 15) >> 2, p4 = lane & 3, blk = (lane >> 4) & 1, db = wave & 3, eh = wave >> 2;
    for (int u = F.vcu; u < 32 * 31; u += F.G) {
        const int bh = u / 31, c = u - bh * 31, b = bh >> 2, h = bh & 3; const size_t row0 = (size_t)b * SEQ + c * 64;
        ml::stage_tile(lds + ml::OFF_K, K2 + row0 * 512 + h * 128, tid); ml::stage_tile(lds + ml::OFF_V, V + row0 * 512 + h * 128, tid);
        if (tid < 64) sWk[tid] = wkg[(size_t)bh * SEQ + c * 64 + tid];
        LDS_WAIT(); __syncthreads();
        if (tid < 128) { float s = 0.f;
            for (int ss = 0; ss < 64; ++ss) s += sWk[ss] * bf2f(*(const LAS bf16*)(lds + ml::OFF_K + ss * ml::TS + tid * 2));
            dn[(size_t)(bh * 32 + c) * 128 + tid] = s; }
        ml::f32x16 acc0 = {}, acc1 = {};
#pragma unroll
        for (int ks = 0; ks < 4; ++ks) {
            const int rowb = 16 * ks + 8 * hi + q4, colb = (16 * blk + 4 * p4) * 2;
            const ml::bf16x8 Af = ml::cat8(ml::trd(lds + ml::OFF_K + rowb * ml::TS + 64 * db + colb), ml::trd(lds + ml::OFF_K + (rowb + 4) * ml::TS + 64 * db + colb));
            float w[8]; { const ml::f32x4v w0 = *(const LAS ml::f32x4v*)(sWk + 16 * ks + 8 * hi), w1 = *(const LAS ml::f32x4v*)(sWk + 16 * ks + 8 * hi + 4);
                w[0] = w0[0]; w[1] = w0[1]; w[2] = w0[2]; w[3] = w0[3]; w[4] = w1[0]; w[5] = w1[1]; w[6] = w1[2]; w[7] = w1[3]; }
            const ml::bf16x8 B0 = ml::scale8(ml::cat8(ml::trd(lds + ml::OFF_V + rowb * ml::TS + 64 * (2 * eh) + colb), ml::trd(lds + ml::OFF_V + (rowb + 4) * ml::TS + 64 * (2 * eh) + colb)), w);
            const ml::bf16x8 B1 = ml::scale8(ml::cat8(ml::trd(lds + ml::OFF_V + rowb * ml::TS + 64 * (2 * eh + 1) + colb), ml::trd(lds + ml::OFF_V + (rowb + 4) * ml::TS + 64 * (2 * eh + 1) + colb)), w);
            acc0 = __builtin_amdgcn_mfma_f32_32x32x16_bf16(Af, B0, acc0, 0, 0, 0); acc1 = __builtin_amdgcn_mfma_f32_32x32x16_bf16(Af, B1, acc1, 0, 0, 0);
        }
        bf16* cb = cst + (size_t)(bh * 32 + c) * 128 * 128;
#pragma unroll
        for (int g = 0; g < 4; ++g) { const int d0 = 32 * db + 8 * g + 4 * hi;
            *(GAS unsigned long long*)(cb + (size_t)(32 * (2 * eh) + r32) * 128 + d0) = (unsigned long long)pk2(acc0[4 * g], acc0[4 * g + 1]) | ((unsigned long long)pk2(acc0[4 * g + 2], acc0[4 * g + 3]) << 32);
            *(GAS unsigned long long*)(cb + (size_t)(32 * (2 * eh + 1) + r32) * 128 + d0) = (unsigned long long)pk2(acc1[4 * g], acc1[4 * g + 1]) | ((unsigned long long)pk2(acc1[4 * g + 2], acc1[4 * g + 3]) << 32); }
        LDS_WAIT(); __syncthreads();
    }
}
__device__ __forceinline__ void ph_ml_scan(Frame& F, unsigned char* ws) {
    const int lane = lane_id(), tid = F.wave * 64 + lane;
    bf16* cst = (bf16*)(ws + WS_MLCST); float* dn = (float*)(ws + WS_MLDN); const float* dec = (const float*)(ws + WS_MLDEC);
    for (int idx = blockIdx.x * 512 + tid; idx < 32 * 2048 + 32 * 128; idx += F.G * 512) {
        if (idx < 32 * 2048) { const int bh = idx >> 11, off = (idx & 2047) * 8; float acc[8];
#pragma unroll
            for (int j = 0; j < 8; ++j) acc[j] = 0.f;
#pragma unroll 4
            for (int c = 0; c < 31; ++c) { const float dc = dec[bh * 32 + c]; GAS v4u* p = (GAS v4u*)(cst + (size_t)(bh * 32 + c) * 16384 + off); const v4u v = *p;
                acc[0] = dc * acc[0] + __uint_as_float(v.x << 16); acc[1] = dc * acc[1] + __uint_as_float(v.x & 0xffff0000u); acc[2] = dc * acc[2] + __uint_as_float(v.y << 16); acc[3] = dc * acc[3] + __uint_as_float(v.y & 0xffff0000u);
                acc[4] = dc * acc[4] + __uint_as_float(v.z << 16); acc[5] = dc * acc[5] + __uint_as_float(v.z & 0xffff0000u); acc[6] = dc * acc[6] + __uint_as_float(v.w << 16); acc[7] = dc * acc[7] + __uint_as_float(v.w & 0xffff0000u);
                v4u o; o.x = pk2(acc[0], acc[1]); o.y = pk2(acc[2], acc[3]); o.z = pk2(acc[4], acc[5]); o.w = pk2(acc[6], acc[7]); *p = o; } }
        else { const int r = idx - 32 * 2048, bh = r >> 7, d = r & 127; float n = 0.f;
            for (int c = 0; c < 31; ++c) { float* p = dn + (size_t)(bh * 32 + c) * 128 + d; n = dec[bh * 32 + c] * n + *p; *p = n; } }
    }
}
__device__ __forceinline__ void ph_ml_out(Frame& F, unsigned char* ws) {
    const int lane = lane_id(), tid = F.wave * 64 + lane, wave = F.wave;
    LAS unsigned char* lds = F.lds; LAS float* sA = (LAS float*)(lds + ml::OFF_SC); LAS float* sMx = sA + 64; LAS float* sWi = sA + 128; LAS float* sEm = sA + 192; LAS float* sN = (LAS float*)(lds + ml::OFF_N);
    const bf16* Q2 = (const bf16*)(ws + WS_MLQ2); const bf16* K2 = (const bf16*)(ws + WS_MLK2); const bf16* V = (const bf16*)(ws + WS_MLV); bf16* mlo = (bf16*)(ws + WS_MLO);
    const bf16* cst = (const bf16*)(ws + WS_MLCST); const float* nst = (const float*)(ws + WS_MLDN); const ml::f32x4v* scal = (const ml::f32x4v*)(ws + WS_MLSCAL);
    const int r32 = lane & 31, hi = lane >> 5, q4 = (lane & 15) >> 2, p4 = lane & 3, blk = (lane >> 4) & 1, eb = wave >> 1, tb = wave & 1, t = 32 * tb + r32;
    for (int u = F.vcu; u < 1024; u += F.G) {
        const int bh = u >> 5, c = u & 31, b = bh >> 2, h = bh & 3; const size_t row0 = (size_t)b * SEQ + c * 64;
        ml::stage_tile(lds + ml::OFF_Q, Q2 + row0 * 512 + h * 128, tid); ml::stage_tile(lds + ml::OFF_K, K2 + row0 * 512 + h * 128, tid); ml::stage_tile(lds + ml::OFF_V, V + row0 * 512 + h * 128, tid);
        if (tid < 64) { const ml::f32x4v s4 = scal[(size_t)bh * SEQ + c * 64 + tid]; sA[tid] = s4[0]; sMx[tid] = s4[1]; sWi[tid] = s4[2]; sEm[tid] = s4[3]; }
        if (tid >= 64 && tid < 192) sN[tid - 64] = c > 0 ? nst[(size_t)(bh * 32 + c - 1) * 128 + tid - 64] : 0.f;
        LDS_WAIT(); __syncthreads();
        ml::f32x16 S0 = {}, S1 = {}; ml::bf16x8 qf[8]; float dni = 0.f;
#pragma unroll
        for (int ks = 0; ks < 8; ++ks) {
            qf[ks] = *(const LAS ml::bf16x8*)(lds + ml::OFF_Q + t * ml::TS + (16 * ks + 8 * hi) * 2);
            const ml::bf16x8 a0 = *(const LAS ml::bf16x8*)(lds + ml::OFF_K + r32 * ml::TS + (16 * ks + 8 * hi) * 2), a1 = *(const LAS ml::bf16x8*)(lds + ml::OFF_K + (32 + r32) * ml::TS + (16 * ks + 8 * hi) * 2);
            S0 = __builtin_amdgcn_mfma_f32_32x32x16_bf16(a0, qf[ks], S0, 0, 0, 0); S1 = __builtin_amdgcn_mfma_f32_32x32x16_bf16(a1, qf[ks], S1, 0, 0, 0);
            const ml::f32x4v n0 = *(const LAS ml::f32x4v*)(sN + 16 * ks + 8 * hi), n1 = *(const LAS ml::f32x4v*)(sN + 16 * ks + 8 * hi + 4);
            dni += ml::bfv(qf[ks][0]) * n0[0] + ml::bfv(qf[ks][1]) * n0[1] + ml::bfv(qf[ks][2]) * n0[2] + ml::bfv(qf[ks][3]) * n0[3] + ml::bfv(qf[ks][4]) * n1[0] + ml::bfv(qf[ks][5]) * n1[1] + ml::bfv(qf[ks][6]) * n1[2] + ml::bfv(qf[ks][7]) * n1[3];
        }
        const float Mxt = sMx[t], wit = sWi[t], emt = sEm[t]; float den = 0.f;
#pragma unroll
        for (int r = 0; r < 16; ++r) { const int s0 = ml::crow(r, hi), s1 = 32 + s0;
            const float w0 = s0 <= t ? __expf(sA[s0] - Mxt) : 0.f, w1 = s1 <= t ? __expf(sA[s1] - Mxt) : 0.f;
            S0[r] *= w0; S1[r] *= w1; den += S0[r] + S1[r]; }
        den = ml::swap_add(den) + wit * ml::swap_add(dni);
        ml::bf16x8 pf[4];
        pf[0] = __builtin_bit_cast(ml::bf16x8, (v4u){pk2(S0[0], S0[1]), pk2(S0[2], S0[3]), pk2(S0[4], S0[5]), pk2(S0[6], S0[7])});
        pf[1] = __builtin_bit_cast(ml::bf16x8, (v4u){pk2(S0[8], S0[9]), pk2(S0[10], S0[11]), pk2(S0[12], S0[13]), pk2(S0[14], S0[15])});
        pf[2] = __builtin_bit_cast(ml::bf16x8, (v4u){pk2(S1[0], S1[1]), pk2(S1[2], S1[3]), pk2(S1[4], S1[5]), pk2(S1[6], S1[7])});
        pf[3] = __builtin_bit_cast(ml::bf16x8, (v4u){pk2(S1[8], S1[9]), pk2(S1[10], S1[11]), pk2(S1[12], S1[13]), pk2(S1[14], S1[15])});
        ml::f32x16 O = {};
#pragma unroll
        for (int kk = 0; kk < 4; ++kk) {
            const int rowb = 16 * kk + 4 * hi + q4, colb = (32 * eb + 16 * blk + 4 * p4) * 2;
            const ml::bf16x8 Av = ml::cat8(ml::trd(lds + ml::OFF_V + rowb * ml::TS + colb), ml::trd(lds + ml::OFF_V + (rowb + 8) * ml::TS + colb));
            O = __builtin_amdgcn_mfma_f32_32x32x16_bf16(Av, pf[kk], O, 0, 0, 0);
        }
        if (c > 0) {
            const bf16* cp = cst + (size_t)(bh * 32 + c - 1) * 16384 + (size_t)(32 * eb + r32) * 128 + 8 * hi;
            float wv[8];
#pragma unroll
            for (int j = 0; j < 8; ++j) wv[j] = wit;
#pragma unroll
            for (int ks = 0; ks < 8; ++ks) { const ml::bf16x8 Ac = *(const GAS ml::bf16x8*)(cp + 16 * ks);
                O = __builtin_amdgcn_mfma_f32_32x32x16_bf16(Ac, ml::scale8(qf[ks], wv), O, 0, 0, 0); }
        }
        const float inv = 1.0f / fmaxf(fabsf(den), emt);
        bf16* op = mlo + (row0 + t) * 512 + h * 128 + 32 * eb + 4 * hi;
#pragma unroll
        for (int g = 0; g < 4; ++g) { GAS v2u* pp = (GAS v2u*)(op + 8 * g); const v2u ov = *pp;
            const float y0 = O[4 * g] * inv * sigmoidf_(__uint_as_float(ov.x << 16)), y1 = O[4 * g + 1] * inv * sigmoidf_(__uint_as_float(ov.x & 0xffff0000u));
            const float y2 = O[4 * g + 2] * inv * sigmoidf_(__uint_as_float(ov.y << 16)), y3 = O[4 * g + 3] * inv * sigmoidf_(__uint_as_float(ov.y & 0xffff0000u));
            v2u o2; o2.x = pk2(y0, y1); o2.y = pk2(y2, y3); *pp = o2; }
        LDS_WAIT(); __syncthreads();
    }
}

__device__ __forceinline__ void ph_sb(Frame& F, unsigned char* ws) {
    const int lane = lane_id(), wave = F.wave, r32 = lane & 31, hi = lane >> 5, q4 = (lane & 15) >> 2, p4 = lane & 3, blk = (lane >> 4) & 1;
    constexpr int RS = 144;
    LAS unsigned char* Kt = F.lds + wave * 9216; LAS unsigned char* Vt = Kt + 32 * RS;
    bf16* sbq = (bf16*)(ws + WS_SBQ); const bf16* sbk = (const bf16*)(ws + WS_SBK); const bf16* sbv = (const bf16*)(ws + WS_SBV);
    const int srow = lane >> 1, shalf = lane & 1;
    for (int u = F.vcu * NWAVES + wave; u < 64 * 64; u += F.G * NWAVES) {
        const int qt = u & 63, bh = u >> 6, b = bh >> 3, h = bh & 7, t0 = qt * 32; const size_t rowb = (size_t)b * SEQ;
        ml::bf16x8 qf[4];
#pragma unroll
        for (int ks = 0; ks < 4; ++ks) qf[ks] = *(const GAS ml::bf16x8*)(sbq + (rowb + t0 + r32) * 512 + h * 64 + 16 * ks + 8 * hi);
        ml::f32x16 O0 = {}, O1 = {}; float carry = 0.f;
        for (int k0 = t0; k0 >= 0; k0 -= 32) {
            { const GAS v4u* ks_ = (const GAS v4u*)(sbk + (rowb + k0 + srow) * 512 + h * 64 + shalf * 32); const GAS v4u* vs_ = (const GAS v4u*)(sbv + (rowb + k0 + srow) * 512 + h * 64 + shalf * 32);
              const v4u a0 = ks_[0], a1 = ks_[1], a2 = ks_[2], a3 = ks_[3], b0 = vs_[0], b1 = vs_[1], b2 = vs_[2], b3 = vs_[3];
              LAS v4u* kd = (LAS v4u*)(Kt + srow * RS + shalf * 64); LAS v4u* vd = (LAS v4u*)(Vt + srow * RS + shalf * 64);
              kd[0] = a0; kd[1] = a1; kd[2] = a2; kd[3] = a3; vd[0] = b0; vd[1] = b1; vd[2] = b2; vd[3] = b3; }
            ml::f32x16 S = {};
#pragma unroll
            for (int ks = 0; ks < 4; ++ks) { const ml::bf16x8 a = *(const LAS ml::bf16x8*)(Kt + r32 * RS + (16 * ks + 8 * hi) * 2); S = __builtin_amdgcn_mfma_f32_32x32x16_bf16(a, qf[ks], S, 0, 0, 0); }
            const int lim = k0 == t0 ? r32 : 64;
            float sfx[16], T[4], To[4];
#pragma unroll
            for (int k = 0; k < 4; ++k) {
                float x[4];
#pragma unroll
                for (int i = 0; i < 4; ++i) { const float z = S[4 * k + i]; const float sp = z > 0.f ? z + __log2f(1.f + exp2f(-z)) : __log2f(1.f + exp2f(z)); x[i] = (8 * k + 4 * hi + i) < lim ? sp : 0.f; }
                x[2] += x[3]; x[1] += x[2]; x[0] += x[1];
                sfx[4 * k] = x[0]; sfx[4 * k + 1] = x[1]; sfx[4 * k + 2] = x[2]; sfx[4 * k + 3] = x[3]; T[k] = x[0];
            }
#pragma unroll
            for (int k = 0; k < 4; ++k) { auto rr = __builtin_amdgcn_permlane32_swap(__float_as_uint(T[k]), __float_as_uint(T[k]), false, false); To[k] = __uint_as_float(hi ? rr[0] : rr[1]); }
            float P = 0.f; float w[16];
#pragma unroll
            for (int k = 3; k >= 0; --k) { const float off = carry + P + (hi == 0 ? To[k] : 0.f);
#pragma unroll
                for (int i = 0; i < 4; ++i) { const float C = sfx[4 * k + i] + off; w[4 * k + i] = (8 * k + 4 * hi + i) < lim ? exp2f(S[4 * k + i] - C) : 0.f; }
                P += T[k] + To[k]; }
            carry += P;
            const ml::bf16x8 pf0 = __builtin_bit_cast(ml::bf16x8, (v4u){pk2(w[0], w[1]), pk2(w[2], w[3]), pk2(w[4], w[5]), pk2(w[6], w[7])});
            const ml::bf16x8 pf1 = __builtin_bit_cast(ml::bf16x8, (v4u){pk2(w[8], w[9]), pk2(w[10], w[11]), pk2(w[12], w[13]), pk2(w[14], w[15])});
#pragma unroll
            for (int kk = 0; kk < 2; ++kk) { const int rb = 16 * kk + 4 * hi + q4; const int cb = (16 * blk + 4 * p4) * 2;
                const ml::bf16x8 A0 = ml::cat8(ml::trd(Vt + rb * RS + cb), ml::trd(Vt + (rb + 8) * RS + cb)), A1 = ml::cat8(ml::trd(Vt + rb * RS + 64 + cb), ml::trd(Vt + (rb + 8) * RS + 64 + cb));
                O0 = __builtin_amdgcn_mfma_f32_32x32x16_bf16(A0, kk ? pf1 : pf0, O0, 0, 0, 0); O1 = __builtin_amdgcn_mfma_f32_32x32x16_bf16(A1, kk ? pf1 : pf0, O1, 0, 0, 0); }
            if (__all(carry > 150.f)) break;
        }
        bf16* op = sbq + (rowb + t0 + r32) * 512 + h * 64 + 4 * hi;
#pragma unroll
        for (int g = 0; g < 4; ++g) {
            *(GAS unsigned long long*)(op + 8 * g) = (unsigned long long)pk2(O0[4 * g], O0[4 * g + 1]) | ((unsigned long long)pk2(O0[4 * g + 2], O0[4 * g + 3]) << 32);
            *(GAS unsigned long long*)(op + 32 + 8 * g) = (unsigned long long)pk2(O1[4 * g], O1[4 * g + 1]) | ((unsigned long long)pk2(O1[4 * g + 2], O1[4 * g + 3]) << 32); }
    }
}
__device__ __forceinline__ void ph_kmean2(Frame& F, unsigned char* ws) {
    const int lane = lane_id(), rp = lane >> 3, pc = lane & 7;
    const bf16* mbk = (const bf16*)(ws + WS_MBK); float* kmean = (float*)(ws + WS_KMEAN);
    for (int u = F.vcu * NWAVES + F.wave; u < 512; u += F.G * NWAVES) {
        const int blk = u & 7, h = (u >> 3) & 7, b = u >> 6;
        const bf16* base = mbk + ((size_t)b * SEQ + blk * 256 + rp) * 512 + h * 64 + pc * 8;
        float acc[8];
#pragma unroll
        for (int j = 0; j < 8; ++j) acc[j] = 0.f;
#pragma unroll 8
        for (int i = 0; i < 32; ++i) { const v4u v = *(const GAS v4u*)(base + (size_t)i * 8 * 512);
            acc[0] += __uint_as_float(v.x << 16); acc[1] += __uint_as_float(v.x & 0xffff0000u); acc[2] += __uint_as_float(v.y << 16); acc[3] += __uint_as_float(v.y & 0xffff0000u);
            acc[4] += __uint_as_float(v.z << 16); acc[5] += __uint_as_float(v.z & 0xffff0000u); acc[6] += __uint_as_float(v.w << 16); acc[7] += __uint_as_float(v.w & 0xffff0000u); }
#pragma unroll
        for (int j = 0; j < 8; ++j) { float v = acc[j]; v += __shfl_xor(v, 8); v += __shfl_xor(v, 16); v += __shfl_xor(v, 32); acc[j] = v * (1.f / 256.f); }
        if (rp == 0) { float* o = kmean + (size_t)u * 64 + pc * 8; *(GAS f32x4*)o = (f32x4){acc[0], acc[1], acc[2], acc[3]}; *(GAS f32x4*)(o + 4) = (f32x4){acc[4], acc[5], acc[6], acc[7]}; }
    }
}
__device__ __forceinline__ void ph_conv2(Frame& F, unsigned char* ws, const float* cw) {
    const int lane = lane_id(), tid = F.wave * 64 + lane;
    const bf16* mlqk = (const bf16*)(ws + WS_MLQK); bf16* q2 = (bf16*)(ws + WS_MLQ2); bf16* k2 = (bf16*)(ws + WS_MLK2);
    for (int idx = blockIdx.x * 512 + tid; idx < M * 128; idx += F.G * 512) {
        const int c8 = (idx & 127) * 8, row = idx >> 7, t = row & (SEQ - 1);
        float y[8];
#pragma unroll
        for (int j = 0; j < 8; ++j) y[j] = 0.f;
#pragma unroll
        for (int j = 0; j < 4; ++j) { if (t - 3 + j >= 0) { const v4u v = *(const GAS v4u*)(mlqk + (size_t)(row - 3 + j) * 1024 + c8); const f32x4 w0 = *(const GAS f32x4*)(cw + j * 1024 + c8), w1 = *(const GAS f32x4*)(cw + j * 1024 + c8 + 4);
            y[0] += w0.x * __uint_as_float(v.x << 16); y[1] += w0.y * __uint_as_float(v.x & 0xffff0000u); y[2] += w0.z * __uint_as_float(v.y << 16); y[3] += w0.w * __uint_as_float(v.y & 0xffff0000u);
            y[4] += w1.x * __uint_as_float(v.z << 16); y[5] += w1.y * __uint_as_float(v.z & 0xffff0000u); y[6] += w1.z * __uint_as_float(v.w << 16); y[7] += w1.w * __uint_as_float(v.w & 0xffff0000u); } }
        const float sc = c8 < 512 ? 1.f : 0.08838834764831845f;
#pragma unroll
        for (int j = 0; j < 8; ++j) y[j] = y[j] * sigmoidf_(y[j]) * sc;
        v4u o; o.x = pk2(y[0], y[1]); o.y = pk2(y[2], y[3]); o.z = pk2(y[4], y[5]); o.w = pk2(y[6], y[7]);
        bf16* dst = c8 < 512 ? q2 + (size_t)row * 512 + c8 : k2 + (size_t)row * 512 + c8 - 512;
        *(GAS v4u*)dst = o;
    }
}

constexpr int NPH = 12;
template <int l> __device__ __forceinline__ void layer_body(Frame& F, const Args& args, const XcdBarrier& bar, const int plo, const int phi) {
    const int LANE_ = lane_id(), TID_ = F.wave * 64 + LANE_; (void)TID_;
    unsigned char* ws = ((unsigned char*)KARG(19));
        const int lo = plo - l * NPH, hi = phi - l * NPH;
#define IN(k) (lo <= (k) && (k) < hi)
#define SEAM(k) do { if ((k) + 1 + l * NPH < phi) xcd_barrier(bar); } while (0)
        const float* xin = l == 0 ? (const float*)KARG(0) : (const float*)((float*)KARG(18));
        if (IN(0)) { p0_prologue<(l > 0)>(F, args, l, xin); SEAM(0); }
        if (IN(1)) {
            pg8::Gemm g{(const pg8::bf16_t*)(ws + WS_XN), (const pg8::bf16_t*)(ws + WS_WTIN), M, 8192, DM}; pg8::StaticOrder S; S.init(M, 8192, F.G, (int)blockIdx.x);
            pg8::EpiInProj E{ws};
            pg8::gemm_phase<pg8::EpiInProj, pg8::StaticOrder, PG8_ALIGN, PG8_SP2>(F.lds + RING_OFF, g, S, E, F.wave);
            SEAM(1);
        }
        if (IN(2)) { ph_ml_scalars(F, ws); ph_prep_qk(F, args, l); ph_conv2(F, ws, (const float*)KARG(6) + l * 4 * 1024); SEAM(2); }
        if (IN(3)) { ph_kmean2(F, ws); ph_ml_state(F, ws); SEAM(3); }
        if (IN(4)) { ph_ml_scan(F, ws); ph_sb(F, ws); SEAM(4); }
        if (IN(5)) {
            ph_ml_out(F, ws);
            const attn_body::AttnTensors AT{(const attn_body::bf16*)(ws + WS_MBQ), (const attn_body::bf16*)(ws + WS_MBK), (const attn_body::bf16*)(ws + WS_MBV), (attn_body::bf16*)(ws + WS_MBQ)};
            const attn_body::StaticOrder S((int)F.G, (int)blockIdx.x);
            attn_body::attn_phase<attn_body::StaticOrder>((char*)F.lds + RING_OFF, AT, S, (const float*)(ws + WS_KMEAN), F.wave);
            SEAM(5);
        }
        if (IN(6)) {
            pg8::Gemm g{(const pg8::bf16_t*)(ws + WS_SBQ), (const pg8::bf16_t*)(ws + WS_WTBR), M, 1024, 512}; pg8::YOrder S{F.vcu, F.G};
            pg8::EpiYMerge E{(const pg8::bf16_t*)(ws + WS_GATES), (pg8::bf16_t*)(ws + WS_MERGED)};
            pg8::gemm_phase<pg8::EpiYMerge, pg8::YOrder, PG8_ALIGN, PG8_SP2>(F.lds + RING_OFF, g, S, E, F.wave);
            SEAM(6);
        }
        if (IN(7)) {
            pg8::Gemm g{(const pg8::bf16_t*)(ws + WS_MERGED), (const pg8::bf16_t*)(ws + WS_WTOUT), M, DM, DM}; pg8::StaticOrder S; S.init(M, DM, F.G, (int)blockIdx.x);
            pg8::EpiResid32 E{xin, ((float*)KARG(18))};
            pg8::gemm_phase<pg8::EpiResid32, pg8::StaticOrder, PG8_ALIGN, PG8_SP2>(F.lds + RING_OFF, g, S, E, F.wave);
            SEAM(7);
        }
        if (IN(8)) { ph_moe_weights(F, args, l); ph_router(F, args, l); SEAM(8); }
        if (IN(9)) { ph_moe_gather(F, args, l); SEAM(9); }
        if (IN(10)) {
            moe_tables(F, l); const LAS int* tab = (const LAS int*)(F.lds + MOE_TAB_OFF);
            pg8::Gemm g{(const pg8::bf16_t*)(ws + WS_XS), (const pg8::bf16_t*)(ws + WS_WT13), M, 512, DM}; pg8::MoeOrder S{F.vcu, F.G, tab[0], 2, tab + 64};
            pg8::EpiSwiGLU E{(pg8::bf16_t*)(ws + WS_HS)};
            pg8::gemm_phase<pg8::EpiSwiGLU, pg8::MoeOrder, PG8_ALIGN, PG8_SP2>(F.lds + RING_OFF, g, S, E, F.wave);
            SEAM(10);
        }
        if (IN(11)) {
            moe_tables(F, l); const LAS int* tab = (const LAS int*)(F.lds + MOE_TAB_OFF);
            pg8::Gemm g{(const pg8::bf16_t*)(ws + WS_HS), (const pg8::bf16_t*)(ws + WS_WT2), M, DM, 256}; pg8::MoeOrder S{F.vcu, F.G, tab[0], 4, tab + 64};
            pg8::EpiMoeOut E{(pg8::bf16_t*)(ws + WS_YP), (const int*)(ws + WS_SPAIR), (const float*)(ws + WS_SW), tab + 256};
            pg8::gemm_phase<pg8::EpiMoeOut, pg8::MoeOrder, PG8_ALIGN, PG8_SP2>(F.lds + RING_OFF, g, S, E, F.wave);
            SEAM(11);
        }
#undef IN
#undef SEAM
}
__global__ void __launch_bounds__(NWAVES * 64, 2) mk(Args args) {
    extern __shared__ __attribute__((aligned(16))) unsigned char lds[];
    Frame F;
    F.lds = (LAS unsigned char*)lds; F.MISC = (volatile LAS unsigned*)(F.lds + MISC_OFF);
    F.wave = __builtin_amdgcn_readfirstlane((int)threadIdx.x >> 6);
    const int LANE_ = lane_id(), TID_ = F.wave * 64 + LANE_;
    F.G = gridDim.x; { const int bx = blockIdx.x; F.vcu = (F.G % 8 == 0) ? (bx % 8) * (F.G / 8) + bx / 8 : bx; }
    unsigned char* ws = ((unsigned char*)KARG(19)); F.ctl = (gu32*)(ws + WS_CTL);
    for (int u = TID_; u < (LDS_BYTES - LDSCTL_OFF) / 4; u += NWAVES * 64) ((LAS unsigned*)(F.lds + LDSCTL_OFF))[u] = 0u;
    __syncthreads();
    const int plo = args.ph_lo, phi = args.ph_hi;
    XcdBarrier bar; bar.bar = (unsigned*)(F.ctl + CW_BAR); bar.x = 0; bar.st = nullptr; bar.w = (unsigned)F.wave;
    if (phi - plo > 1) bar = xcd_barrier_post((unsigned*)(F.ctl + CW_BAR), F.MISC + 8, (unsigned)F.wave);
    layer_body<0>(F, args, bar, plo, phi);
    layer_body<1>(F, args, bar, plo, phi);
    if (plo <= DEPTH * NPH && DEPTH * NPH < phi) ph_final(F, args);
}

#ifndef MK_ONE_LAUNCH
#define MK_ONE_LAUNCH 1
#endif
extern "C" void kernel_launch(void* const* d_in, const int* in_sizes, int n_in, void* d_out, int out_size, void* d_ws, size_t ws_size, hipStream_t stream) {
    static int grid = 0;
    if (grid == 0) {
        if (n_in != 18 || out_size != M * DM || ws_size < WS_END) { fprintf(stderr, "kernel_launch: unexpected shapes (n_in %d out %d ws %zu)\n", n_in, out_size, ws_size); grid = -1; return; }
        int dev = 0, cus = 0;
        if (hipGetDevice(&dev) != hipSuccess || hipDeviceGetAttribute(&cus, hipDeviceAttributeMultiprocessorCount, dev) != hipSuccess) { grid = -1; return; }
        if (hipFuncSetAttribute((const void*)mk, hipFuncAttributeMaxDynamicSharedMemorySize, LDS_BYTES) != hipSuccess) { grid = -1; return; }
        int per_cu = 0;
        if (hipOccupancyMaxActiveBlocksPerMultiprocessor(&per_cu, (const void*)mk, NWAVES * 64, LDS_BYTES) != hipSuccess || per_cu < 1) fprintf(stderr, "kernel_launch: occupancy query says %d blocks per CU\n", per_cu);
        (void)hipGetLastError();
        grid = cus;
    }
    if (grid < 0) return;
    (void)hipMemsetAsync((char*)d_ws + WS_CTL, 0, CTL_ZERO_BYTES, stream);
    Args a{};
    for (int i = 0; i < 18; ++i) a.in[i] = d_in[i];
    a.out = (float*)d_out; a.ws = (unsigned char*)d_ws; a.layer = 0;
#if MK_ONE_LAUNCH
    a.ph_lo = 0; a.ph_hi = DEPTH * NPH + 1; hipLaunchKernelGGL(mk, dim3(grid), dim3(NWAVES * 64), LDS_BYTES, stream, a);
#else
    for (int p = 0; p < DEPTH * NPH + 1; ++p) { a.ph_lo = p; a.ph_hi = p + 1; hipLaunchKernelGGL(mk, dim3(grid), dim3(NWAVES * 64), LDS_BYTES, stream, a); }
#endif
}
```
